# Optimizing an MI355X kernel written in HIP

```python
import jax, jax.numpy as jnp
from jax import lax
import numpy as np

D_MODEL = 1024
BATCH = 1
SEQ = 16384
DEPTH = 4

HEAD_DIM = 64
N_MIXERS = 3
BAND_BLOCK = 128
A_HEADS = 16
A_KV_HEADS = 2
A_WINDOW = 128
B_HEADS = 16
B_PATTERNS = ((128, 1), (512, 4), (2048, 16))
B_GROUPS = len(B_PATTERNS)
C_HEADS = 16
C_BLOCK = 256
C_TOPK = 3
C_QCHUNK = 64
PEER_HEADS = 8
PEER_NKEYS = 128
PEER_EXPERTS = PEER_NKEYS * PEER_NKEYS
PEER_DKEY = 256
PEER_TOPK = 16
PEER_CHUNK = 128
PLE_DIM = 256
LN_EPS = 1e-5
DEEPNORM_ALPHA = (2 * DEPTH) ** 0.25
DEEPNORM_BETA = (8 * DEPTH) ** -0.25
N_LAYERS_A = (DEPTH + 2) // 3
N_LAYERS_B = (DEPTH + 1) // 3
N_LAYERS_C = DEPTH // 3
A_QKV = (A_HEADS + 2 * A_KV_HEADS) * HEAD_DIM
B_QKV = (B_GROUPS * B_HEADS + 2 * B_HEADS) * HEAD_DIM
C_QKV = 3 * C_HEADS * HEAD_DIM

kernel_name = "hybrid_swa_dilated_moba_peer_deepnorm"


def alibi_slopes(n):
    return jnp.exp2(-8.0 * jnp.arange(1, n + 1, dtype=jnp.float32) / n)


def layer_norm(x, g, b):
    xf = x.astype(jnp.float32)
    mu = xf.mean(-1, keepdims=True)
    var = jnp.mean(jnp.square(xf - mu), -1, keepdims=True)
    return ((xf - mu) * lax.rsqrt(var + LN_EPS) * g.astype(jnp.float32) + b.astype(jnp.float32)).astype(x.dtype)


def banded_attention(q, k, v, slopes, max_dist, dist_scale, sinks=None):
    n, s, hk, g, dh = q.shape
    nb = s // BAND_BLOCK
    qb = q.reshape(n, nb, BAND_BLOCK, hk, g, dh)

    def with_prev(t):
        tb = t.reshape(n, nb, BAND_BLOCK, hk, dh)
        prev = jnp.pad(tb, ((0, 0), (1, 0), (0, 0), (0, 0), (0, 0)))[:, :-1]
        return jnp.concatenate([prev, tb], axis=2)

    kb, vb = with_prev(k), with_prev(v)
    scores = jnp.einsum('nbqhgd,nbkhd->nbhgqk', qb, kb).astype(jnp.float32) * (dh ** -0.5)
    dist = (jnp.arange(BAND_BLOCK)[:, None] + BAND_BLOCK) - jnp.arange(2 * BAND_BLOCK)[None, :]
    valid = (dist >= 0) & (dist <= max_dist)
    first = (jnp.arange(nb) == 0)[:, None, None] & (jnp.arange(2 * BAND_BLOCK) < BAND_BLOCK)[None, None, :]
    valid = valid[None] & ~first
    bias = -(slopes.reshape(hk, g)[:, :, None, None] * (dist_scale * dist.astype(jnp.float32)))
    scores = jnp.where(valid[None, :, None, None], scores + bias[None, None], -jnp.inf)
    m = scores.max(-1)
    if sinks is not None:
        sink = sinks.reshape(hk, g).astype(jnp.float32)[None, None, :, :, None]
        m = jnp.maximum(m, sink)
    e = jnp.exp(scores - m[..., None])
    denom = e.sum(-1)
    if sinks is not None:
        denom = denom + jnp.exp(sink - m)
    probs = (e / denom[..., None]).astype(v.dtype)
    o = jnp.einsum('nbhgqk,nbkhd->nbqhgd', probs, vb).reshape(n, s, hk, g, dh)
    lse = (m + jnp.log(denom)).transpose(0, 1, 4, 2, 3).reshape(n, s, hk, g)
    return o, lse


def mixer_a(x, w_qkv, sinks, w_o):
    b, s, _ = x.shape
    grp = A_HEADS // A_KV_HEADS
    qkv = x @ w_qkv
    q, k, v = jnp.split(qkv, [A_HEADS * HEAD_DIM, (A_HEADS + A_KV_HEADS) * HEAD_DIM], axis=-1)
    q = q.reshape(b, s, A_KV_HEADS, grp, HEAD_DIM)
    k = k.reshape(b, s, A_KV_HEADS, HEAD_DIM)
    v = v.reshape(b, s, A_KV_HEADS, HEAD_DIM)
    o, _ = banded_attention(q, k, v, alibi_slopes(A_HEADS), A_WINDOW - 1, 1.0, sinks)
    return o.reshape(b, s, A_HEADS * HEAD_DIM) @ w_o


def dilate(t, r):
    b, sp = t.shape[:2]
    t = jnp.moveaxis(t.reshape(b, sp // r, r, *t.shape[2:]), 2, 1)
    return t.reshape(b * r, sp // r, *t.shape[3:])


def undilate(t, b, r):
    sr = t.shape[1]
    t = jnp.moveaxis(t.reshape(b, r, sr, *t.shape[2:]), 1, 2)
    return t.reshape(b, sr * r, *t.shape[3:])


def mixer_b(x, w_qkv, w_o):
    b, s, _ = x.shape
    hd = B_HEADS * HEAD_DIM
    qkv = x @ w_qkv
    qs = qkv[..., :B_GROUPS * hd].reshape(b, s, B_GROUPS, B_HEADS, HEAD_DIM)
    k = qkv[..., B_GROUPS * hd:(B_GROUPS + 1) * hd].reshape(b, s, B_HEADS, HEAD_DIM)
    v = qkv[..., (B_GROUPS + 1) * hd:].reshape(b, s, B_HEADS, HEAD_DIM)
    slopes = alibi_slopes(B_HEADS)
    outs, lses = [], []
    for gi, (w, r) in enumerate(B_PATTERNS):
        span = r * BAND_BLOCK
        sp = -(-s // span) * span
        pad = ((0, 0), (0, sp - s), (0, 0), (0, 0))
        qg = dilate(jnp.pad(qs[:, :, gi], pad), r)[:, :, :, None]
        kg = dilate(jnp.pad(k, pad), r)
        vg = dilate(jnp.pad(v, pad), r)
        o, lse = banded_attention(qg, kg, vg, slopes, w // r, float(r))
        outs.append(undilate(o[:, :, :, 0], b, r)[:, :s])
        lses.append(undilate(lse[..., 0], b, r)[:, :s])
    wts = jax.nn.softmax(jnp.stack(lses, 0), axis=0)
    o = jnp.einsum('gbsh,gbshd->bshd', wts.astype(x.dtype), jnp.stack(outs, 0))
    return o.reshape(b, s, hd) @ w_o


def mixer_c(x, w_qkv, w_o):
    b, s, _ = x.shape
    hd = C_HEADS * HEAD_DIM
    scale = HEAD_DIM ** -0.5
    sp = -(-s // C_BLOCK) * C_BLOCK
    nblk = sp // C_BLOCK
    qkv = jnp.pad(x @ w_qkv, ((0, 0), (0, sp - s), (0, 0)))
    q, k, v = jnp.split(qkv, 3, axis=-1)
    q = q.reshape(b, sp, C_HEADS, HEAD_DIM)
    kb = k.reshape(b, nblk, C_BLOCK, C_HEADS, HEAD_DIM)
    vb = v.reshape(b, nblk, C_BLOCK, C_HEADS, HEAD_DIM)
    kmean = kb.mean(axis=2)
    gate = jnp.einsum('bshd,bnhd->bhsn', q, kmean).astype(jnp.float32)
    qblk = jnp.arange(sp) // C_BLOCK
    past = jnp.arange(nblk)[None, :] < qblk[:, None]
    gate = jnp.where(past[None, None], gate, -jnp.inf)
    topk = min(C_TOPK, nblk)
    _, sel = lax.top_k(gate, topk)
    sel_valid = jnp.arange(topk)[None, :] < qblk[:, None]
    kbh = kb.transpose(0, 3, 1, 2, 4)
    vbh = vb.transpose(0, 3, 1, 2, 4)
    slopes = alibi_slopes(C_HEADS)
    bi = jnp.arange(b)[:, None, None, None]
    hi = jnp.arange(C_HEADS)[None, :, None, None]

    def attend_chunk(c):
        t0 = c * C_QCHUNK
        qc = lax.dynamic_slice_in_dim(q, t0, C_QCHUNK, axis=1)
        selc = lax.dynamic_slice_in_dim(sel, t0, C_QCHUNK, axis=2)
        validc = lax.dynamic_slice_in_dim(sel_valid, t0, C_QCHUNK, axis=0)
        ob = t0 // C_BLOCK
        k_own = lax.dynamic_index_in_dim(kb, ob, axis=1, keepdims=False)
        v_own = lax.dynamic_index_in_dim(vb, ob, axis=1, keepdims=False)
        kg = kbh[bi, hi, selc]
        vg = vbh[bi, hi, selc]
        tq = t0 + jnp.arange(C_QCHUNK)
        s_sel = jnp.einsum('bqhd,bhqkjd->bhqkj', qc, kg).astype(jnp.float32) * scale
        pos_sel = selc[..., None] * C_BLOCK + jnp.arange(C_BLOCK)
        d_sel = (tq[:, None, None] - pos_sel).astype(jnp.float32)
        s_sel = jnp.where(validc[None, None, :, :, None], s_sel - slopes[:, None, None, None] * d_sel, -jnp.inf)
        s_own = jnp.einsum('bqhd,bjhd->bhqj', qc, k_own).astype(jnp.float32) * scale
        d_own = tq[:, None] - (ob * C_BLOCK + jnp.arange(C_BLOCK))[None, :]
        s_own = jnp.where((d_own >= 0)[None, None], s_own - slopes[:, None, None] * d_own.astype(jnp.float32), -jnp.inf)
        scores = jnp.concatenate([s_sel.reshape(b, C_HEADS, C_QCHUNK, topk * C_BLOCK), s_own], axis=-1)
        probs = jax.nn.softmax(scores, axis=-1).astype(v.dtype)
        p_sel = probs[..., :topk * C_BLOCK].reshape(b, C_HEADS, C_QCHUNK, topk, C_BLOCK)
        p_own = probs[..., topk * C_BLOCK:]
        return (jnp.einsum('bhqkj,bhqkjd->bqhd', p_sel, vg)
                + jnp.einsum('bhqj,bjhd->bqhd', p_own, v_own))

    o = lax.map(attend_chunk, jnp.arange(sp // C_QCHUNK))
    o = jnp.moveaxis(o, 0, 1).reshape(b, sp, hd)[:, :s]
    return o @ w_o


def peer(x, w_q, subkeys, u, v):
    b, s, d = x.shape
    n_tok = b * s
    t = x.reshape(n_tok, d)
    q = (t @ w_q).astype(jnp.float32).reshape(n_tok, PEER_HEADS, 2, PEER_DKEY // 2)
    sc = jnp.einsum('thcd,ckd->thck', q, subkeys.astype(jnp.float32))
    v1, i1 = lax.top_k(sc[:, :, 0], PEER_TOPK)
    v2, i2 = lax.top_k(sc[:, :, 1], PEER_TOPK)
    cand = (v1[..., :, None] + v2[..., None, :]).reshape(n_tok, PEER_HEADS, PEER_TOPK * PEER_TOPK)
    cidx = (i1[..., :, None] * PEER_NKEYS + i2[..., None, :]).reshape(n_tok, PEER_HEADS, PEER_TOPK * PEER_TOPK)
    best, pos = lax.top_k(cand, PEER_TOPK)
    experts = jnp.take_along_axis(cidx, pos, axis=-1).reshape(n_tok, PEER_HEADS * PEER_TOPK)
    gates = jax.nn.softmax(best, axis=-1).reshape(n_tok, PEER_HEADS * PEER_TOPK)

    def chunk(c):
        t0 = c * PEER_CHUNK
        xc = lax.dynamic_slice_in_dim(t, t0, PEER_CHUNK, axis=0)
        ec = lax.dynamic_slice_in_dim(experts, t0, PEER_CHUNK, axis=0)
        gc = lax.dynamic_slice_in_dim(gates, t0, PEER_CHUNK, axis=0)
        h = jnp.einsum('cd,ced->ce', xc, u[ec])
        a = (jax.nn.gelu(h.astype(jnp.float32), approximate=False) * gc).astype(x.dtype)
        return jnp.einsum('ce,ced->cd', a, v[ec])

    return lax.map(chunk, jnp.arange(n_tok // PEER_CHUNK)).reshape(b, s, d)


def per_layer_embedding(x, p_i, w_p, w_g, b_g):
    gate = jax.nn.sigmoid((x @ w_g + b_g).astype(jnp.float32)).astype(x.dtype)
    return x + gate * (p_i @ w_p)


def setup_inputs(seed: int = 0) -> dict:
    key = jax.random.key(seed)
    ks = jax.random.split(key, 20)
    f32 = jnp.float32
    d = D_MODEL

    def nrm(k, shape, scale):
        return jax.random.normal(k, shape, f32) * scale

    def value_scaled(w, v_start):
        col = jnp.where(jnp.arange(w.shape[-1]) >= v_start, DEEPNORM_BETA, 1.0).astype(f32)
        return w * col

    hd = B_HEADS * HEAD_DIM
    return {
        "x": nrm(ks[0], (BATCH, SEQ, d), 1.0),
        "p": nrm(ks[1], (DEPTH, BATCH, SEQ, PLE_DIM), 1.0),
        "a_w_qkv": value_scaled(nrm(ks[2], (N_LAYERS_A, d, A_QKV), d ** -0.5), (A_HEADS + A_KV_HEADS) * HEAD_DIM),
        "a_sinks": nrm(ks[3], (N_LAYERS_A, A_HEADS), 0.5),
        "a_w_o": nrm(ks[4], (N_LAYERS_A, A_HEADS * HEAD_DIM, d), DEEPNORM_BETA * (A_HEADS * HEAD_DIM) ** -0.5),
        "b_w_qkv": value_scaled(nrm(ks[5], (N_LAYERS_B, d, B_QKV), d ** -0.5), (B_GROUPS + 1) * hd),
        "b_w_o": nrm(ks[6], (N_LAYERS_B, hd, d), DEEPNORM_BETA * hd ** -0.5),
        "c_w_qkv": value_scaled(nrm(ks[7], (N_LAYERS_C, d, C_QKV), d ** -0.5), 2 * C_HEADS * HEAD_DIM),
        "c_w_o": nrm(ks[8], (N_LAYERS_C, C_HEADS * HEAD_DIM, d), DEEPNORM_BETA * (C_HEADS * HEAD_DIM) ** -0.5),
        "ln1_g": 1.0 + nrm(ks[9], (DEPTH, d), 0.02),
        "ln1_b": nrm(ks[10], (DEPTH, d), 0.02),
        "ln2_g": 1.0 + nrm(ks[11], (DEPTH, d), 0.02),
        "ln2_b": nrm(ks[12], (DEPTH, d), 0.02),
        "peer_w_q": nrm(ks[13], (DEPTH, d, PEER_HEADS * PEER_DKEY), d ** -0.5),
        "peer_subkeys": nrm(ks[14], (DEPTH, 2, PEER_NKEYS, PEER_DKEY // 2), (PEER_DKEY // 2) ** -0.5),
        "peer_u": nrm(ks[15], (DEPTH, PEER_EXPERTS, d), d ** -0.5),
        "peer_v": nrm(ks[16], (DEPTH, PEER_EXPERTS, d), DEEPNORM_BETA * PEER_HEADS ** -0.5),
        "ple_w": nrm(ks[17], (DEPTH, PLE_DIM, d), PLE_DIM ** -0.5),
        "ple_gate_w": nrm(ks[18], (DEPTH, d, d), d ** -0.5),
        "ple_gate_b": nrm(ks[19], (DEPTH, d), 0.02),
    }


def reference(x, p, a_w_qkv, a_sinks, a_w_o, b_w_qkv, b_w_o, c_w_qkv, c_w_o,
              ln1_g, ln1_b, ln2_g, ln2_b, peer_w_q, peer_subkeys, peer_u, peer_v,
              ple_w, ple_gate_w, ple_gate_b):
    for i in range(DEPTH):
        kind, j = i % N_MIXERS, i // N_MIXERS
        if kind == 0:
            y = mixer_a(x, a_w_qkv[j], a_sinks[j], a_w_o[j])
        elif kind == 1:
            y = mixer_b(x, b_w_qkv[j], b_w_o[j])
        else:
            y = mixer_c(x, c_w_qkv[j], c_w_o[j])
        x = layer_norm(DEEPNORM_ALPHA * x + y, ln1_g[i], ln1_b[i])
        y = peer(x, peer_w_q[i], peer_subkeys[i], peer_u[i], peer_v[i])
        x = layer_norm(DEEPNORM_ALPHA * x + y, ln2_g[i], ln2_b[i])
        x = per_layer_embedding(x, p[i], ple_w[i], ple_gate_w[i], ple_gate_b[i])
    return x
```

```cpp
#include <hip/hip_runtime.h>
#include <hip/hip_cooperative_groups.h>
#include <cstdio>
#include <cstdint>
namespace cg = cooperative_groups;
namespace pg8 {
#define PG8_LAS __attribute__((address_space(3)))
typedef unsigned short bf16_t;
typedef short bf16x8 __attribute__((ext_vector_type(8)));
typedef float f32x4 __attribute__((ext_vector_type(4)));
typedef unsigned u32x4 __attribute__((ext_vector_type(4)));
constexpr int BM = 256, BK = 64, HALF = 128, HTB = HALF * BK * 2  , STAGE_BYTES = 8 * HTB, NXCD = 8, WGM = 8;

__host__ __device__ __forceinline__ int lds_byte(int r, int c) { const int st = (r >> 4) * 2 + (c >> 5), rr = r & 15, cc = c & 31, ob = rr * 64 + cc * 2; return st * 1024 + (ob ^ (((ob >> 9) & 1) << 5)); }
__host__ __device__ __forceinline__ void stage_rc(int b, int& R, int& C) { const int st = b / 1024, sb = b % 1024, swz = sb ^ (((sb >> 9) & 1) << 5); R = (st >> 1) * 16 + swz / 64; C = (st & 1) * 32 + (swz % 64) / 2; }
__host__ __device__ __forceinline__ int perm32(int rho) { const int n = rho >> 4, i = rho & 15; return 8 * (i >> 2) + 4 * n + (i & 3); }

struct Unit { int pm, pn; };
struct Gemm { const bf16_t* A; const bf16_t* Bt; int M, N, K; };

struct StaticOrder {
    int nM, nN, nwg, G, c;
    __host__ __device__ void init(int M, int N, int G_, int c_) { nM = M / BM; nN = N / BM; nwg = nM * nN; G = G_; c = c_; }
    __host__ __device__ bool next(int i, Unit& u) const {
        const long L = (long)i * G + c; if (L >= nwg) return false;
        int wgid = (int)L; { const int q = nwg / NXCD, r = nwg % NXCD, xcd = wgid % NXCD, off = wgid / NXCD; wgid = (xcd < r ? xcd * (q + 1) : r * (q + 1) + (xcd - r) * q) + off; }
        const int nig = WGM * nN, gid = wgid / nig, fm = gid * WGM, gsz = (nM - fm) < WGM ? (nM - fm) : WGM;
        u.pm = fm + ((wgid % nig) % gsz); u.pn = (wgid % nig) / gsz; return true;
    }
    __device__ __forceinline__ void a_ready(const Unit&) const {}
    __device__ __forceinline__ void done(const Unit&) const {}
};

__device__ __forceinline__ unsigned cvt_pk_bf16(float lo, float hi) { unsigned r; asm volatile("v_cvt_pk_bf16_f32 %0, %1, %2" : "=v"(r) : "v"(lo), "v"(hi)); return r; }
typedef float f32x2 __attribute__((ext_vector_type(2)));
__device__ __forceinline__ f32x2 gelu_pk(f32x2 v) {
    const f32x2 av = __builtin_elementwise_abs(v), d = av * 0.2316418882f + 1.0f;
    f32x2 t; t.x = __builtin_amdgcn_rcpf(d.x); t.y = __builtin_amdgcn_rcpf(d.y);
    f32x2 q = t * 0.5307027145f + (-0.7265760135f); q = q * t + 0.7107068705f; q = q * t + (-0.142248368f); q = q * t + 0.127414796f; q = q * t;
    const f32x2 s = (v * v) * (-0.72134752044f);
    f32x2 e; e.x = __builtin_amdgcn_exp2f(s.x); e.y = __builtin_amdgcn_exp2f(s.y);
    const f32x2 m = v * (q * e), r = v - m;
    f32x2 o; o.x = v.x < 0.f ? m.x : r.x; o.y = v.y < 0.f ? m.y : r.y; return o;
}

template <int ACT  > struct EpiBf16 {
    static constexpr bool PERM = true, AFTER_DRAIN = false; static_assert(ACT == 0 || ACT == 1, "EpiBf16: ACT is 0 (none) or 1 (gelu_pk)");
    bf16_t* O; int ldc; const float* bias; int split_cols; size_t split_stride; float scale0;
    __device__ __forceinline__ void operator()(const f32x4 (&acc)[2][2][4][2], const Unit& u, int wr, int wc, int fr, int fq) const {
        const int row0 = u.pm * BM + wr * 64 + fr; int colt = u.pn * BM; bf16_t* base = O;
        float sc = 1.f; if (split_cols) { const int t = colt / split_cols; base += (size_t)t * split_stride; colt -= t * split_cols; if (t == 0) sc = scale0; }
        const int col0 = colt + wc * 32 + 8 * fq, bcol0 = u.pn * BM + wc * 32 + 8 * fq;
        f32x4 bv[2][2];
#pragma unroll
        for (int bj = 0; bj < 2; ++bj)
#pragma unroll
            for (int n = 0; n < 2; ++n) bv[bj][n] = bias ? *(const f32x4*)(bias + bcol0 + bj * HALF + 4 * n) : (f32x4){0.f, 0.f, 0.f, 0.f};
#pragma unroll
        for (int ai = 0; ai < 2; ++ai)
#pragma unroll
            for (int m = 0; m < 4; ++m) { bf16_t* rowp = base + (size_t)(row0 + ai * HALF + m * 16) * ldc + col0;
#pragma unroll
                for (int bj = 0; bj < 2; ++bj) { f32x4 v0 = acc[ai][bj][m][0] + bv[bj][0], v1 = acc[ai][bj][m][1] + bv[bj][1];
                    if (ACT == 1) { f32x2 a = gelu_pk((f32x2){v0[0], v0[1]}), b = gelu_pk((f32x2){v0[2], v0[3]}), c = gelu_pk((f32x2){v1[0], v1[1]}), d = gelu_pk((f32x2){v1[2], v1[3]});
                        v0 = (f32x4){a.x, a.y, b.x, b.y}; v1 = (f32x4){c.x, c.y, d.x, d.y}; }
                    v0 = v0 * sc; v1 = v1 * sc; u32x4 w; w.x = cvt_pk_bf16(v0[0], v0[1]); w.y = cvt_pk_bf16(v0[2], v0[3]); w.z = cvt_pk_bf16(v1[0], v1[1]); w.w = cvt_pk_bf16(v1[2], v1[3]);
                    *(u32x4*)(rowp + bj * HALF) = w; } }
    }
};
typedef unsigned u32x2e __attribute__((ext_vector_type(2)));
struct EpiF32 {
    static constexpr bool PERM = false, AFTER_DRAIN = false;
    float* O; int ldc;
    __device__ __forceinline__ void operator()(const f32x4 (&acc)[2][2][4][2], const Unit& u, int wr, int wc, int fr, int fq) const {
        const int col0 = u.pn * BM + wc * 32 + 4 * fq;
#pragma unroll
        for (int ai = 0; ai < 2; ++ai)
#pragma unroll
            for (int m = 0; m < 4; ++m) { const size_t off = (size_t)(u.pm * BM + ai * HALF + wr * 64 + m * 16 + fr) * ldc + col0;
#pragma unroll
                for (int bj = 0; bj < 2; ++bj)
#pragma unroll
                    for (int n = 0; n < 2; ++n) *(f32x4*)(O + off + bj * HALF + n * 16) = acc[ai][bj][m][n]; }
    }
};
struct EpiResid {
    static constexpr bool PERM = false, AFTER_DRAIN = false;
    const float* X; float* Z; int ldc; float alpha;
    __device__ __forceinline__ void operator()(const f32x4 (&acc)[2][2][4][2], const Unit& u, int wr, int wc, int fr, int fq) const {
        const int col0 = u.pn * BM + wc * 32 + 4 * fq;
#pragma unroll
        for (int ai = 0; ai < 2; ++ai)
#pragma unroll
            for (int m = 0; m < 4; ++m) { const size_t off = (size_t)(u.pm * BM + ai * HALF + wr * 64 + m * 16 + fr) * ldc + col0;
#pragma unroll
                for (int bj = 0; bj < 2; ++bj)
#pragma unroll
                    for (int n = 0; n < 2; ++n) { const f32x4 xv = *(const f32x4*)(X + off + bj * HALF + n * 16); *(f32x4*)(Z + off + bj * HALF + n * 16) = xv * alpha + acc[ai][bj][m][n]; } }
    }
};
struct EpiPle {
    static constexpr bool PERM = false, AFTER_DRAIN = false;
    const float* X2; const float* PW; const float* bg; float* OUT; bf16_t* OUTB; int ldc;
    __device__ __forceinline__ void operator()(const f32x4 (&acc)[2][2][4][2], const Unit& u, int wr, int wc, int fr, int fq) const {
        const int col0 = u.pn * BM + wc * 32 + 4 * fq;
#pragma unroll
        for (int ai = 0; ai < 2; ++ai)
#pragma unroll
            for (int m = 0; m < 4; ++m) { const size_t off = (size_t)(u.pm * BM + ai * HALF + wr * 64 + m * 16 + fr) * ldc + col0;
#pragma unroll
                for (int bj = 0; bj < 2; ++bj)
#pragma unroll
                    for (int n = 0; n < 2; ++n) { const int co = bj * HALF + n * 16;
                        const f32x4 xv = *(const f32x4*)(X2 + off + co), pw = *(const f32x4*)(PW + off + co), bv = *(const f32x4*)(bg + col0 + co);
                        const f32x4 a = acc[ai][bj][m][n] + bv; f32x4 o;
#pragma unroll
                        for (int e = 0; e < 4; ++e) { const float sg = 1.0f / (1.0f + __expf(-a[e])); o[e] = xv[e] + sg * pw[e]; }
                        *(f32x4*)(OUT + off + co) = o;
                        u32x2e w; w.x = cvt_pk_bf16(o[0], o[1]); w.y = cvt_pk_bf16(o[2], o[3]); *(u32x2e*)(OUTB + off + co) = w; } }
    }
};
template <class Epi, class Sched, bool ALIGN_EPI = false, bool SP2 = false>
__device__ __forceinline__ void gemm_phase(PG8_LAS unsigned char* lds, const Gemm g, const Sched& S, const Epi& E) {
    int tid_ = threadIdx.x; asm volatile("" : "+v"(tid_));
    const int tid = tid_, wid = __builtin_amdgcn_readfirstlane(tid >> 6), lane = tid & 63, wr = wid >> 2, wc = wid & 3, fr = lane & 15, fq = lane >> 4;
    const int K = g.K, nt = K / BK;
    unsigned voffA[2], voffB[2];
#pragma unroll
    for (int i = 0; i < 2; ++i) { int R, C; stage_rc(tid * 16 + i * 8192, R, C); const int Rb = Epi::PERM ? ((R & ~31) + perm32(R & 31)) : R;
        voffA[i] = (unsigned)(R * K + C) * 2u; voffB[i] = (unsigned)(Rb * K + C) * 2u; }
    const size_t kstep = (size_t)(BK * 2);
    const size_t hstep = (size_t)HALF * K * 2;
    const size_t tstep = 2 * hstep;
    const unsigned ldsw = (unsigned)wid * 1024u;
    const int aoff = lds_byte(wr * 64 + fr, fq * 8), boff = lds_byte(wc * 32 + fr, fq * 8);
#define PG8_SA(b, h) (((b) * 2 + (h)) * HTB)
#define PG8_SB(b, h) ((4 + (b) * 2 + (h)) * HTB)
#define PG8_STAGE(bufoff, gbase, voff) do { _Pragma("unroll") for (int _i = 0; _i < 2; ++_i) \
        __builtin_amdgcn_global_load_lds((const unsigned*)((const char*)(gbase) + (voff)[_i]), (PG8_LAS unsigned*)(lds + (bufoff) + ldsw + _i * 8192), 16, 0, 0); } while (0)
#define PG8_LDA(dst, b, h) do { _Pragma("unroll") for (int m = 0; m < 4; ++m) _Pragma("unroll") for (int k = 0; k < 2; ++k) dst[m][k] = *(const PG8_LAS bf16x8*)(lds + PG8_SA(b, h) + aoff + m * 2048 + k * 1024); } while (0)
#define PG8_LDB(dst, b, h) do { _Pragma("unroll") for (int n = 0; n < 2; ++n) _Pragma("unroll") for (int k = 0; k < 2; ++k) dst[n][k] = *(const PG8_LAS bf16x8*)(lds + PG8_SB(b, h) + boff + n * 2048 + k * 1024); } while (0)
#define PG8_MMA(ai, bj, At, Bt) do { __builtin_amdgcn_s_setprio(1); _Pragma("unroll") for (int m = 0; m < 4; ++m) _Pragma("unroll") for (int n = 0; n < 2; ++n) _Pragma("unroll") for (int k = 0; k < 2; ++k) \
        acc[ai][bj][m][n] = __builtin_amdgcn_mfma_f32_16x16x32_bf16(Bt[n][k], At[m][k], acc[ai][bj][m][n], 0, 0, 0); __builtin_amdgcn_s_setprio(0); } while (0)
#define PG8_WAIT_V(n) asm volatile("s_waitcnt vmcnt(" #n ")" ::: "memory")
#define PG8_WAIT_L(n) asm volatile("s_waitcnt lgkmcnt(" #n ")" ::: "memory")
#define PG8_BAR __builtin_amdgcn_s_barrier()
#define PG8_SCHED __builtin_amdgcn_sched_barrier(0)
    Unit cur, nxt; int ui = 0;
    if (!S.next(0, cur)) return;
    f32x4 acc[2][2][4][2];
#pragma unroll
    for (int a = 0; a < 2; ++a)
#pragma unroll
        for (int b = 0; b < 2; ++b)
#pragma unroll
            for (int m = 0; m < 4; ++m)
#pragma unroll
                for (int n = 0; n < 2; ++n) acc[a][b][m][n] = (f32x4){0.f, 0.f, 0.f, 0.f};
    bf16x8 At[4][2], B0[2][2], B1[2][2];
    const char* cA = (const char*)g.A + (size_t)cur.pm * tstep; const char* cB = (const char*)g.Bt + (size_t)cur.pn * tstep;
    S.a_ready(cur);
    if constexpr (SP2) {
        PG8_STAGE(PG8_SB(0, 0), cB, voffB); PG8_STAGE(PG8_SB(0, 1), cB + hstep, voffB); PG8_STAGE(PG8_SA(0, 0), cA, voffA); PG8_STAGE(PG8_SA(0, 1), cA + hstep, voffA);
        if (wr == 1) PG8_BAR;
        PG8_WAIT_V(2); PG8_BAR;
        PG8_STAGE(PG8_SB(1, 0), cB + kstep, voffB); PG8_STAGE(PG8_SA(1, 0), cA + kstep, voffA); PG8_STAGE(PG8_SB(1, 1), cB + hstep + kstep, voffB);
        PG8_WAIT_V(6); PG8_BAR;
    } else {
        PG8_STAGE(PG8_SB(0, 0), cB, voffB); PG8_STAGE(PG8_SA(0, 0), cA, voffA); PG8_STAGE(PG8_SB(0, 1), cB + hstep, voffB); PG8_STAGE(PG8_SA(0, 1), cA + hstep, voffA);
        if (wr == 1) PG8_BAR;
        PG8_WAIT_V(4); PG8_BAR;
        PG8_STAGE(PG8_SB(1, 0), cB + kstep, voffB); PG8_STAGE(PG8_SA(1, 0), cA + kstep, voffA); PG8_STAGE(PG8_SB(1, 1), cB + hstep + kstep, voffB);
        PG8_WAIT_V(6); PG8_BAR;
    }
    for (;;) {
        const bool has_next = S.next(ui + 1, nxt);
        const char* nA = has_next ? (const char*)g.A + (size_t)nxt.pm * tstep : cA; const char* nB = has_next ? (const char*)g.Bt + (size_t)nxt.pn * tstep : cB;
        for (int t = 0; t < nt; t += 2) {
            const bool last = (t == nt - 2);
            const char* a1 = cA + (size_t)(t + 1) * kstep;
            const char* a2 = last ? nA : cA + (size_t)(t + 2) * kstep; const char* b2 = last ? nB : cB + (size_t)(t + 2) * kstep;
            const char* a3 = a2 + kstep; const char* b3 = b2 + kstep;
            if (last && has_next) S.a_ready(nxt);
            if constexpr (SP2) {
            PG8_LDB(B0, 0, 0); PG8_LDB(B1, 0, 1); PG8_SCHED; PG8_LDA(At, 0, 0); PG8_STAGE(PG8_SA(1, 1), a1 + hstep, voffA);
            PG8_WAIT_V(8); PG8_WAIT_L(0); PG8_BAR; PG8_MMA(0, 0, At, B0); PG8_MMA(0, 1, At, B1); PG8_BAR; PG8_SCHED;
            PG8_LDA(At, 0, 1); PG8_STAGE(PG8_SB(0, 0), b2, voffB); PG8_STAGE(PG8_SB(0, 1), b2 + hstep, voffB); PG8_STAGE(PG8_SA(0, 0), a2, voffA);
            PG8_WAIT_V(8); PG8_WAIT_L(0); PG8_BAR; PG8_MMA(1, 0, At, B0); PG8_MMA(1, 1, At, B1); PG8_BAR; PG8_SCHED;
            PG8_LDB(B0, 1, 0); PG8_LDB(B1, 1, 1); PG8_SCHED; PG8_LDA(At, 1, 0); PG8_STAGE(PG8_SA(0, 1), a2 + hstep, voffA);
            PG8_WAIT_V(8); PG8_WAIT_L(0); PG8_BAR; PG8_MMA(0, 0, At, B0); PG8_MMA(0, 1, At, B1); PG8_BAR; PG8_SCHED;
            PG8_LDA(At, 1, 1); PG8_STAGE(PG8_SB(1, 0), b3, voffB); PG8_STAGE(PG8_SB(1, 1), b3 + hstep, voffB); PG8_STAGE(PG8_SA(1, 0), a3, voffA);
            PG8_WAIT_V(8); PG8_WAIT_L(0); PG8_BAR; PG8_MMA(1, 0, At, B0); PG8_MMA(1, 1, At, B1); PG8_BAR; PG8_SCHED;
            } else {
            PG8_LDB(B0, 0, 0); PG8_SCHED; PG8_LDA(At, 0, 0); PG8_STAGE(PG8_SA(1, 1), a1 + hstep, voffA);
            PG8_WAIT_L(8); PG8_BAR; PG8_WAIT_L(0); PG8_MMA(0, 0, At, B0); PG8_BAR; PG8_SCHED;
            PG8_LDB(B1, 0, 1); PG8_STAGE(PG8_SB(0, 0), b2, voffB);
            PG8_BAR; PG8_WAIT_L(0); PG8_MMA(0, 1, At, B1); PG8_BAR;
            PG8_LDA(At, 0, 1); PG8_STAGE(PG8_SA(0, 0), a2, voffA);
            PG8_BAR; PG8_WAIT_L(0); PG8_MMA(1, 0, At, B0); PG8_BAR; PG8_SCHED;
            PG8_STAGE(PG8_SB(0, 1), b2 + hstep, voffB);
            PG8_WAIT_V(6); PG8_BAR; PG8_MMA(1, 1, At, B1); PG8_BAR;
            PG8_LDB(B0, 1, 0); PG8_SCHED; PG8_LDA(At, 1, 0); PG8_STAGE(PG8_SA(0, 1), a2 + hstep, voffA);
            PG8_WAIT_L(8); PG8_BAR; PG8_WAIT_L(0); PG8_MMA(0, 0, At, B0); PG8_BAR; PG8_SCHED;
            PG8_LDB(B1, 1, 1); PG8_STAGE(PG8_SB(1, 0), b3, voffB);
            PG8_BAR; PG8_WAIT_L(0); PG8_MMA(0, 1, At, B1); PG8_BAR;
            PG8_LDA(At, 1, 1); PG8_STAGE(PG8_SA(1, 0), a3, voffA);
            PG8_BAR; PG8_WAIT_L(0); PG8_MMA(1, 0, At, B0); PG8_BAR; PG8_SCHED;
            PG8_STAGE(PG8_SB(1, 1), b3 + hstep, voffB);
            PG8_WAIT_V(6); PG8_BAR; PG8_MMA(1, 1, At, B1); PG8_BAR;
            }
        }
        if constexpr (ALIGN_EPI) { if (wr == 0) PG8_BAR; }
        if constexpr (!Epi::AFTER_DRAIN) { E(acc, cur, wr, wc, fr, fq); S.done(cur); }
        if (!has_next) break;
#pragma unroll
        for (int a = 0; a < 2; ++a)
#pragma unroll
            for (int b = 0; b < 2; ++b)
#pragma unroll
                for (int m = 0; m < 4; ++m)
#pragma unroll
                    for (int n = 0; n < 2; ++n) acc[a][b][m][n] = (f32x4){0.f, 0.f, 0.f, 0.f};
        cur = nxt; cA = nA; cB = nB; ++ui;
        if constexpr (ALIGN_EPI) { if (wr == 1) PG8_BAR; }
    }
    PG8_WAIT_V(0);
    if constexpr (!ALIGN_EPI) { if (wr == 0) PG8_BAR; }
    PG8_BAR;
    if constexpr (Epi::AFTER_DRAIN) { E.fused(acc, cur, wr, wc, fr, fq, lds, wid, lane); S.done(cur); }
#undef PG8_SA
#undef PG8_SB
#undef PG8_STAGE
#undef PG8_LDA
#undef PG8_LDB
#undef PG8_MMA
#undef PG8_WAIT_V
#undef PG8_WAIT_L
#undef PG8_BAR
#undef PG8_SCHED
}
}
#ifndef PG8_SP2
#define PG8_SP2 true
#endif
#ifndef PG8_ALIGN
#define PG8_ALIGN true
#endif
constexpr int S = 16384, D = 1024, DEPTH = 4, NW = 8, NTHR = 512;
constexpr int PEER_E = 16384;
constexpr float LN_EPS = 1e-5f;
constexpr float DN_ALPHA = 1.681792830507429f;
constexpr float LOG2E = 1.4426950408889634f, LN2F = 0.6931471805599453f;
constexpr size_t MiB = 1u << 20;
constexpr size_t WS_CTL = 0;
constexpr size_t WS_WQKV_A = 1 * MiB;
constexpr size_t WS_WO_A = WS_WQKV_A + 5 * MiB;
constexpr size_t WS_WQKV_B = WS_WO_A + 4 * MiB;
constexpr size_t WS_WO_B = WS_WQKV_B + 10 * MiB;
constexpr size_t WS_WQKV_C = WS_WO_B + 2 * MiB;
constexpr size_t WS_WO_C = WS_WQKV_C + 6 * MiB;
constexpr size_t WS_WEFF = WS_WO_C + 2 * MiB;
constexpr size_t WS_PLEW = WS_WEFF + 16 * MiB;
constexpr size_t WS_PLEG = WS_PLEW + 2 * MiB;
constexpr size_t WS_KMEAN = WS_PLEG + 8 * MiB;
constexpr size_t WS_LSE = WS_KMEAN + 1 * MiB;
constexpr size_t WS_U = 64 * MiB;
constexpr size_t WS_V = WS_U + 128 * MiB;
constexpr size_t WS_P = WS_V + 128 * MiB;
constexpr size_t WS_F0 = WS_P + 32 * MiB;
constexpr size_t WS_F1 = WS_F0 + 64 * MiB;
constexpr size_t WS_B0 = WS_F1 + 64 * MiB;
constexpr size_t WS_B1 = WS_B0 + 32 * MiB;
constexpr size_t WS_QKV = WS_B1 + 32 * MiB;
constexpr size_t WS_O = WS_QKV + 160 * MiB;
constexpr size_t WS_OG = WS_O + 32 * MiB;
constexpr size_t WS_END = WS_OG + 96 * MiB;
static_assert(WS_LSE + 4 * MiB <= WS_U, "ws map");

constexpr int LDS_BYTES = 147456;

#define GAS __attribute__((address_space(1)))
#define LAS __attribute__((address_space(3)))
typedef unsigned short bf16;
typedef unsigned v4u __attribute__((ext_vector_type(4)));
typedef unsigned v2u __attribute__((ext_vector_type(2)));
typedef float f32x4 __attribute__((ext_vector_type(4)));
typedef short bf16x8 __attribute__((ext_vector_type(8)));
typedef __bf16 bf2_t __attribute__((ext_vector_type(2)));

__device__ __forceinline__ unsigned f2bf(float f) { unsigned u = __builtin_bit_cast(unsigned, f); return (u + 0x7fffu + ((u >> 16) & 1u)) >> 16; }
__device__ __forceinline__ unsigned pk2(float lo, float hi) { return f2bf(lo) | (f2bf(hi) << 16); }
__device__ __forceinline__ float bflo(unsigned w) { return __uint_as_float(w << 16); }
__device__ __forceinline__ float bfhi(unsigned w) { return __uint_as_float(w & 0xffff0000u); }
__device__ __forceinline__ float wave_sum(float v) {
#pragma unroll
    for (int o = 1; o < 64; o <<= 1) v += __shfl_xor(v, o);
    return v;
}
#define DPPI(x, ctl) __builtin_amdgcn_update_dpp(0, (int)(x), (ctl), 0xF, 0xF, true)
__device__ __forceinline__ unsigned row_max_u32(unsigned x) {
    unsigned y;
    y = (unsigned)DPPI(x, 0xB1); x = x > y ? x : y;
    y = (unsigned)DPPI(x, 0x4E); x = x > y ? x : y;
    y = (unsigned)DPPI(x, 0x141); x = x > y ? x : y;
    y = (unsigned)DPPI(x, 0x140); x = x > y ? x : y;
    return x;
}
__device__ __forceinline__ float row_max_f32(float x) {
    x = fmaxf(x, __int_as_float(DPPI(__float_as_int(x), 0xB1)));
    x = fmaxf(x, __int_as_float(DPPI(__float_as_int(x), 0x4E)));
    x = fmaxf(x, __int_as_float(DPPI(__float_as_int(x), 0x141)));
    x = fmaxf(x, __int_as_float(DPPI(__float_as_int(x), 0x140)));
    return x;
}
__device__ __forceinline__ float row_sum_f32(float x) {
    x += __int_as_float(DPPI(__float_as_int(x), 0xB1));
    x += __int_as_float(DPPI(__float_as_int(x), 0x4E));
    x += __int_as_float(DPPI(__float_as_int(x), 0x141));
    x += __int_as_float(DPPI(__float_as_int(x), 0x140));
    return x;
}
__device__ __forceinline__ float dot16bf(v4u a0, v4u a1, v4u b0, v4u b1) {
    float acc = 0.f;
    asm volatile("s_nop 1\n\tv_dot2c_f32_bf16 %0, %1, %9\n\tv_dot2c_f32_bf16 %0, %2, %10\n\tv_dot2c_f32_bf16 %0, %3, %11\n\tv_dot2c_f32_bf16 %0, %4, %12\n\t"
                 "v_dot2c_f32_bf16 %0, %5, %13\n\tv_dot2c_f32_bf16 %0, %6, %14\n\tv_dot2c_f32_bf16 %0, %7, %15\n\tv_dot2c_f32_bf16 %0, %8, %16\n\ts_nop 2"
                 : "+v"(acc)
                 : "v"(a0.x), "v"(a0.y), "v"(a0.z), "v"(a0.w), "v"(a1.x), "v"(a1.y), "v"(a1.z), "v"(a1.w),
                   "v"(b0.x), "v"(b0.y), "v"(b0.z), "v"(b0.w), "v"(b1.x), "v"(b1.y), "v"(b1.z), "v"(b1.w));
    return acc;
}
__device__ __forceinline__ unsigned sortable(float f) { const unsigned u = __float_as_uint(f); return (u & 0x80000000u) ? ~u : (u | 0x80000000u); }

__device__ __forceinline__ void p0_transpose_item(const float* W, int K, int N, bf16* WT, LAS float* scr, int item, int lane) {
    const int nblk = N / 32, kb = item / nblk, nb = item % nblk, k0 = 64 * kb, n0 = 32 * nb;
#pragma unroll 8
    for (int i = 0; i < 32; ++i) { const int kk = 2 * i + (lane >> 5); scr[kk * 33 + (lane & 31)] = W[(size_t)(k0 + kk) * N + n0 + (lane & 31)]; }
    asm volatile("s_waitcnt lgkmcnt(0)" ::: "memory");
    const int c = lane & 7;
#pragma unroll
    for (int j = 0; j < 4; ++j) { const int n = (lane >> 3) + 8 * j; const LAS float* s = scr + (8 * c) * 33 + n;
        v4u o; o.x = pk2(s[0 * 33], s[1 * 33]); o.y = pk2(s[2 * 33], s[3 * 33]); o.z = pk2(s[4 * 33], s[5 * 33]); o.w = pk2(s[6 * 33], s[7 * 33]);
        *(v4u*)(WT + (size_t)(n0 + n) * K + k0 + 8 * c) = o; }
    asm volatile("s_waitcnt lgkmcnt(0)" ::: "memory");
}
__device__ __forceinline__ void p0_transpose(const float* W, int K, int N, bf16* WT, LAS float* scr, int gw, int NGW, int lane) {
    const int items = (K / 64) * (N / 32);
    for (int it = gw; it < items; it += NGW) p0_transpose_item(W, K, N, WT, scr, it, lane);
}
__device__ __forceinline__ void p0_convert(const float* src, bf16* dst, size_t n, size_t gtid, size_t nthr) {
    const size_t n8 = n / 8;
    for (size_t i = gtid; i < n8; i += nthr) {
        const f32x4 a = *(const f32x4*)(src + i * 8), b = *(const f32x4*)(src + i * 8 + 4);
        v4u o; o.x = pk2(a.x, a.y); o.y = pk2(a.z, a.w); o.z = pk2(b.x, b.y); o.w = pk2(b.z, b.w);
        *(v4u*)(dst + i * 8) = o;
    }
}
__device__ __forceinline__ void p0_weff(const float* wq, const float* subk, bf16* weff, LAS unsigned char* lds, int bid, int G, int tid) {
    LAS float* SK = (LAS float*)lds;
    LAS float* WQ = SK + 128 * 129;
    for (int unit = bid; unit < 256; unit += G) {
        const int i = unit >> 6, hc = (unit >> 2) & 15, kq = unit & 3, c = hc & 1;
        __syncthreads();
        const float* sk = subk + ((size_t)(i * 2 + c) * 128) * 128;
        for (int idx = tid; idx < 128 * 128; idx += NTHR) SK[(idx >> 7) * 129 + (idx & 127)] = sk[idx];
        const int k = tid & 127, kg = tid >> 7;
        for (int kt = 0; kt < 8; ++kt) {
            const int kk0 = kq * 256 + kt * 32;
            __syncthreads();
            for (int idx = tid; idx < 32 * 128; idx += NTHR) WQ[(idx >> 7) * 129 + (idx & 127)] = wq[((size_t)i * 1024 + kk0 + (idx >> 7)) * 2048 + hc * 128 + (idx & 127)];
            __syncthreads();
            float acc[8];
#pragma unroll
            for (int j = 0; j < 8; ++j) acc[j] = 0.f;
            for (int d = 0; d < 128; ++d) { const float a = SK[k * 129 + d];
#pragma unroll
                for (int j = 0; j < 8; ++j) acc[j] += a * WQ[(kg * 8 + j) * 129 + d]; }
            v4u o; o.x = pk2(acc[0], acc[1]); o.y = pk2(acc[2], acc[3]); o.z = pk2(acc[4], acc[5]); o.w = pk2(acc[6], acc[7]);
            *(v4u*)(weff + ((size_t)i * 2048 + hc * 128 + k) * 1024 + kk0 + kg * 8) = o;
        }
    }
    __syncthreads();
}

__device__ __forceinline__ void ln_row(const float* zrow, const float* g, const float* b, float* orow, bf16* obrow, int lane) {
    const f32x4* zr = (const f32x4*)zrow + lane;
    f32x4 v[4]; float s = 0.f;
#pragma unroll
    for (int j = 0; j < 4; ++j) { v[j] = zr[64 * j]; s += (v[j].x + v[j].y) + (v[j].z + v[j].w); }
    const float mean = wave_sum(s) * (1.f / D); float s2 = 0.f;
#pragma unroll
    for (int j = 0; j < 4; ++j) { v[j] = v[j] - mean; s2 += (v[j].x * v[j].x + v[j].y * v[j].y) + (v[j].z * v[j].z + v[j].w * v[j].w); }
    const float rstd = 1.f / sqrtf(wave_sum(s2) * (1.f / D) + LN_EPS);
#pragma unroll
    for (int j = 0; j < 4; ++j) { const f32x4 gg = ((const f32x4*)g + lane)[64 * j], bb = ((const f32x4*)b + lane)[64 * j];
        const f32x4 o = v[j] * rstd * gg + bb; ((f32x4*)orow + lane)[64 * j] = o;
        v2u w; w.x = pk2(o.x, o.y); w.y = pk2(o.z, o.w); ((v2u*)obrow + lane)[64 * j] = w; }
}

namespace att {
constexpr int KP = 144;
constexpr int VT_OFF = 64 * KP;
constexpr int MISC_OFF = 2 * 64 * KP;
struct Stage { v4u k, v; };
__device__ __forceinline__ Stage gload(const bf16* kb, const bf16* vb, int pitch, int tok0, int tstride, int jd0, int tid) {
    Stage s; const int row = tid >> 3, ch = tid & 7, key = tid & 63, vc = tid >> 6;
    s.k = *(const v4u*)(kb + (size_t)(tok0 + tstride * (jd0 + row)) * pitch + ch * 8);
    s.v = *(const v4u*)(vb + (size_t)(tok0 + tstride * (jd0 + key)) * pitch + vc * 8);
    return s;
}
__device__ __forceinline__ void lstore(LAS unsigned char* lds, const Stage& s, int tid) {
    const int row = tid >> 3, ch = tid & 7, key = tid & 63, vc = tid >> 6;
    *(LAS v4u*)(lds + row * KP + ch * 16) = s.k;
    LAS unsigned short* vt = (LAS unsigned short*)(lds + VT_OFF);
#pragma unroll
    for (int i = 0; i < 8; ++i) vt[(vc * 8 + i) * (KP / 2) + key] = (unsigned short)(s.v[i >> 1] >> ((i & 1) * 16));
}
__device__ __forceinline__ void qk(f32x4 (&s)[4], LAS const unsigned char* lds, const bf16x8 (&qf)[2], int fr, int g) {
#pragma unroll
    for (int mt = 0; mt < 4; ++mt) { s[mt] = (f32x4){0.f, 0.f, 0.f, 0.f};
#pragma unroll
        for (int ks = 0; ks < 2; ++ks) { const bf16x8 kf = *(const LAS bf16x8*)(lds + (mt * 16 + fr) * KP + (ks * 32 + 8 * g) * 2);
            s[mt] = __builtin_amdgcn_mfma_f32_16x16x32_bf16(kf, qf[ks], s[mt], 0, 0, 0); } }
}
__device__ __forceinline__ void tile_compute(LAS const unsigned char* lds, const bf16x8 (&qf)[2], float& m, float& l, f32x4 (&o)[4], int dist0, bool lane_ok, int maxd, float sc2, float slope2, int fr, int g) {
    f32x4 s[4];
    qk(s, lds, qf, fr, g);
    float tmax = -1e30f;
#pragma unroll
    for (int mt = 0; mt < 4; ++mt)
#pragma unroll
        for (int r = 0; r < 4; ++r) { const int d = dist0 - mt * 16 - r; const bool valid = lane_ok && d >= 0 && d <= maxd;
            const float val = valid ? (s[mt][r] * sc2 - slope2 * (float)d) : -1e30f; s[mt][r] = val; tmax = fmaxf(tmax, val); }
    tmax = fmaxf(tmax, __shfl_xor(tmax, 16)); tmax = fmaxf(tmax, __shfl_xor(tmax, 32));
    const float mnew = fmaxf(m, tmax), alpha = exp2f(m - mnew);
    float psum = 0.f;
#pragma unroll
    for (int mt = 0; mt < 4; ++mt)
#pragma unroll
        for (int r = 0; r < 4; ++r) { const float p = (s[mt][r] > -1e29f) ? exp2f(s[mt][r] - mnew) : 0.f; psum += p; s[mt][r] = p; }
    l = l * alpha + psum; m = mnew;
#pragma unroll
    for (int dt = 0; dt < 4; ++dt) o[dt] = o[dt] * alpha;
    bf16x8 pb[2];
#pragma unroll
    for (int kk = 0; kk < 2; ++kk) { v4u w; w.x = pk2(s[2 * kk][0], s[2 * kk][1]); w.y = pk2(s[2 * kk][2], s[2 * kk][3]); w.z = pk2(s[2 * kk + 1][0], s[2 * kk + 1][1]); w.w = pk2(s[2 * kk + 1][2], s[2 * kk + 1][3]);
        pb[kk] = __builtin_bit_cast(bf16x8, w); }
#pragma unroll
    for (int dt = 0; dt < 4; ++dt)
#pragma unroll
        for (int kk = 0; kk < 2; ++kk) { LAS const unsigned char* vp = lds + VT_OFF + (dt * 16 + fr) * KP + (32 * kk + 4 * g) * 2;
            const v2u lo = *(const LAS v2u*)vp, hi = *(const LAS v2u*)(vp + 32);
            v4u w; w.x = lo.x; w.y = lo.y; w.z = hi.x; w.w = hi.y;
            o[dt] = __builtin_amdgcn_mfma_f32_16x16x32_bf16(__builtin_bit_cast(bf16x8, w), pb[kk], o[dt], 0, 0, 0); }
}
__device__ __forceinline__ void load_q(bf16x8 (&qf)[2], const bf16* qrow, int g) {
    qf[0] = *(const bf16x8*)(qrow + 8 * g); qf[1] = *(const bf16x8*)(qrow + 32 + 8 * g);
}
__device__ __forceinline__ void store_o(bf16* orow, const f32x4 (&o)[4], float scale, int g) {
#ifdef EXP_NOATT
    scale = 0.f;
#endif
#pragma unroll
    for (int dt = 0; dt < 4; ++dt) { v2u w; w.x = pk2(o[dt][0] * scale, o[dt][1] * scale); w.y = pk2(o[dt][2] * scale, o[dt][3] * scale); *(v2u*)(orow + dt * 16 + 4 * g) = w; }
}

__device__ __forceinline__ void banded_unit(LAS unsigned char* lds, const bf16* qb, const bf16* kb, const bf16* vb, int pitch, int tok0, int tstride, int idil0, int maxd, float slope2,
                                            float& m, float& l, f32x4 (&o)[4], int tid) {
    const int lane = tid & 63, w = tid >> 6, fr = lane & 15, g = lane >> 4;
    const int iq = idil0 + 16 * w + fr;
    bf16x8 qf[2]; load_q(qf, qb + (size_t)(tok0 + tstride * iq) * pitch, g);
    m = -1e30f; l = 0.f;
#pragma unroll
    for (int dt = 0; dt < 4; ++dt) o[dt] = (f32x4){0.f, 0.f, 0.f, 0.f};
    const int kt0 = idil0 >= 128 ? 0 : 2;
    Stage st = gload(kb, vb, pitch, tok0, tstride, idil0 - 128 + 64 * kt0, tid);
    for (int kt = kt0; kt < 4; ++kt) {
        const int jd0 = idil0 - 128 + 64 * kt;
        __syncthreads();
        lstore(lds, st, tid);
        __syncthreads();
        if (kt + 1 < 4) st = gload(kb, vb, pitch, tok0, tstride, jd0 + 64, tid);
        const bool poss = (jd0 <= iq) && (jd0 + 63 >= iq - maxd);
        if (__any(poss)) tile_compute(lds, qf, m, l, o, iq - jd0 - 4 * g, true, maxd, 0.125f * LOG2E, slope2, fr, g);
    }
    l += __shfl_xor(l, 16); l += __shfl_xor(l, 32);
}
}

struct Args { const float* in[20]; float* out; unsigned char* ws; };
enum { I_X = 0, I_P, I_AWQKV, I_ASINK, I_AWO, I_BWQKV, I_BWO, I_CWQKV, I_CWO, I_LN1G, I_LN1B, I_LN2G, I_LN2B, I_PWQ, I_PSUBK, I_PU, I_PV, I_PLEW, I_PLEGW, I_PLEGB, I_OUT, I_WS };
constexpr int PTAB_OFF = 131072 + 1024;
__device__ __forceinline__ unsigned long long ldp(LAS unsigned char* lds, int i) {
    volatile LAS unsigned* t = (volatile LAS unsigned*)(lds + PTAB_OFF);
    const unsigned lo = __builtin_amdgcn_readfirstlane(t[2 * i]), hi = __builtin_amdgcn_readfirstlane(t[2 * i + 1]);
    return ((unsigned long long)hi << 32) | lo;
}
#define INP(i) ((const float*)ldp(lds, (i)))
#define WSP() ((unsigned char*)ldp(lds, I_WS))
#define LAUNDER(v) asm volatile("" : "+s"(v))
struct Ctx { int tid, lane, wave, G, bid, gw, NGW; };
__device__ __forceinline__ Ctx mkctx() { Ctx c; int t_ = threadIdx.x; asm volatile("" : "+v"(t_)); c.tid = t_; c.lane = c.tid & 63; c.wave = __builtin_amdgcn_readfirstlane(c.tid >> 6); c.G = gridDim.x; c.bid = blockIdx.x; c.gw = c.bid * NW + c.wave; c.NGW = c.G * NW; return c; }

__device__ __forceinline__ void ph_prologue(LAS unsigned char* lds) {
    const Ctx c = mkctx(); unsigned char* ws = WSP();
    const size_t gtid = (size_t)c.bid * NTHR + c.tid, nthr = (size_t)c.G * NTHR;
    LAS float* scr = (LAS float*)(lds + c.wave * 16384);
    for (int j = 0; j < 2; ++j) {
        p0_transpose(INP(I_AWQKV) + (size_t)j * 1024 * 1280, 1024, 1280, (bf16*)(ws + WS_WQKV_A) + (size_t)j * 1280 * 1024, scr, c.gw, c.NGW, c.lane);
        p0_transpose(INP(I_AWO) + (size_t)j * 1024 * 1024, 1024, 1024, (bf16*)(ws + WS_WO_A) + (size_t)j * 1024 * 1024, scr, c.gw, c.NGW, c.lane);
    }
    p0_transpose(INP(I_BWQKV), 1024, 5120, (bf16*)(ws + WS_WQKV_B), scr, c.gw, c.NGW, c.lane);
    p0_transpose(INP(I_BWO), 1024, 1024, (bf16*)(ws + WS_WO_B), scr, c.gw, c.NGW, c.lane);
    p0_transpose(INP(I_CWQKV), 1024, 3072, (bf16*)(ws + WS_WQKV_C), scr, c.gw, c.NGW, c.lane);
    p0_transpose(INP(I_CWO), 1024, 1024, (bf16*)(ws + WS_WO_C), scr, c.gw, c.NGW, c.lane);
    for (int i = 0; i < DEPTH; ++i) {
        p0_transpose(INP(I_PLEW) + (size_t)i * 256 * 1024, 256, 1024, (bf16*)(ws + WS_PLEW) + (size_t)i * 1024 * 256, scr, c.gw, c.NGW, c.lane);
        p0_transpose(INP(I_PLEGW) + (size_t)i * 1024 * 1024, 1024, 1024, (bf16*)(ws + WS_PLEG) + (size_t)i * 1024 * 1024, scr, c.gw, c.NGW, c.lane);
    }
    p0_convert(INP(I_X), (bf16*)(ws + WS_B0), (size_t)S * D, gtid, nthr);
    p0_convert(INP(I_P), (bf16*)(ws + WS_P), (size_t)DEPTH * S * 256, gtid, nthr);
    p0_convert(INP(I_PU), (bf16*)(ws + WS_U), (size_t)DEPTH * PEER_E * D, gtid, nthr);
    p0_convert(INP(I_PV), (bf16*)(ws + WS_V), (size_t)DEPTH * PEER_E * D, gtid, nthr);
    p0_weff(INP(I_PWQ), INP(I_PSUBK), (bf16*)(ws + WS_WEFF), lds, c.bid, c.G, c.tid);
}
__device__ __forceinline__ bf16* bcur(unsigned char* ws, int li) { return (bf16*)(ws + ((li & 1) ? WS_B1 : WS_B0)); }
__device__ __forceinline__ bf16* both(unsigned char* ws, int li) { return (bf16*)(ws + ((li & 1) ? WS_B0 : WS_B1)); }

__device__ __forceinline__ void ph_qkv(LAS unsigned char* lds, int li) {
    unsigned char* ws = WSP(); const int kind = li % 3, lj = li / 3;
    const int NQKV = kind == 0 ? 1280 : (kind == 1 ? 5120 : 3072);
    const bf16* wqkv = kind == 0 ? (const bf16*)(ws + WS_WQKV_A) + (size_t)lj * 1280 * 1024 : (kind == 1 ? (const bf16*)(ws + WS_WQKV_B) : (const bf16*)(ws + WS_WQKV_C));
    pg8::Gemm g{bcur(ws, li), wqkv, S, NQKV, D}; pg8::StaticOrder So; So.init(S, NQKV, (int)gridDim.x, (int)blockIdx.x);
    pg8::EpiBf16<0> E{(bf16*)(ws + WS_QKV), NQKV, nullptr, 0, 0, 1.f};
    pg8::gemm_phase<pg8::EpiBf16<0>, pg8::StaticOrder, PG8_ALIGN, PG8_SP2>(lds, g, So, E);
}
__device__ __forceinline__ void ph_attn_a(LAS unsigned char* lds, int li) {
    const Ctx c = mkctx(); unsigned char* ws = WSP(); const int lj = li / 3;
    bf16* const QKV = (bf16*)(ws + WS_QKV); bf16* const Ob = (bf16*)(ws + WS_O);
    const float* sinks = INP(I_ASINK) + lj * 16;
    for (int u = c.bid; u < 16 * 128; u += c.G) {
        const int h = u >> 7, qb = u & 127, kvh = h >> 3;
        const float slope = exp2f(-0.5f * (float)(h + 1));
        float m, l; f32x4 o[4];
        att::banded_unit(lds, QKV + h * 64, QKV + 1024 + kvh * 64, QKV + 1152 + kvh * 64, 1280, 0, 1, qb * 128, 127, slope * LOG2E, m, l, o, c.tid);
        const float sk2 = sinks[h] * LOG2E, mf = fmaxf(m, sk2), lf = l * exp2f(m - mf) + exp2f(sk2 - mf);
        const int tok = qb * 128 + 16 * (c.tid >> 6) + (c.lane & 15);
        att::store_o(Ob + (size_t)tok * 1024 + h * 64, o, exp2f(m - mf) / lf, c.lane >> 4);
    }
}
__device__ __forceinline__ void ph_attn_b(LAS unsigned char* lds) {
    const Ctx c = mkctx(); unsigned char* ws = WSP();
    bf16* const QKV = (bf16*)(ws + WS_QKV); bf16* const OG = (bf16*)(ws + WS_OG); float* const LSE = (float*)(ws + WS_LSE);
    for (int u = c.bid; u < 3 * 16 * 128; u += c.G) {
        const int gi = u >> 11, h = (u >> 7) & 15, uu = u & 127;
        const int r = gi == 0 ? 1 : (gi == 1 ? 4 : 16);
        const int cc = uu % r, b = uu / r;
        const float slope = exp2f(-0.5f * (float)(h + 1));
        float m, l; f32x4 o[4];
        att::banded_unit(lds, QKV + gi * 1024 + h * 64, QKV + 3072 + h * 64, QKV + 4096 + h * 64, 5120, cc, r, b * 128, 128, slope * (float)r * LOG2E, m, l, o, c.tid);
        const int tok = cc + r * (b * 128 + 16 * (c.tid >> 6) + (c.lane & 15));
        att::store_o(OG + ((size_t)gi * S + tok) * 1024 + h * 64, o, 1.0f / l, c.lane >> 4);
        if ((c.lane >> 4) == 0) LSE[((size_t)gi * S + tok) * 16 + h] = (m + log2f(l)) * LN2F;
    }
}
__device__ __forceinline__ void ph_merge_b(LAS unsigned char* lds) {
    const Ctx c = mkctx(); unsigned char* ws = WSP();
    const bf16* OG = (const bf16*)(ws + WS_OG); const float* LSE = (const float*)(ws + WS_LSE); bf16* const Ob = (bf16*)(ws + WS_O);
    const size_t gtid = (size_t)c.bid * NTHR + c.tid, nthr = (size_t)c.G * NTHR;
    for (size_t idx = gtid; idx < (size_t)S * 16 * 8; idx += nthr) {
        const int t = (int)(idx >> 7), h = (int)(idx >> 3) & 15, cch = (int)idx & 7;
        const float l0 = LSE[((size_t)0 * S + t) * 16 + h], l1 = LSE[((size_t)1 * S + t) * 16 + h], l2 = LSE[((size_t)2 * S + t) * 16 + h];
        const float mx = fmaxf(l0, fmaxf(l1, l2)); float w0 = __expf(l0 - mx), w1 = __expf(l1 - mx), w2 = __expf(l2 - mx); const float inv = 1.0f / (w0 + w1 + w2);
        w0 *= inv; w1 *= inv; w2 *= inv;
        const size_t off = (size_t)t * 1024 + h * 64 + cch * 8;
        const v4u a = *(const v4u*)(OG + off), bq = *(const v4u*)(OG + (size_t)S * 1024 + off), cq = *(const v4u*)(OG + (size_t)2 * S * 1024 + off);
        v4u o;
#pragma unroll
        for (int e = 0; e < 4; ++e) o[e] = pk2(w0 * bflo(a[e]) + w1 * bflo(bq[e]) + w2 * bflo(cq[e]), w0 * bfhi(a[e]) + w1 * bfhi(bq[e]) + w2 * bfhi(cq[e]));
        *(v4u*)(Ob + off) = o;
    }
}
__device__ __forceinline__ void ph_kmean(LAS unsigned char* lds) {
    const Ctx c = mkctx(); unsigned char* ws = WSP();
    const bf16* QKV = (const bf16*)(ws + WS_QKV); bf16* const KMEAN = (bf16*)(ws + WS_KMEAN);
    const size_t gtid = (size_t)c.bid * NTHR + c.tid, nthr = (size_t)c.G * NTHR;
    for (size_t idx = gtid; idx < 64 * 512; idx += nthr) {
        const int blk = (int)(idx >> 9), cp = (int)idx & 511;
        const bf16* kp = QKV + (size_t)blk * 256 * 3072 + 1024 + cp * 2;
        float s0 = 0.f, s1 = 0.f;
        for (int r = 0; r < 256; ++r) { const unsigned w = *(const unsigned*)(kp + (size_t)r * 3072); s0 += bflo(w); s1 += bfhi(w); }
        *(unsigned*)(KMEAN + blk * 1024 + cp * 2) = pk2(s0 * (1.f / 256.f), s1 * (1.f / 256.f));
    }
}
__device__ __forceinline__ void ph_attn_c(LAS unsigned char* lds) {
    const Ctx c = mkctx(); unsigned char* ws = WSP();
    const bf16* QKV = (const bf16*)(ws + WS_QKV); const bf16* KMEAN = (const bf16*)(ws + WS_KMEAN); bf16* const Ob = (bf16*)(ws + WS_O);
    const int tid = c.tid, lane = c.lane, G = c.G, bid = c.bid;
    const int rounds = (2048 + G - 1) / G;
    for (int rd = 0; rd < rounds; ++rd) {
        const int L = rd * G + ((rd & 1) ? (G - 1 - bid) : bid);
        if (L >= 2048) continue;
        const int qt = 127 - (L >> 4), h = L & 15, qblk = qt >> 1, t0 = qt * 128;
        const int w = tid >> 6, fr = lane & 15, g = lane >> 4;
        const int iq = t0 + 16 * w + fr;
        const bf16* qb = QKV + h * 64; const bf16* kb = QKV + 1024 + h * 64; const bf16* vb = QKV + 2048 + h * 64;
        const float slope2 = exp2f(-0.5f * (float)(h + 1)) * LOG2E;
        bf16x8 qf[2]; att::load_q(qf, qb + (size_t)iq * 3072, g);
        unsigned long long selmask = 0ull, bunion = 0ull;
        if (qblk > 0) {
            __syncthreads();
            { const int row = tid >> 3, ch = tid & 7; *(LAS v4u*)(lds + row * att::KP + ch * 16) = *(const v4u*)(KMEAN + row * 1024 + h * 64 + ch * 8); }
            __syncthreads();
            f32x4 s[4]; att::qk(s, lds, qf, fr, g);
            const int nsel = qblk < 3 ? qblk : 3;
            for (int sr = 0; sr < nsel; ++sr) {
                float best = -INFINITY; int bi = 64;
#pragma unroll
                for (int mt = 0; mt < 4; ++mt)
#pragma unroll
                    for (int r = 0; r < 4; ++r) { const int n = mt * 16 + 4 * g + r; const bool ok = n < qblk && !((selmask >> n) & 1ull);
                        if (ok && (s[mt][r] > best || bi == 64)) { best = s[mt][r]; bi = n; } }
#pragma unroll
                for (int x = 16; x <= 32; x <<= 1) { const float ob = __shfl_xor(best, x); const int oi = __shfl_xor(bi, x);
                    if (oi < 64 && (bi == 64 || ob > best || (ob == best && oi < bi))) { best = ob; bi = oi; } }
                selmask |= 1ull << bi;
            }
            unsigned lo = (unsigned)selmask, hi = (unsigned)(selmask >> 32);
#pragma unroll
            for (int x = 1; x < 16; x <<= 1) { lo |= __shfl_xor(lo, x); hi |= __shfl_xor(hi, x); }
            LAS unsigned* wun = (LAS unsigned*)(lds + att::MISC_OFF);
            if (lane == 0) { wun[2 * w] = lo; wun[2 * w + 1] = hi; }
            __syncthreads();
            unsigned ul = 0, uh = 0;
#pragma unroll
            for (int x = 0; x < 8; ++x) { ul |= wun[2 * x]; uh |= wun[2 * x + 1]; }
            bunion = ((unsigned long long)uh << 32) | ul;
        }
        float m = -1e30f, l = 0.f; f32x4 o[4];
#pragma unroll
        for (int dt = 0; dt < 4; ++dt) o[dt] = (f32x4){0.f, 0.f, 0.f, 0.f};
        const int nown = (t0 + 128 - qblk * 256) / 64;
        unsigned long long todo = bunion;
        int kbcur = todo ? (__ffsll((long long)todo) - 1) : qblk, sub = 0;
        if (todo) todo &= todo - 1;
        att::Stage st = att::gload(kb, vb, 3072, 0, 1, kbcur * 256, tid);
        for (;;) {
            const int jd0 = kbcur * 256 + sub * 64;
            const bool own = kbcur == qblk;
            int nkb = kbcur, nsub = sub + 1; bool more = true;
            if (!own) { if (nsub == 4) { nsub = 0; if (todo) { nkb = __ffsll((long long)todo) - 1; todo &= todo - 1; } else nkb = qblk; } }
            else if (nsub == nown) more = false;
            __syncthreads();
            att::lstore(lds, st, tid);
            __syncthreads();
            if (more) st = att::gload(kb, vb, 3072, 0, 1, nkb * 256 + nsub * 64, tid);
            const bool lane_ok = own ? (jd0 <= iq) : (((selmask >> kbcur) & 1ull) != 0ull);
            if (__any(lane_ok)) att::tile_compute(lds, qf, m, l, o, iq - jd0 - 4 * g, lane_ok, 0x3fffffff, 0.125f * LOG2E, slope2, fr, g);
            if (!more) break;
            kbcur = nkb; sub = nsub;
        }
        l += __shfl_xor(l, 16); l += __shfl_xor(l, 32);
        att::store_o(Ob + (size_t)iq * 1024 + h * 64, o, 1.0f / l, g);
    }
}
__device__ __forceinline__ void ph_oproj(LAS unsigned char* lds, int li) {
    unsigned char* ws = WSP(); const int kind = li % 3, lj = li / 3;
    const bf16* wo = kind == 0 ? (const bf16*)(ws + WS_WO_A) + (size_t)lj * 1024 * 1024 : (kind == 1 ? (const bf16*)(ws + WS_WO_B) : (const bf16*)(ws + WS_WO_C));
    const float* xin = li == 0 ? INP(I_X) : (const float*)(ws + WS_F0);
    pg8::Gemm g{(const bf16*)(ws + WS_O), wo, S, D, D}; pg8::StaticOrder So; So.init(S, D, (int)gridDim.x, (int)blockIdx.x);
    pg8::EpiResid E{xin, (float*)(ws + WS_F1), D, DN_ALPHA};
    pg8::gemm_phase<pg8::EpiResid, pg8::StaticOrder, PG8_ALIGN, PG8_SP2>(lds, g, So, E);
}
__device__ __forceinline__ void ph_ln1(LAS unsigned char* lds, int li) {
    const Ctx c = mkctx(); unsigned char* ws = WSP();
    float* const F1 = (float*)(ws + WS_F1); bf16* const Bc = bcur(ws, li);
    const float* g1 = INP(I_LN1G) + li * D; const float* b1 = INP(I_LN1B) + li * D;
    for (int r = c.gw; r < S; r += c.NGW) ln_row(F1 + (size_t)r * D, g1, b1, F1 + (size_t)r * D, Bc + (size_t)r * D, c.lane);
}
__device__ __forceinline__ void ph_sc(LAS unsigned char* lds, int li) {
    unsigned char* ws = WSP();
    pg8::Gemm g{bcur(ws, li), (const bf16*)(ws + WS_WEFF) + (size_t)li * 2048 * 1024, S, 2048, D}; pg8::StaticOrder So; So.init(S, 2048, (int)gridDim.x, (int)blockIdx.x);
    pg8::EpiF32 E{(float*)(ws + WS_QKV), 2048};
    pg8::gemm_phase<pg8::EpiF32, pg8::StaticOrder, PG8_ALIGN, PG8_SP2>(lds, g, So, E);
}
__device__ __forceinline__ void ph_peer(LAS unsigned char* lds, int li) {
    const Ctx c = mkctx(); unsigned char* ws = WSP();
    const int lane = c.lane, gw = c.gw, NGW = c.NGW;
    const float* SC = (const float*)(ws + WS_QKV); float* const F0 = (float*)(ws + WS_F0); const float* F1 = (const float*)(ws + WS_F1); bf16* const Bcur = bcur(ws, li);
    const bf16* U = (const bf16*)(ws + WS_U) + (size_t)li * PEER_E * D; const bf16* V = (const bf16*)(ws + WS_V) + (size_t)li * PEER_E * D;
    const float* g2 = INP(I_LN2G) + li * D; const float* b2 = INP(I_LN2B) + li * D;
    const int seg = lane >> 4, r = lane & 15;
#pragma unroll 1
    for (int t = gw; t < S; t += NGW) {
        const float* scr = SC + (size_t)t * 2048;
        float tv[4]; int ti[4];
#pragma unroll
        for (int p = 0; p < 4; ++p) {
            const int Gp = 4 * p + seg;
            const float* b = scr + Gp * 128 + r * 8;
            const f32x4 a0 = *(const f32x4*)b, a1 = *(const f32x4*)(b + 4);
            unsigned kk[8];
#pragma unroll
            for (int j = 0; j < 4; ++j) { kk[j] = (sortable(a0[j]) & ~127u) | (unsigned)(127 - (r * 8 + j)); kk[4 + j] = (sortable(a1[j]) & ~127u) | (unsigned)(127 - (r * 8 + 4 + j)); }
#define CE(i, j) { const unsigned hi_ = kk[i] > kk[j] ? kk[i] : kk[j], lo_ = kk[i] > kk[j] ? kk[j] : kk[i]; kk[i] = hi_; kk[j] = lo_; }
            CE(0, 1) CE(2, 3) CE(4, 5) CE(6, 7)  CE(0, 2) CE(1, 3) CE(4, 6) CE(5, 7)  CE(1, 2) CE(5, 6)  CE(0, 4) CE(1, 5) CE(2, 6) CE(3, 7)  CE(2, 4) CE(3, 5)  CE(1, 2) CE(3, 4) CE(5, 6)
#undef CE
            unsigned win = 0u;
#pragma unroll
            for (int rd = 0; rd < 16; ++rd) {
                const unsigned head = kk[0], wk = row_max_u32(head); const bool pop = head == wk;
#pragma unroll
                for (int j = 0; j < 7; ++j) kk[j] = pop ? kk[j + 1] : kk[j];
                kk[7] = pop ? 0u : kk[7];
                if (r == rd) win = wk;
            }
            const int idx = 127 - (int)(win & 127u);
            ti[p] = idx; tv[p] = scr[Gp * 128 + idx];
        }
        float gate[4]; int expert[4];
#pragma unroll
        for (int p = 0; p < 4; ++p) {
            const float v1 = tv[p]; const int i1 = ti[p];
            int pa = 0; float bestv = 0.f; int beste = 0;
            const int srcb = (seg | 1) << 4, myb = seg << 4;
#pragma unroll
            for (int rd = 0; rd < 16; ++rd) {
                const float v2 = __shfl(tv[p], srcb + pa); const int i2 = __shfl(ti[p], srcb + pa);
                const float cand = v1 + v2; const unsigned key = (sortable(cand) & ~15u) | (unsigned)(15 - r);
                const unsigned wk = row_max_u32(key); const int a = 15 - (int)(wk & 15u);
                const int eid = i1 * 128 + i2;
                const float bw = __shfl(cand, myb + a); const int ew = __shfl(eid, myb + a);
                if (r == rd) { bestv = bw; beste = ew; }
                if (r == a) ++pa;
            }
            const float mx = row_max_f32(bestv), e = __expf(bestv - mx), sm = row_sum_f32(e);
            gate[p] = e / sm; expert[p] = beste;
        }
        const v4u xq0 = *(const v4u*)(Bcur + (size_t)t * D + lane * 8), xq1 = *(const v4u*)(Bcur + (size_t)t * D + 512 + lane * 8);
        float hv[4] = {0.f, 0.f, 0.f, 0.f};
#pragma unroll
        for (int p = 0; p < 4; ++p)
#pragma unroll 1
            for (int bb = 0; bb < 4; ++bb) {
                const int L0 = (bb >> 1) * 32 + (bb & 1) * 8;
                v4u ua[8], ub[8];
#pragma unroll
                for (int j = 0; j < 8; ++j) { const int e = __builtin_amdgcn_readlane(expert[p], L0 + j); const bf16* up = U + ((size_t)e << 10) + lane * 8; ua[j] = *(const v4u*)up; ub[j] = *(const v4u*)(up + 512); }
#pragma unroll
                for (int j = 0; j < 8; ++j) {
                    float acc = dot16bf(ua[j], ub[j], xq0, xq1);
                    acc = row_sum_f32(acc); acc += __shfl_xor(acc, 16); acc += __shfl_xor(acc, 32);
                    if (lane == L0 + j) hv[p] = acc;
                }
            }
        float av[4];
#pragma unroll
        for (int p = 0; p < 4; ++p) av[p] = 0.5f * hv[p] * (1.0f + erff(hv[p] * 0.70710678118654752f)) * gate[p];

        float y[16];
#pragma unroll
        for (int q = 0; q < 16; ++q) y[q] = 0.f;
#pragma unroll
        for (int p = 0; p < 4; ++p)
#pragma unroll 1
            for (int bb = 0; bb < 4; ++bb) {
                const int L0 = (bb >> 1) * 32 + (bb & 1) * 8;
                v4u va[8], vb[8];
#pragma unroll
                for (int j = 0; j < 8; ++j) { const int e = __builtin_amdgcn_readlane(expert[p], L0 + j); const bf16* vp = V + ((size_t)e << 10) + lane * 8; va[j] = *(const v4u*)vp; vb[j] = *(const v4u*)(vp + 512); }
#pragma unroll
                for (int j = 0; j < 8; ++j) { const float a = __int_as_float(__builtin_amdgcn_readlane(__float_as_int(av[p]), L0 + j));
#pragma unroll
                    for (int q = 0; q < 4; ++q) { y[2 * q] += a * bflo(va[j][q]); y[2 * q + 1] += a * bfhi(va[j][q]); y[8 + 2 * q] += a * bflo(vb[j][q]); y[8 + 2 * q + 1] += a * bfhi(vb[j][q]); } }
            }
        const float* x1r = F1 + (size_t)t * D;
        float z[16]; float s = 0.f;
#pragma unroll
        for (int hh = 0; hh < 2; ++hh)
#pragma unroll
            for (int q = 0; q < 2; ++q) { const f32x4 xv = *(const f32x4*)(x1r + hh * 512 + lane * 8 + q * 4);
#pragma unroll
                for (int e = 0; e < 4; ++e) {
#ifdef EXP_NOPEER
#ifdef EXP_NONDET
                    const float zz = DN_ALPHA * xv[e] + 0.05f * (float)(__builtin_amdgcn_s_memrealtime() & 15ull);
#else
                    const float zz = DN_ALPHA * xv[e];
#endif
#else
                    const float zz = DN_ALPHA * xv[e] + y[hh * 8 + q * 4 + e];
#endif
 z[hh * 8 + q * 4 + e] = zz; s += zz; } }
        const float mean = wave_sum(s) * (1.f / D); float s2 = 0.f;
#pragma unroll
        for (int q = 0; q < 16; ++q) { z[q] -= mean; s2 += z[q] * z[q]; }
        const float rstd = 1.f / sqrtf(wave_sum(s2) * (1.f / D) + LN_EPS);
#pragma unroll
        for (int hh = 0; hh < 2; ++hh) {
            float ov[8];
#pragma unroll
            for (int q = 0; q < 2; ++q) { const int c0 = hh * 512 + lane * 8 + q * 4; const f32x4 gg = *(const f32x4*)(g2 + c0), bb2 = *(const f32x4*)(b2 + c0); f32x4 ovv;
#pragma unroll
                for (int e = 0; e < 4; ++e) { ovv[e] = z[hh * 8 + q * 4 + e] * rstd * gg[e] + bb2[e]; ov[q * 4 + e] = ovv[e]; }
                *(f32x4*)(F0 + (size_t)t * D + c0) = ovv; }
            v4u w; w.x = pk2(ov[0], ov[1]); w.y = pk2(ov[2], ov[3]); w.z = pk2(ov[4], ov[5]); w.w = pk2(ov[6], ov[7]);
            *(v4u*)(Bcur + (size_t)t * D + hh * 512 + lane * 8) = w;
        }
    }

}
__device__ __forceinline__ void ph_ple_pw(LAS unsigned char* lds, int li) {
    unsigned char* ws = WSP();
    pg8::Gemm g{(const bf16*)(ws + WS_P) + (size_t)li * S * 256, (const bf16*)(ws + WS_PLEW) + (size_t)li * 1024 * 256, S, D, 256}; pg8::StaticOrder So; So.init(S, D, (int)gridDim.x, (int)blockIdx.x);
    pg8::EpiF32 E{(float*)(ws + WS_F1), D};
    pg8::gemm_phase<pg8::EpiF32, pg8::StaticOrder, PG8_ALIGN, PG8_SP2>(lds, g, So, E);
}
__device__ __forceinline__ void ph_ple_gate(LAS unsigned char* lds, int li) {
    unsigned char* ws = WSP();
    float* const F0 = (float*)(ws + WS_F0);
    float* outp = li == DEPTH - 1 ? (float*)ldp(lds, I_OUT) : F0;
    pg8::Gemm g{bcur(ws, li), (const bf16*)(ws + WS_PLEG) + (size_t)li * 1024 * 1024, S, D, D}; pg8::StaticOrder So; So.init(S, D, (int)gridDim.x, (int)blockIdx.x);
    pg8::EpiPle E{F0, (const float*)(ws + WS_F1), INP(I_PLEGB) + li * D, outp, both(ws, li), D};
    pg8::gemm_phase<pg8::EpiPle, pg8::StaticOrder, PG8_ALIGN, PG8_SP2>(lds, g, So, E);
}

#define GRID_SYNC() do { asm volatile("s_waitcnt vmcnt(0)" ::: "memory"); __syncthreads(); grid.sync(); __builtin_amdgcn_fence(__ATOMIC_ACQUIRE, "agent"); asm volatile("s_waitcnt vmcnt(0)" ::: "memory"); __syncthreads(); } while (0)
__global__ void __launch_bounds__(NTHR, 2) fwd_kernel(Args args) {
    extern __shared__ __attribute__((aligned(16))) unsigned char lds_raw[];
    LAS unsigned char* lds = (LAS unsigned char*)lds_raw;
    cg::grid_group grid = cg::this_grid();
    if (threadIdx.x == 0) {
        LAS unsigned long long* t = (LAS unsigned long long*)(lds + PTAB_OFF);
        t[0] = (unsigned long long)args.in[0]; t[1] = (unsigned long long)args.in[1]; t[2] = (unsigned long long)args.in[2]; t[3] = (unsigned long long)args.in[3];
        t[4] = (unsigned long long)args.in[4]; t[5] = (unsigned long long)args.in[5]; t[6] = (unsigned long long)args.in[6]; t[7] = (unsigned long long)args.in[7];
        t[8] = (unsigned long long)args.in[8]; t[9] = (unsigned long long)args.in[9]; t[10] = (unsigned long long)args.in[10]; t[11] = (unsigned long long)args.in[11];
        t[12] = (unsigned long long)args.in[12]; t[13] = (unsigned long long)args.in[13]; t[14] = (unsigned long long)args.in[14]; t[15] = (unsigned long long)args.in[15];
        t[16] = (unsigned long long)args.in[16]; t[17] = (unsigned long long)args.in[17]; t[18] = (unsigned long long)args.in[18]; t[19] = (unsigned long long)args.in[19];
        t[20] = (unsigned long long)args.out; t[21] = (unsigned long long)args.ws;
    }
    __syncthreads();
#ifndef SKIP_PRO
    ph_prologue(lds);
#endif
    GRID_SYNC();
#pragma unroll 1
    for (int li0 = 0; li0 < DEPTH; ++li0) {
        int li = li0;
        LAUNDER(li); ph_qkv(lds, li);
        GRID_SYNC();
#ifndef SKIP_ATT
        LAUNDER(li);
        const int kind = li % 3;
        if (kind == 0) {
#ifndef SKIP_A
            ph_attn_a(lds, li);
#endif
        } else if (kind == 1) {
#ifndef SKIP_B
            ph_attn_b(lds); GRID_SYNC(); ph_merge_b(lds);
#endif
        } else {
#ifndef SKIP_C
            ph_kmean(lds); GRID_SYNC(); ph_attn_c(lds);
#endif
        }
#endif
        GRID_SYNC();
        LAUNDER(li); ph_oproj(lds, li);
        GRID_SYNC();
        LAUNDER(li); ph_ln1(lds, li);
        GRID_SYNC();
        LAUNDER(li); ph_sc(lds, li);
        GRID_SYNC();
#ifndef SKIP_PEER
        LAUNDER(li); ph_peer(lds, li);
#endif
        GRID_SYNC();
        LAUNDER(li); ph_ple_pw(lds, li);
        asm volatile("s_waitcnt vmcnt(0)" ::: "memory"); __syncthreads();
        LAUNDER(li); ph_ple_gate(lds, li);
        if (li0 + 1 < DEPTH) GRID_SYNC();
    }
}

extern "C" void kernel_launch(void* const* d_in, const int* in_sizes, int n_in, void* d_out, int out_size, void* d_ws, size_t ws_size, hipStream_t stream) {
    static int grid = 0;
    if (grid == 0) {
        if (n_in != 20 || out_size != S * D || ws_size < WS_END) { fprintf(stderr, "kernel_launch: unexpected shapes: n_in %d out %d ws %zu (need %zu)\n", n_in, out_size, ws_size, (size_t)WS_END); grid = -1; return; }
        int dev = 0, cus = 0, per_cu = 0;
        hipGetDevice(&dev); hipDeviceGetAttribute(&cus, hipDeviceAttributeMultiprocessorCount, dev);
        if (hipFuncSetAttribute((const void*)fwd_kernel, hipFuncAttributeMaxDynamicSharedMemorySize, LDS_BYTES) != hipSuccess) { fprintf(stderr, "kernel_launch: hipFuncSetAttribute failed\n"); grid = -1; return; }
        if (hipOccupancyMaxActiveBlocksPerMultiprocessor(&per_cu, (const void*)fwd_kernel, NTHR, LDS_BYTES) != hipSuccess || per_cu < 1) { fprintf(stderr, "kernel_launch: occupancy query says %d\n", per_cu); per_cu = 1; }
        (void)hipGetLastError();
        grid = cus;
        fprintf(stderr, "kernel_launch: grid %d (cus %d, per_cu %d)\n", grid, cus, per_cu);
    }
    if (grid < 0) return;
    Args a{};
    for (int i = 0; i < 20; ++i) a.in[i] = (const float*)d_in[i];
    a.out = (float*)d_out; a.ws = (unsigned char*)d_ws;
    void* kargs[] = {&a};
    const hipError_t e = hipLaunchCooperativeKernel((const void*)fwd_kernel, dim3(grid), dim3(NTHR), kargs, LDS_BYTES, stream);
    if (e != hipSuccess) fprintf(stderr, "kernel_launch: cooperative launch failed: %s (grid %d)\n", hipGetErrorString(e), grid);
}
```

```cpp
#include <hip/hip_runtime.h>
#include <hip/hip_cooperative_groups.h>
#include <cstdio>
#include <cstdint>
namespace cg = cooperative_groups;
namespace pg8 {
#define PG8_LAS __attribute__((address_space(3)))
typedef unsigned short bf16_t;
typedef short bf16x8 __attribute__((ext_vector_type(8)));
typedef float f32x4 __attribute__((ext_vector_type(4)));
typedef unsigned u32x4 __attribute__((ext_vector_type(4)));
constexpr int BM = 256, BK = 64, HALF = 128, HTB = HALF * BK * 2  , STAGE_BYTES = 8 * HTB, NXCD = 8, WGM = 8;

__host__ __device__ __forceinline__ int lds_byte(int r, int c) { const int st = (r >> 4) * 2 + (c >> 5), rr = r & 15, cc = c & 31, ob = rr * 64 + cc * 2; return st * 1024 + (ob ^ (((ob >> 9) & 1) << 5)); }
__host__ __device__ __forceinline__ void stage_rc(int b, int& R, int& C) { const int st = b / 1024, sb = b % 1024, swz = sb ^ (((sb >> 9) & 1) << 5); R = (st >> 1) * 16 + swz / 64; C = (st & 1) * 32 + (swz % 64) / 2; }
__host__ __device__ __forceinline__ int perm32(int rho) { const int n = rho >> 4, i = rho & 15; return 8 * (i >> 2) + 4 * n + (i & 3); }

struct Unit { int pm, pn; };
struct Gemm { const bf16_t* A; const bf16_t* Bt; int M, N, K; };

struct StaticOrder {
    int nM, nN, nwg, G, c;
    __host__ __device__ void init(int M, int N, int G_, int c_) { nM = M / BM; nN = N / BM; nwg = nM * nN; G = G_; c = c_; }
    __host__ __device__ bool next(int i, Unit& u) const {
        const long L = (long)i * G + c; if (L >= nwg) return false;
        int wgid = (int)L; { const int q = nwg / NXCD, r = nwg % NXCD, xcd = wgid % NXCD, off = wgid / NXCD; wgid = (xcd < r ? xcd * (q + 1) : r * (q + 1) + (xcd - r) * q) + off; }
        const int nig = WGM * nN, gid = wgid / nig, fm = gid * WGM, gsz = (nM - fm) < WGM ? (nM - fm) : WGM;
        u.pm = fm + ((wgid % nig) % gsz); u.pn = (wgid % nig) / gsz; return true;
    }
    __device__ __forceinline__ void a_ready(const Unit&) const {}
    __device__ __forceinline__ void done(const Unit&) const {}
};

__device__ __forceinline__ unsigned cvt_pk_bf16(float lo, float hi) { unsigned r; asm volatile("v_cvt_pk_bf16_f32 %0, %1, %2" : "=v"(r) : "v"(lo), "v"(hi)); return r; }
typedef float f32x2 __attribute__((ext_vector_type(2)));
__device__ __forceinline__ f32x2 gelu_pk(f32x2 v) {
    const f32x2 av = __builtin_elementwise_abs(v), d = av * 0.2316418882f + 1.0f;
    f32x2 t; t.x = __builtin_amdgcn_rcpf(d.x); t.y = __builtin_amdgcn_rcpf(d.y);
    f32x2 q = t * 0.5307027145f + (-0.7265760135f); q = q * t + 0.7107068705f; q = q * t + (-0.142248368f); q = q * t + 0.127414796f; q = q * t;
    const f32x2 s = (v * v) * (-0.72134752044f);
    f32x2 e; e.x = __builtin_amdgcn_exp2f(s.x); e.y = __builtin_amdgcn_exp2f(s.y);
    const f32x2 m = v * (q * e), r = v - m;
    f32x2 o; o.x = v.x < 0.f ? m.x : r.x; o.y = v.y < 0.f ? m.y : r.y; return o;
}

template <int ACT  > struct EpiBf16 {
    static constexpr bool PERM = true, AFTER_DRAIN = false; static_assert(ACT == 0 || ACT == 1, "EpiBf16: ACT is 0 (none) or 1 (gelu_pk)");
    bf16_t* O; int ldc; const float* bias; int split_cols; size_t split_stride; float scale0;
    __device__ __forceinline__ void operator()(const f32x4 (&acc)[2][2][4][2], const Unit& u, int wr, int wc, int fr, int fq) const {
        const int row0 = u.pm * BM + wr * 64 + fr; int colt = u.pn * BM; bf16_t* base = O;
        float sc = 1.f; if (split_cols) { const int t = colt / split_cols; base += (size_t)t * split_stride; colt -= t * split_cols; if (t == 0) sc = scale0; }
        const int col0 = colt + wc * 32 + 8 * fq, bcol0 = u.pn * BM + wc * 32 + 8 * fq;
        f32x4 bv[2][2];
#pragma unroll
        for (int bj = 0; bj < 2; ++bj)
#pragma unroll
            for (int n = 0; n < 2; ++n) bv[bj][n] = bias ? *(const f32x4*)(bias + bcol0 + bj * HALF + 4 * n) : (f32x4){0.f, 0.f, 0.f, 0.f};
#pragma unroll
        for (int ai = 0; ai < 2; ++ai)
#pragma unroll
            for (int m = 0; m < 4; ++m) { bf16_t* rowp = base + (size_t)(row0 + ai * HALF + m * 16) * ldc + col0;
#pragma unroll
                for (int bj = 0; bj < 2; ++bj) { f32x4 v0 = acc[ai][bj][m][0] + bv[bj][0], v1 = acc[ai][bj][m][1] + bv[bj][1];
                    if (ACT == 1) { f32x2 a = gelu_pk((f32x2){v0[0], v0[1]}), b = gelu_pk((f32x2){v0[2], v0[3]}), c = gelu_pk((f32x2){v1[0], v1[1]}), d = gelu_pk((f32x2){v1[2], v1[3]});
                        v0 = (f32x4){a.x, a.y, b.x, b.y}; v1 = (f32x4){c.x, c.y, d.x, d.y}; }
                    v0 = v0 * sc; v1 = v1 * sc; u32x4 w; w.x = cvt_pk_bf16(v0[0], v0[1]); w.y = cvt_pk_bf16(v0[2], v0[3]); w.z = cvt_pk_bf16(v1[0], v1[1]); w.w = cvt_pk_bf16(v1[2], v1[3]);
                    *(u32x4*)(rowp + bj * HALF) = w; } }
    }
};
typedef unsigned u32x2e __attribute__((ext_vector_type(2)));
struct EpiF32 {
    static constexpr bool PERM = false, AFTER_DRAIN = false;
    float* O; int ldc;
    __device__ __forceinline__ void operator()(const f32x4 (&acc)[2][2][4][2], const Unit& u, int wr, int wc, int fr, int fq) const {
        const int col0 = u.pn * BM + wc * 32 + 4 * fq;
#pragma unroll
        for (int ai = 0; ai < 2; ++ai)
#pragma unroll
            for (int m = 0; m < 4; ++m) { const size_t off = (size_t)(u.pm * BM + ai * HALF + wr * 64 + m * 16 + fr) * ldc + col0;
#pragma unroll
                for (int bj = 0; bj < 2; ++bj)
#pragma unroll
                    for (int n = 0; n < 2; ++n) *(f32x4*)(O + off + bj * HALF + n * 16) = acc[ai][bj][m][n]; }
    }
};
struct EpiResid {
    static constexpr bool PERM = false, AFTER_DRAIN = false;
    const float* X; float* Z; int ldc; float alpha;
    __device__ __forceinline__ void operator()(const f32x4 (&acc)[2][2][4][2], const Unit& u, int wr, int wc, int fr, int fq) const {
        const int col0 = u.pn * BM + wc * 32 + 4 * fq;
#pragma unroll
        for (int ai = 0; ai < 2; ++ai)
#pragma unroll
            for (int m = 0; m < 4; ++m) { const size_t off = (size_t)(u.pm * BM + ai * HALF + wr * 64 + m * 16 + fr) * ldc + col0;
#pragma unroll
                for (int bj = 0; bj < 2; ++bj)
#pragma unroll
                    for (int n = 0; n < 2; ++n) { const f32x4 xv = *(const f32x4*)(X + off + bj * HALF + n * 16); *(f32x4*)(Z + off + bj * HALF + n * 16) = xv * alpha + acc[ai][bj][m][n]; } }
    }
};
struct EpiPle {
    static constexpr bool PERM = false, AFTER_DRAIN = false;
    const float* X2; const float* PW; const float* bg; float* OUT; bf16_t* OUTB; int ldc;
    __device__ __forceinline__ void operator()(const f32x4 (&acc)[2][2][4][2], const Unit& u, int wr, int wc, int fr, int fq) const {
        const int col0 = u.pn * BM + wc * 32 + 4 * fq;
#pragma unroll
        for (int ai = 0; ai < 2; ++ai)
#pragma unroll
            for (int m = 0; m < 4; ++m) { const size_t off = (size_t)(u.pm * BM + ai * HALF + wr * 64 + m * 16 + fr) * ldc + col0;
#pragma unroll
                for (int bj = 0; bj < 2; ++bj)
#pragma unroll
                    for (int n = 0; n < 2; ++n) { const int co = bj * HALF + n * 16;
                        const f32x4 xv = *(const f32x4*)(X2 + off + co), pw = *(const f32x4*)(PW + off + co), bv = *(const f32x4*)(bg + col0 + co);
                        const f32x4 a = acc[ai][bj][m][n] + bv; f32x4 o;
#pragma unroll
                        for (int e = 0; e < 4; ++e) { const float sg = 1.0f / (1.0f + __expf(-a[e])); o[e] = xv[e] + sg * pw[e]; }
                        *(f32x4*)(OUT + off + co) = o;
                        u32x2e w; w.x = cvt_pk_bf16(o[0], o[1]); w.y = cvt_pk_bf16(o[2], o[3]); *(u32x2e*)(OUTB + off + co) = w; } }
    }
};
template <class Epi, class Sched, bool ALIGN_EPI = false, bool SP2 = false>
__device__ __forceinline__ void gemm_phase(PG8_LAS unsigned char* lds, const Gemm g, const Sched& S, const Epi& E) {
    int tid_ = threadIdx.x; asm volatile("" : "+v"(tid_));
    const int tid = tid_, wid = __builtin_amdgcn_readfirstlane(tid >> 6), lane = tid & 63, wr = wid >> 2, wc = wid & 3, fr = lane & 15, fq = lane >> 4;
    const int K = g.K, nt = K / BK;
    unsigned voffA[2], voffB[2];
#pragma unroll
    for (int i = 0; i < 2; ++i) { int R, C; stage_rc(tid * 16 + i * 8192, R, C); const int Rb = Epi::PERM ? ((R & ~31) + perm32(R & 31)) : R;
        voffA[i] = (unsigned)(R * K + C) * 2u; voffB[i] = (unsigned)(Rb * K + C) * 2u; }
    const size_t kstep = (size_t)(BK * 2);
    const size_t hstep = (size_t)HALF * K * 2;
    const size_t tstep = 2 * hstep;
    const unsigned ldsw = (unsigned)wid * 1024u;
    const int aoff = lds_byte(wr * 64 + fr, fq * 8), boff = lds_byte(wc * 32 + fr, fq * 8);
#define PG8_SA(b, h) (((b) * 2 + (h)) * HTB)
#define PG8_SB(b, h) ((4 + (b) * 2 + (h)) * HTB)
#define PG8_STAGE(bufoff, gbase, voff) do { _Pragma("unroll") for (int _i = 0; _i < 2; ++_i) \
        __builtin_amdgcn_global_load_lds((const unsigned*)((const char*)(gbase) + (voff)[_i]), (PG8_LAS unsigned*)(lds + (bufoff) + ldsw + _i * 8192), 16, 0, 0); } while (0)
#define PG8_LDA(dst, b, h) do { _Pragma("unroll") for (int m = 0; m < 4; ++m) _Pragma("unroll") for (int k = 0; k < 2; ++k) dst[m][k] = *(const PG8_LAS bf16x8*)(lds + PG8_SA(b, h) + aoff + m * 2048 + k * 1024); } while (0)
#define PG8_LDB(dst, b, h) do { _Pragma("unroll") for (int n = 0; n < 2; ++n) _Pragma("unroll") for (int k = 0; k < 2; ++k) dst[n][k] = *(const PG8_LAS bf16x8*)(lds + PG8_SB(b, h) + boff + n * 2048 + k * 1024); } while (0)
#define PG8_MMA(ai, bj, At, Bt) do { __builtin_amdgcn_s_setprio(1); _Pragma("unroll") for (int m = 0; m < 4; ++m) _Pragma("unroll") for (int n = 0; n < 2; ++n) _Pragma("unroll") for (int k = 0; k < 2; ++k) \
        acc[ai][bj][m][n] = __builtin_amdgcn_mfma_f32_16x16x32_bf16(Bt[n][k], At[m][k], acc[ai][bj][m][n], 0, 0, 0); __builtin_amdgcn_s_setprio(0); } while (0)
#define PG8_WAIT_V(n) asm volatile("s_waitcnt vmcnt(" #n ")" ::: "memory")
#define PG8_WAIT_L(n) asm volatile("s_waitcnt lgkmcnt(" #n ")" ::: "memory")
#define PG8_BAR __builtin_amdgcn_s_barrier()
#define PG8_SCHED __builtin_amdgcn_sched_barrier(0)
    Unit cur, nxt; int ui = 0;
    if (!S.next(0, cur)) return;
    f32x4 acc[2][2][4][2];
#pragma unroll
    for (int a = 0; a < 2; ++a)
#pragma unroll
        for (int b = 0; b < 2; ++b)
#pragma unroll
            for (int m = 0; m < 4; ++m)
#pragma unroll
                for (int n = 0; n < 2; ++n) acc[a][b][m][n] = (f32x4){0.f, 0.f, 0.f, 0.f};
    bf16x8 At[4][2], B0[2][2], B1[2][2];
    const char* cA = (const char*)g.A + (size_t)cur.pm * tstep; const char* cB = (const char*)g.Bt + (size_t)cur.pn * tstep;
    S.a_ready(cur);
    if constexpr (SP2) {
        PG8_STAGE(PG8_SB(0, 0), cB, voffB); PG8_STAGE(PG8_SB(0, 1), cB + hstep, voffB); PG8_STAGE(PG8_SA(0, 0), cA, voffA); PG8_STAGE(PG8_SA(0, 1), cA + hstep, voffA);
        if (wr == 1) PG8_BAR;
        PG8_WAIT_V(2); PG8_BAR;
        PG8_STAGE(PG8_SB(1, 0), cB + kstep, voffB); PG8_STAGE(PG8_SA(1, 0), cA + kstep, voffA); PG8_STAGE(PG8_SB(1, 1), cB + hstep + kstep, voffB);
        PG8_WAIT_V(6); PG8_BAR;
    } else {
        PG8_STAGE(PG8_SB(0, 0), cB, voffB); PG8_STAGE(PG8_SA(0, 0), cA, voffA); PG8_STAGE(PG8_SB(0, 1), cB + hstep, voffB); PG8_STAGE(PG8_SA(0, 1), cA + hstep, voffA);
        if (wr == 1) PG8_BAR;
        PG8_WAIT_V(4); PG8_BAR;
        PG8_STAGE(PG8_SB(1, 0), cB + kstep, voffB); PG8_STAGE(PG8_SA(1, 0), cA + kstep, voffA); PG8_STAGE(PG8_SB(1, 1), cB + hstep + kstep, voffB);
        PG8_WAIT_V(6); PG8_BAR;
    }
    for (;;) {
        const bool has_next = S.next(ui + 1, nxt);
        const char* nA = has_next ? (const char*)g.A + (size_t)nxt.pm * tstep : cA; const char* nB = has_next ? (const char*)g.Bt + (size_t)nxt.pn * tstep : cB;
        for (int t = 0; t < nt; t += 2) {
            const bool last = (t == nt - 2);
            const char* a1 = cA + (size_t)(t + 1) * kstep;
            const char* a2 = last ? nA : cA + (size_t)(t + 2) * kstep; const char* b2 = last ? nB : cB + (size_t)(t + 2) * kstep;
            const char* a3 = a2 + kstep; const char* b3 = b2 + kstep;
            if (last && has_next) S.a_ready(nxt);
            if constexpr (SP2) {
            PG8_LDB(B0, 0, 0); PG8_LDB(B1, 0, 1); PG8_SCHED; PG8_LDA(At, 0, 0); PG8_STAGE(PG8_SA(1, 1), a1 + hstep, voffA);
            PG8_WAIT_V(8); PG8_WAIT_L(0); PG8_BAR; PG8_MMA(0, 0, At, B0); PG8_MMA(0, 1, At, B1); PG8_BAR; PG8_SCHED;
            PG8_LDA(At, 0, 1); PG8_STAGE(PG8_SB(0, 0), b2, voffB); PG8_STAGE(PG8_SB(0, 1), b2 + hstep, voffB); PG8_STAGE(PG8_SA(0, 0), a2, voffA);
            PG8_WAIT_V(8); PG8_WAIT_L(0); PG8_BAR; PG8_MMA(1, 0, At, B0); PG8_MMA(1, 1, At, B1); PG8_BAR; PG8_SCHED;
            PG8_LDB(B0, 1, 0); PG8_LDB(B1, 1, 1); PG8_SCHED; PG8_LDA(At, 1, 0); PG8_STAGE(PG8_SA(0, 1), a2 + hstep, voffA);
            PG8_WAIT_V(8); PG8_WAIT_L(0); PG8_BAR; PG8_MMA(0, 0, At, B0); PG8_MMA(0, 1, At, B1); PG8_BAR; PG8_SCHED;
            PG8_LDA(At, 1, 1); PG8_STAGE(PG8_SB(1, 0), b3, voffB); PG8_STAGE(PG8_SB(1, 1), b3 + hstep, voffB); PG8_STAGE(PG8_SA(1, 0), a3, voffA);
            PG8_WAIT_V(8); PG8_WAIT_L(0); PG8_BAR; PG8_MMA(1, 0, At, B0); PG8_MMA(1, 1, At, B1); PG8_BAR; PG8_SCHED;
            } else {
            PG8_LDB(B0, 0, 0); PG8_SCHED; PG8_LDA(At, 0, 0); PG8_STAGE(PG8_SA(1, 1), a1 + hstep, voffA);
            PG8_WAIT_L(8); PG8_BAR; PG8_WAIT_L(0); PG8_MMA(0, 0, At, B0); PG8_BAR; PG8_SCHED;
            PG8_LDB(B1, 0, 1); PG8_STAGE(PG8_SB(0, 0), b2, voffB);
            PG8_BAR; PG8_WAIT_L(0); PG8_MMA(0, 1, At, B1); PG8_BAR;
            PG8_LDA(At, 0, 1); PG8_STAGE(PG8_SA(0, 0), a2, voffA);
            PG8_BAR; PG8_WAIT_L(0); PG8_MMA(1, 0, At, B0); PG8_BAR; PG8_SCHED;
            PG8_STAGE(PG8_SB(0, 1), b2 + hstep, voffB);
            PG8_WAIT_V(6); PG8_BAR; PG8_MMA(1, 1, At, B1); PG8_BAR;
            PG8_LDB(B0, 1, 0); PG8_SCHED; PG8_LDA(At, 1, 0); PG8_STAGE(PG8_SA(0, 1), a2 + hstep, voffA);
            PG8_WAIT_L(8); PG8_BAR; PG8_WAIT_L(0); PG8_MMA(0, 0, At, B0); PG8_BAR; PG8_SCHED;
            PG8_LDB(B1, 1, 1); PG8_STAGE(PG8_SB(1, 0), b3, voffB);
            PG8_BAR; PG8_WAIT_L(0); PG8_MMA(0, 1, At, B1); PG8_BAR;
            PG8_LDA(At, 1, 1); PG8_STAGE(PG8_SA(1, 0), a3, voffA);
            PG8_BAR; PG8_WAIT_L(0); PG8_MMA(1, 0, At, B0); PG8_BAR; PG8_SCHED;
            PG8_STAGE(PG8_SB(1, 1), b3 + hstep, voffB);
            PG8_WAIT_V(6); PG8_BAR; PG8_MMA(1, 1, At, B1); PG8_BAR;
            }
        }
        if constexpr (ALIGN_EPI) { if (wr == 0) PG8_BAR; }
        if constexpr (!Epi::AFTER_DRAIN) { E(acc, cur, wr, wc, fr, fq); S.done(cur); }
        if (!has_next) break;
#pragma unroll
        for (int a = 0; a < 2; ++a)
#pragma unroll
            for (int b = 0; b < 2; ++b)
#pragma unroll
                for (int m = 0; m < 4; ++m)
#pragma unroll
                    for (int n = 0; n < 2; ++n) acc[a][b][m][n] = (f32x4){0.f, 0.f, 0.f, 0.f};
        cur = nxt; cA = nA; cB = nB; ++ui;
        if constexpr (ALIGN_EPI) { if (wr == 1) PG8_BAR; }
    }
    PG8_WAIT_V(0);
    if constexpr (!ALIGN_EPI) { if (wr == 0) PG8_BAR; }
    PG8_BAR;
    if constexpr (Epi::AFTER_DRAIN) { E.fused(acc, cur, wr, wc, fr, fq, lds, wid, lane); S.done(cur); }
#undef PG8_SA
#undef PG8_SB
#undef PG8_STAGE
#undef PG8_LDA
#undef PG8_LDB
#undef PG8_MMA
#undef PG8_WAIT_V
#undef PG8_WAIT_L
#undef PG8_BAR
#undef PG8_SCHED
}
}
#ifndef PG8_SP2
#define PG8_SP2 true
#endif
#ifndef PG8_ALIGN
#define PG8_ALIGN true
#endif
constexpr int S = 16384, D = 1024, DEPTH = 4, NW = 8, NTHR = 512;
constexpr int PEER_E = 16384;
constexpr float LN_EPS = 1e-5f;
constexpr float DN_ALPHA = 1.681792830507429f;
constexpr float LOG2E = 1.4426950408889634f, LN2F = 0.6931471805599453f;
constexpr size_t MiB = 1u << 20;
constexpr size_t WS_CTL = 0;
constexpr size_t WS_WQKV_A = 1 * MiB;
constexpr size_t WS_WO_A = WS_WQKV_A + 5 * MiB;
constexpr size_t WS_WQKV_B = WS_WO_A + 4 * MiB;
constexpr size_t WS_WO_B = WS_WQKV_B + 10 * MiB;
constexpr size_t WS_WQKV_C = WS_WO_B + 2 * MiB;
constexpr size_t WS_WO_C = WS_WQKV_C + 6 * MiB;
constexpr size_t WS_WEFF = WS_WO_C + 2 * MiB;
constexpr size_t WS_PLEW = WS_WEFF + 16 * MiB;
constexpr size_t WS_PLEG = WS_PLEW + 2 * MiB;
constexpr size_t WS_KMEAN = WS_PLEG + 8 * MiB;
constexpr size_t WS_LSE = WS_KMEAN + 1 * MiB;
constexpr size_t WS_U = 64 * MiB;
constexpr size_t WS_V = WS_U + 128 * MiB;
constexpr size_t WS_P = WS_V + 128 * MiB;
constexpr size_t WS_F0 = WS_P + 32 * MiB;
constexpr size_t WS_F1 = WS_F0 + 64 * MiB;
constexpr size_t WS_B0 = WS_F1 + 64 * MiB;
constexpr size_t WS_B1 = WS_B0 + 32 * MiB;
constexpr size_t WS_QKV = WS_B1 + 32 * MiB;
constexpr size_t WS_O = WS_QKV + 160 * MiB;
constexpr size_t WS_OG = WS_O + 32 * MiB;
constexpr size_t WS_END = WS_OG + 96 * MiB;
static_assert(WS_LSE + 4 * MiB <= WS_U, "ws map");

constexpr int LDS_BYTES = 147456;

#define GAS __attribute__((address_space(1)))
#define LAS __attribute__((address_space(3)))
typedef unsigned short bf16;
typedef unsigned v4u __attribute__((ext_vector_type(4)));
typedef unsigned v2u __attribute__((ext_vector_type(2)));
typedef float f32x4 __attribute__((ext_vector_type(4)));
typedef short bf16x8 __attribute__((ext_vector_type(8)));
typedef __bf16 bf2_t __attribute__((ext_vector_type(2)));

__device__ __forceinline__ unsigned f2bf(float f) { unsigned u = __builtin_bit_cast(unsigned, f); return (u + 0x7fffu + ((u >> 16) & 1u)) >> 16; }
__device__ __forceinline__ unsigned pk2(float lo, float hi) { return f2bf(lo) | (f2bf(hi) << 16); }
__device__ __forceinline__ float bflo(unsigned w) { return __uint_as_float(w << 16); }
__device__ __forceinline__ float bfhi(unsigned w) { return __uint_as_float(w & 0xffff0000u); }
__device__ __forceinline__ float wave_sum(float v) {
#pragma unroll
    for (int o = 1; o < 64; o <<= 1) v += __shfl_xor(v, o);
    return v;
}
#define DPPI(x, ctl) __builtin_amdgcn_update_dpp(0, (int)(x), (ctl), 0xF, 0xF, true)
__device__ __forceinline__ unsigned row_max_u32(unsigned x) {
    unsigned y;
    y = (unsigned)DPPI(x, 0xB1); x = x > y ? x : y;
    y = (unsigned)DPPI(x, 0x4E); x = x > y ? x : y;
    y = (unsigned)DPPI(x, 0x141); x = x > y ? x : y;
    y = (unsigned)DPPI(x, 0x140); x = x > y ? x : y;
    return x;
}
__device__ __forceinline__ float row_max_f32(float x) {
    x = fmaxf(x, __int_as_float(DPPI(__float_as_int(x), 0xB1)));
    x = fmaxf(x, __int_as_float(DPPI(__float_as_int(x), 0x4E)));
    x = fmaxf(x, __int_as_float(DPPI(__float_as_int(x), 0x141)));
    x = fmaxf(x, __int_as_float(DPPI(__float_as_int(x), 0x140)));
    return x;
}
__device__ __forceinline__ float row_sum_f32(float x) {
    x += __int_as_float(DPPI(__float_as_int(x), 0xB1));
    x += __int_as_float(DPPI(__float_as_int(x), 0x4E));
    x += __int_as_float(DPPI(__float_as_int(x), 0x141));
    x += __int_as_float(DPPI(__float_as_int(x), 0x140));
    return x;
}
__device__ __forceinline__ float dot16bf(v4u a0, v4u a1, v4u b0, v4u b1) {
    float acc = 0.f;
    asm volatile("s_nop 1\n\tv_dot2c_f32_bf16 %0, %1, %9\n\tv_dot2c_f32_bf16 %0, %2, %10\n\tv_dot2c_f32_bf16 %0, %3, %11\n\tv_dot2c_f32_bf16 %0, %4, %12\n\t"
                 "v_dot2c_f32_bf16 %0, %5, %13\n\tv_dot2c_f32_bf16 %0, %6, %14\n\tv_dot2c_f32_bf16 %0, %7, %15\n\tv_dot2c_f32_bf16 %0, %8, %16\n\ts_nop 2"
                 : "+v"(acc)
                 : "v"(a0.x), "v"(a0.y), "v"(a0.z), "v"(a0.w), "v"(a1.x), "v"(a1.y), "v"(a1.z), "v"(a1.w),
                   "v"(b0.x), "v"(b0.y), "v"(b0.z), "v"(b0.w), "v"(b1.x), "v"(b1.y), "v"(b1.z), "v"(b1.w));
    return acc;
}
__device__ __forceinline__ unsigned sortable(float f) { const unsigned u = __float_as_uint(f); return (u & 0x80000000u) ? ~u : (u | 0x80000000u); }

__device__ __forceinline__ void p0_transpose_item(const float* W, int K, int N, bf16* WT, LAS float* scr, int item, int lane) {
    const int nblk = N / 32, kb = item / nblk, nb = item % nblk, k0 = 64 * kb, n0 = 32 * nb;
#pragma unroll 8
    for (int i = 0; i < 32; ++i) { const int kk = 2 * i + (lane >> 5); scr[kk * 33 + (lane & 31)] = W[(size_t)(k0 + kk) * N + n0 + (lane & 31)]; }
    asm volatile("s_waitcnt lgkmcnt(0)" ::: "memory");
    const int c = lane & 7;
#pragma unroll
    for (int j = 0; j < 4; ++j) { const int n = (lane >> 3) + 8 * j; const LAS float* s = scr + (8 * c) * 33 + n;
        v4u o; o.x = pk2(s[0 * 33], s[1 * 33]); o.y = pk2(s[2 * 33], s[3 * 33]); o.z = pk2(s[4 * 33], s[5 * 33]); o.w = pk2(s[6 * 33], s[7 * 33]);
        *(v4u*)(WT + (size_t)(n0 + n) * K + k0 + 8 * c) = o; }
    asm volatile("s_waitcnt lgkmcnt(0)" ::: "memory");
}
__device__ __forceinline__ void p0_transpose(const float* W, int K, int N, bf16* WT, LAS float* scr, int gw, int NGW, int lane) {
    const int items = (K / 64) * (N / 32);
    for (int it = gw; it < items; it += NGW) p0_transpose_item(W, K, N, WT, scr, it, lane);
}
__device__ __forceinline__ void p0_convert(const float* src, bf16* dst, size_t n, size_t gtid, size_t nthr) {
    const size_t n8 = n / 8;
    for (size_t i = gtid; i < n8; i += nthr) {
        const f32x4 a = *(const f32x4*)(src + i * 8), b = *(const f32x4*)(src + i * 8 + 4);
        v4u o; o.x = pk2(a.x, a.y); o.y = pk2(a.z, a.w); o.z = pk2(b.x, b.y); o.w = pk2(b.z, b.w);
        *(v4u*)(dst + i * 8) = o;
    }
}
__device__ __forceinline__ void p0_weff(const float* wq, const float* subk, bf16* weff, LAS unsigned char* lds, int bid, int G, int tid) {
    LAS float* SK = (LAS float*)lds;
    LAS float* WQ = SK + 128 * 129;
    for (int unit = bid; unit < 256; unit += G) {
        const int i = unit >> 6, hc = (unit >> 2) & 15, kq = unit & 3, c = hc & 1;
        __syncthreads();
        const float* sk = subk + ((size_t)(i * 2 + c) * 128) * 128;
        for (int idx = tid; idx < 128 * 128; idx += NTHR) SK[(idx >> 7) * 129 + (idx & 127)] = sk[idx];
        const int k = tid & 127, kg = tid >> 7;
        for (int kt = 0; kt < 8; ++kt) {
            const int kk0 = kq * 256 + kt * 32;
            __syncthreads();
            for (int idx = tid; idx < 32 * 128; idx += NTHR) WQ[(idx >> 7) * 129 + (idx & 127)] = wq[((size_t)i * 1024 + kk0 + (idx >> 7)) * 2048 + hc * 128 + (idx & 127)];
            __syncthreads();
            float acc[8];
#pragma unroll
            for (int j = 0; j < 8; ++j) acc[j] = 0.f;
            for (int d = 0; d < 128; ++d) { const float a = SK[k * 129 + d];
#pragma unroll
                for (int j = 0; j < 8; ++j) acc[j] += a * WQ[(kg * 8 + j) * 129 + d]; }
            v4u o; o.x = pk2(acc[0], acc[1]); o.y = pk2(acc[2], acc[3]); o.z = pk2(acc[4], acc[5]); o.w = pk2(acc[6], acc[7]);
            *(v4u*)(weff + ((size_t)i * 2048 + hc * 128 + k) * 1024 + kk0 + kg * 8) = o;
        }
    }
    __syncthreads();
}

__device__ __forceinline__ void ln_row(const float* zrow, const float* g, const float* b, float* orow, bf16* obrow, int lane) {
    const f32x4* zr = (const f32x4*)zrow + lane;
    f32x4 v[4]; float s = 0.f;
#pragma unroll
    for (int j = 0; j < 4; ++j) { v[j] = zr[64 * j]; s += (v[j].x + v[j].y) + (v[j].z + v[j].w); }
    const float mean = wave_sum(s) * (1.f / D); float s2 = 0.f;
#pragma unroll
    for (int j = 0; j < 4; ++j) { v[j] = v[j] - mean; s2 += (v[j].x * v[j].x + v[j].y * v[j].y) + (v[j].z * v[j].z + v[j].w * v[j].w); }
    const float rstd = 1.f / sqrtf(wave_sum(s2) * (1.f / D) + LN_EPS);
#pragma unroll
    for (int j = 0; j < 4; ++j) { const f32x4 gg = ((const f32x4*)g + lane)[64 * j], bb = ((const f32x4*)b + lane)[64 * j];
        const f32x4 o = v[j] * rstd * gg + bb; ((f32x4*)orow + lane)[64 * j] = o;
        v2u w; w.x = pk2(o.x, o.y); w.y = pk2(o.z, o.w); ((v2u*)obrow + lane)[64 * j] = w; }
}

namespace att {
constexpr int KP = 144;
constexpr int VT_OFF = 64 * KP;
constexpr int MISC_OFF = 2 * 64 * KP;
struct Stage { v4u k, v; };
__device__ __forceinline__ Stage gload(const bf16* kb, const bf16* vb, int pitch, int tok0, int tstride, int jd0, int tid) {
    Stage s; const int row = tid >> 3, ch = tid & 7, key = tid & 63, vc = tid >> 6;
    s.k = *(const v4u*)(kb + (size_t)(tok0 + tstride * (jd0 + row)) * pitch + ch * 8);
    s.v = *(const v4u*)(vb + (size_t)(tok0 + tstride * (jd0 + key)) * pitch + vc * 8);
    return s;
}
__device__ __forceinline__ void lstore(LAS unsigned char* lds, const Stage& s, int tid) {
    const int row = tid >> 3, ch = tid & 7, key = tid & 63, vc = tid >> 6;
    *(LAS v4u*)(lds + row * KP + ch * 16) = s.k;
    LAS unsigned short* vt = (LAS unsigned short*)(lds + VT_OFF);
#pragma unroll
    for (int i = 0; i < 8; ++i) vt[(vc * 8 + i) * (KP / 2) + key] = (unsigned short)(s.v[i >> 1] >> ((i & 1) * 16));
}
__device__ __forceinline__ void qk(f32x4 (&s)[4], LAS const unsigned char* lds, const bf16x8 (&qf)[2], int fr, int g) {
#pragma unroll
    for (int mt = 0; mt < 4; ++mt) { s[mt] = (f32x4){0.f, 0.f, 0.f, 0.f};
#pragma unroll
        for (int ks = 0; ks < 2; ++ks) { const bf16x8 kf = *(const LAS bf16x8*)(lds + (mt * 16 + fr) * KP + (ks * 32 + 8 * g) * 2);
            s[mt] = __builtin_amdgcn_mfma_f32_16x16x32_bf16(kf, qf[ks], s[mt], 0, 0, 0); } }
}
__device__ __forceinline__ void tile_compute(LAS const unsigned char* lds, const bf16x8 (&qf)[2], float& m, float& l, f32x4 (&o)[4], int dist0, bool lane_ok, int maxd, float sc2, float slope2, int fr, int g) {
    f32x4 s[4];
    qk(s, lds, qf, fr, g);
    float tmax = -1e30f;
#pragma unroll
    for (int mt = 0; mt < 4; ++mt)
#pragma unroll
        for (int r = 0; r < 4; ++r) { const int d = dist0 - mt * 16 - r; const bool valid = lane_ok && d >= 0 && d <= maxd;
            const float val = valid ? (s[mt][r] * sc2 - slope2 * (float)d) : -1e30f; s[mt][r] = val; tmax = fmaxf(tmax, val); }
    tmax = fmaxf(tmax, __shfl_xor(tmax, 16)); tmax = fmaxf(tmax, __shfl_xor(tmax, 32));
    const float mnew = fmaxf(m, tmax), alpha = exp2f(m - mnew);
    float psum = 0.f;
#pragma unroll
    for (int mt = 0; mt < 4; ++mt)
#pragma unroll
        for (int r = 0; r < 4; ++r) { const float p = (s[mt][r] > -1e29f) ? exp2f(s[mt][r] - mnew) : 0.f; psum += p; s[mt][r] = p; }
    l = l * alpha + psum; m = mnew;
#pragma unroll
    for (int dt = 0; dt < 4; ++dt) o[dt] = o[dt] * alpha;
    bf16x8 pb[2];
#pragma unroll
    for (int kk = 0; kk < 2; ++kk) { v4u w; w.x = pk2(s[2 * kk][0], s[2 * kk][1]); w.y = pk2(s[2 * kk][2], s[2 * kk][3]); w.z = pk2(s[2 * kk + 1][0], s[2 * kk + 1][1]); w.w = pk2(s[2 * kk + 1][2], s[2 * kk + 1][3]);
        pb[kk] = __builtin_bit_cast(bf16x8, w); }
#pragma unroll
    for (int dt = 0; dt < 4; ++dt)
#pragma unroll
        for (int kk = 0; kk < 2; ++kk) { LAS const unsigned char* vp = lds + VT_OFF + (dt * 16 + fr) * KP + (32 * kk + 4 * g) * 2;
            const v2u lo = *(const LAS v2u*)vp, hi = *(const LAS v2u*)(vp + 32);
            v4u w; w.x = lo.x; w.y = lo.y; w.z = hi.x; w.w = hi.y;
            o[dt] = __builtin_amdgcn_mfma_f32_16x16x32_bf16(__builtin_bit_cast(bf16x8, w), pb[kk], o[dt], 0, 0, 0); }
}
__device__ __forceinline__ void load_q(bf16x8 (&qf)[2], const bf16* qrow, int g) {
    qf[0] = *(const bf16x8*)(qrow + 8 * g); qf[1] = *(const bf16x8*)(qrow + 32 + 8 * g);
}
__device__ __forceinline__ void store_o(bf16* orow, const f32x4 (&o)[4], float scale, int g) {
#ifdef EXP_NOATT
    scale = 0.f;
#endif
#pragma unroll
    for (int dt = 0; dt < 4; ++dt) { v2u w; w.x = pk2(o[dt][0] * scale, o[dt][1] * scale); w.y = pk2(o[dt][2] * scale, o[dt][3] * scale); *(v2u*)(orow + dt * 16 + 4 * g) = w; }
}

__device__ __forceinline__ void banded_unit(LAS unsigned char* lds, const bf16* qb, const bf16* kb, const bf16* vb, int pitch, int tok0, int tstride, int idil0, int maxd, float slope2,
                                            float& m, float& l, f32x4 (&o)[4], int tid) {
    const int lane = tid & 63, w = tid >> 6, fr = lane & 15, g = lane >> 4;
    const int iq = idil0 + 16 * w + fr;
    bf16x8 qf[2]; load_q(qf, qb + (size_t)(tok0 + tstride * iq) * pitch, g);
    m = -1e30f; l = 0.f;
#pragma unroll
    for (int dt = 0; dt < 4; ++dt) o[dt] = (f32x4){0.f, 0.f, 0.f, 0.f};
    const int kt0 = idil0 >= 128 ? 0 : 2;
    Stage st = gload(kb, vb, pitch, tok0, tstride, idil0 - 128 + 64 * kt0, tid);
    for (int kt = kt0; kt < 4; ++kt) {
        const int jd0 = idil0 - 128 + 64 * kt;
        __syncthreads();
        lstore(lds, st, tid);
        __syncthreads();
        if (kt + 1 < 4) st = gload(kb, vb, pitch, tok0, tstride, jd0 + 64, tid);
        const bool poss = (jd0 <= iq) && (jd0 + 63 >= iq - maxd);
        if (__any(poss)) tile_compute(lds, qf, m, l, o, iq - jd0 - 4 * g, true, maxd, 0.125f * LOG2E, slope2, fr, g);
    }
    l += __shfl_xor(l, 16); l += __shfl_xor(l, 32);
}
}

#define XB_TMO      128
#define XB_XCNT(j)  (256  + 64 * (j))
#define XB_XSUB(j)  (1280 + 64 * (j))
#define XB_XGEN(j)  (2304 + 64 * (j))
#define XB_TOP      3328
#define XB_TOPGEN   3392
#define XCD_BAR_WORDS 3456
#define XB_SPIN_CAP (1u << 18)

__device__ __forceinline__ unsigned xb_ld(unsigned* p)              { return __hip_atomic_load(p, __ATOMIC_RELAXED, __HIP_MEMORY_SCOPE_AGENT); }
__device__ __forceinline__ unsigned xb_add(unsigned* p, unsigned v) { return __hip_atomic_fetch_add(p, v, __ATOMIC_RELAXED, __HIP_MEMORY_SCOPE_AGENT); }
__device__ __forceinline__ unsigned xb_xcc_id() { return (unsigned)__builtin_amdgcn_s_getreg((3 << 11) | 20) & 0xFu; }
#define XB_SPIN(cond, bar) do { unsigned _sp = 0; while (cond) { __builtin_amdgcn_s_sleep(1); \
    if ((++_sp & 255u) == 0u) { if (xb_ld(&(bar)[XB_TMO])) break; if (_sp > XB_SPIN_CAP) { atomicAdd(&(bar)[XB_TMO], 1u); break; } } } } while (0)

struct XcdBarrier {
    unsigned* bar; unsigned x;
    volatile LAS unsigned* st;
};

__device__ __forceinline__ XcdBarrier xcd_barrier_post(unsigned* bar, volatile LAS unsigned* st) {
    XcdBarrier b; b.bar = bar; b.x = xb_xcc_id(); b.st = st;
    if (threadIdx.x == 0) (void)xb_add(&bar[XB_XCNT(b.x)], 1u);
    return b;
}
__device__ __forceinline__ void xcd_barrier_complete(unsigned* bar, unsigned x, unsigned& nloc, unsigned& nx) {
    const unsigned G = gridDim.x * gridDim.y * gridDim.z;
    unsigned sum, cnt, mine, sp = 0u;
    for (;;) {
        sum = 0u; cnt = 0u; mine = 0u;
#pragma unroll
        for (unsigned j = 0; j < 16; ++j) { const unsigned c = xb_ld(&bar[XB_XCNT(j)]); sum += c; cnt += (c > 0u) ? 1u : 0u; mine = (j == x) ? c : mine; }
        if (sum == G) break;
        __builtin_amdgcn_s_sleep(1);
        if ((++sp & 255u) == 0u) { if (xb_ld(&bar[XB_TMO])) break; if (sp > XB_SPIN_CAP) { atomicAdd(&bar[XB_TMO], 1u); break; } }
    }
    nloc = mine > 0u ? mine : 1u; nx = cnt > 0u ? cnt : 1u;
}

__device__ __forceinline__ void xcd_barrier(const XcdBarrier& b) {
    asm volatile("s_waitcnt vmcnt(0)" ::: "memory");
    __syncthreads();
    if (threadIdx.x == 0) {
        unsigned* bar = b.bar;
        __builtin_amdgcn_s_waitcnt(0);
        unsigned nloc = b.st[0], nx = b.st[1];
        if (nloc == 0u) { xcd_barrier_complete(bar, b.x, nloc, nx); b.st[0] = nloc; b.st[1] = nx; }
        const unsigned old = xb_add(&bar[XB_XSUB(b.x)], 1u);
        const unsigned gen = old / nloc;
        if (old + 1u == (gen + 1u) * nloc) {
            __builtin_amdgcn_fence(__ATOMIC_RELEASE, "agent");
            asm volatile("s_waitcnt vmcnt(0)" ::: "memory");
            const unsigned og = xb_add(&bar[XB_TOP], 1u);
            const unsigned tg = og / nx;
            if (og + 1u == (tg + 1u) * nx) xb_add(&bar[XB_TOPGEN], 1u);
            else XB_SPIN(xb_ld(&bar[XB_TOPGEN]) == tg, bar);
            __builtin_amdgcn_fence(__ATOMIC_ACQUIRE, "agent");
            xb_add(&bar[XB_XGEN(b.x)], 1u);
            asm volatile("s_waitcnt vmcnt(0)" ::: "memory");
        } else {
            XB_SPIN(xb_ld(&bar[XB_XGEN(b.x)]) == gen, bar);
            __builtin_amdgcn_fence(__ATOMIC_ACQUIRE, "agent");
            asm volatile("s_waitcnt vmcnt(0)" ::: "memory");
        }
    }
    __syncthreads();
}

struct Args { const float* in[20]; float* out; unsigned char* ws; };
enum { I_X = 0, I_P, I_AWQKV, I_ASINK, I_AWO, I_BWQKV, I_BWO, I_CWQKV, I_CWO, I_LN1G, I_LN1B, I_LN2G, I_LN2B, I_PWQ, I_PSUBK, I_PU, I_PV, I_PLEW, I_PLEGW, I_PLEGB, I_OUT, I_WS };
constexpr int PTAB_OFF = 131072 + 1024, XBST_OFF = 131072 + 2048;
__device__ __forceinline__ unsigned long long ldp(LAS unsigned char* lds, int i) {
    volatile LAS unsigned* t = (volatile LAS unsigned*)(lds + PTAB_OFF);
    const unsigned lo = __builtin_amdgcn_readfirstlane(t[2 * i]), hi = __builtin_amdgcn_readfirstlane(t[2 * i + 1]);
    return ((unsigned long long)hi << 32) | lo;
}
#define INP(i) ((const float*)ldp(lds, (i)))
#define WSP() ((unsigned char*)ldp(lds, I_WS))
#define LAUNDER(v) asm volatile("" : "+s"(v))
struct Ctx { int tid, lane, wave, G, bid, gw, NGW; };
__device__ __forceinline__ Ctx mkctx() { Ctx c; int t_ = threadIdx.x; asm volatile("" : "+v"(t_)); c.tid = t_; c.lane = c.tid & 63; c.wave = __builtin_amdgcn_readfirstlane(c.tid >> 6); c.G = gridDim.x; c.bid = blockIdx.x; c.gw = c.bid * NW + c.wave; c.NGW = c.G * NW; return c; }

__device__ __forceinline__ void ph_prologue(LAS unsigned char* lds) {
    const Ctx c = mkctx(); unsigned char* ws = WSP();
    const size_t gtid = (size_t)c.bid * NTHR + c.tid, nthr = (size_t)c.G * NTHR;
    LAS float* scr = (LAS float*)(lds + c.wave * 16384);
    for (int j = 0; j < 2; ++j) {
        p0_transpose(INP(I_AWQKV) + (size_t)j * 1024 * 1280, 1024, 1280, (bf16*)(ws + WS_WQKV_A) + (size_t)j * 1280 * 1024, scr, c.gw, c.NGW, c.lane);
        p0_transpose(INP(I_AWO) + (size_t)j * 1024 * 1024, 1024, 1024, (bf16*)(ws + WS_WO_A) + (size_t)j * 1024 * 1024, scr, c.gw, c.NGW, c.lane);
    }
    p0_transpose(INP(I_BWQKV), 1024, 5120, (bf16*)(ws + WS_WQKV_B), scr, c.gw, c.NGW, c.lane);
    p0_transpose(INP(I_BWO), 1024, 1024, (bf16*)(ws + WS_WO_B), scr, c.gw, c.NGW, c.lane);
    p0_transpose(INP(I_CWQKV), 1024, 3072, (bf16*)(ws + WS_WQKV_C), scr, c.gw, c.NGW, c.lane);
    p0_transpose(INP(I_CWO), 1024, 1024, (bf16*)(ws + WS_WO_C), scr, c.gw, c.NGW, c.lane);
    for (int i = 0; i < DEPTH; ++i) {
        p0_transpose(INP(I_PLEW) + (size_t)i * 256 * 1024, 256, 1024, (bf16*)(ws + WS_PLEW) + (size_t)i * 1024 * 256, scr, c.gw, c.NGW, c.lane);
        p0_transpose(INP(I_PLEGW) + (size_t)i * 1024 * 1024, 1024, 1024, (bf16*)(ws + WS_PLEG) + (size_t)i * 1024 * 1024, scr, c.gw, c.NGW, c.lane);
    }
    p0_convert(INP(I_X), (bf16*)(ws + WS_B0), (size_t)S * D, gtid, nthr);
    p0_convert(INP(I_P), (bf16*)(ws + WS_P), (size_t)DEPTH * S * 256, gtid, nthr);
    p0_convert(INP(I_PU), (bf16*)(ws + WS_U), (size_t)DEPTH * PEER_E * D, gtid, nthr);
    p0_convert(INP(I_PV), (bf16*)(ws + WS_V), (size_t)DEPTH * PEER_E * D, gtid, nthr);
    p0_weff(INP(I_PWQ), INP(I_PSUBK), (bf16*)(ws + WS_WEFF), lds, c.bid, c.G, c.tid);
}
__device__ __forceinline__ bf16* bcur(unsigned char* ws, int li) { return (bf16*)(ws + ((li & 1) ? WS_B1 : WS_B0)); }
__device__ __forceinline__ bf16* both(unsigned char* ws, int li) { return (bf16*)(ws + ((li & 1) ? WS_B0 : WS_B1)); }

__device__ __forceinline__ void ph_qkv(LAS unsigned char* lds, int li) {
    unsigned char* ws = WSP(); const int kind = li % 3, lj = li / 3;
    const int NQKV = kind == 0 ? 1280 : (kind == 1 ? 5120 : 3072);
    const bf16* wqkv = kind == 0 ? (const bf16*)(ws + WS_WQKV_A) + (size_t)lj * 1280 * 1024 : (kind == 1 ? (const bf16*)(ws + WS_WQKV_B) : (const bf16*)(ws + WS_WQKV_C));
    pg8::Gemm g{bcur(ws, li), wqkv, S, NQKV, D}; pg8::StaticOrder So; So.init(S, NQKV, (int)gridDim.x, (int)blockIdx.x);
    pg8::EpiBf16<0> E{(bf16*)(ws + WS_QKV), NQKV, nullptr, 0, 0, 1.f};
    pg8::gemm_phase<pg8::EpiBf16<0>, pg8::StaticOrder, PG8_ALIGN, PG8_SP2>(lds, g, So, E);
}
__device__ __forceinline__ void ph_attn_a(LAS unsigned char* lds, int li) {
    const Ctx c = mkctx(); unsigned char* ws = WSP(); const int lj = li / 3;
    bf16* const QKV = (bf16*)(ws + WS_QKV); bf16* const Ob = (bf16*)(ws + WS_O);
    const float* sinks = INP(I_ASINK) + lj * 16;
    for (int u = c.bid; u < 16 * 128; u += c.G) {
        const int h = u >> 7, qb = u & 127, kvh = h >> 3;
        const float slope = exp2f(-0.5f * (float)(h + 1));
        float m, l; f32x4 o[4];
        att::banded_unit(lds, QKV + h * 64, QKV + 1024 + kvh * 64, QKV + 1152 + kvh * 64, 1280, 0, 1, qb * 128, 127, slope * LOG2E, m, l, o, c.tid);
        const float sk2 = sinks[h] * LOG2E, mf = fmaxf(m, sk2), lf = l * exp2f(m - mf) + exp2f(sk2 - mf);
        const int tok = qb * 128 + 16 * (c.tid >> 6) + (c.lane & 15);
        att::store_o(Ob + (size_t)tok * 1024 + h * 64, o, exp2f(m - mf) / lf, c.lane >> 4);
    }
}
__device__ __forceinline__ void ph_attn_b(LAS unsigned char* lds) {
    const Ctx c = mkctx(); unsigned char* ws = WSP();
    bf16* const QKV = (bf16*)(ws + WS_QKV); bf16* const OG = (bf16*)(ws + WS_OG); float* const LSE = (float*)(ws + WS_LSE);
    for (int u = c.bid; u < 3 * 16 * 128; u += c.G) {
        const int gi = u >> 11, h = (u >> 7) & 15, uu = u & 127;
        const int r = gi == 0 ? 1 : (gi == 1 ? 4 : 16);
        const int cc = uu % r, b = uu / r;
        const float slope = exp2f(-0.5f * (float)(h + 1));
        float m, l; f32x4 o[4];
        att::banded_unit(lds, QKV + gi * 1024 + h * 64, QKV + 3072 + h * 64, QKV + 4096 + h * 64, 5120, cc, r, b * 128, 128, slope * (float)r * LOG2E, m, l, o, c.tid);
        const int tok = cc + r * (b * 128 + 16 * (c.tid >> 6) + (c.lane & 15));
        att::store_o(OG + ((size_t)gi * S + tok) * 1024 + h * 64, o, 1.0f / l, c.lane >> 4);
        if ((c.lane >> 4) == 0) LSE[((size_t)gi * S + tok) * 16 + h] = (m + log2f(l)) * LN2F;
    }
}
__device__ __forceinline__ void ph_merge_b(LAS unsigned char* lds) {
    const Ctx c = mkctx(); unsigned char* ws = WSP();
    const bf16* OG = (const bf16*)(ws + WS_OG); const float* LSE = (const float*)(ws + WS_LSE); bf16* const Ob = (bf16*)(ws + WS_O);
    const size_t gtid = (size_t)c.bid * NTHR + c.tid, nthr = (size_t)c.G * NTHR;
    for (size_t idx = gtid; idx < (size_t)S * 16 * 8; idx += nthr) {
        const int t = (int)(idx >> 7), h = (int)(idx >> 3) & 15, cch = (int)idx & 7;
        const float l0 = LSE[((size_t)0 * S + t) * 16 + h], l1 = LSE[((size_t)1 * S + t) * 16 + h], l2 = LSE[((size_t)2 * S + t) * 16 + h];
        const float mx = fmaxf(l0, fmaxf(l1, l2)); float w0 = __expf(l0 - mx), w1 = __expf(l1 - mx), w2 = __expf(l2 - mx); const float inv = 1.0f / (w0 + w1 + w2);
        w0 *= inv; w1 *= inv; w2 *= inv;
        const size_t off = (size_t)t * 1024 + h * 64 + cch * 8;
        const v4u a = *(const v4u*)(OG + off), bq = *(const v4u*)(OG + (size_t)S * 1024 + off), cq = *(const v4u*)(OG + (size_t)2 * S * 1024 + off);
        v4u o;
#pragma unroll
        for (int e = 0; e < 4; ++e) o[e] = pk2(w0 * bflo(a[e]) + w1 * bflo(bq[e]) + w2 * bflo(cq[e]), w0 * bfhi(a[e]) + w1 * bfhi(bq[e]) + w2 * bfhi(cq[e]));
        *(v4u*)(Ob + off) = o;
    }
}
__device__ __forceinline__ void ph_kmean(LAS unsigned char* lds) {
    const Ctx c = mkctx(); unsigned char* ws = WSP();
    const bf16* QKV = (const bf16*)(ws + WS_QKV); bf16* const KMEAN = (bf16*)(ws + WS_KMEAN);
    const size_t gtid = (size_t)c.bid * NTHR + c.tid, nthr = (size_t)c.G * NTHR;
    for (size_t idx = gtid; idx < 64 * 512; idx += nthr) {
        const int blk = (int)(idx >> 9), cp = (int)idx & 511;
        const bf16* kp = QKV + (size_t)blk * 256 * 3072 + 1024 + cp * 2;
        float s0 = 0.f, s1 = 0.f;
        for (int r = 0; r < 256; ++r) { const unsigned w = *(const unsigned*)(kp + (size_t)r * 3072); s0 += bflo(w); s1 += bfhi(w); }
        *(unsigned*)(KMEAN + blk * 1024 + cp * 2) = pk2(s0 * (1.f / 256.f), s1 * (1.f / 256.f));
    }
}
__device__ __forceinline__ void ph_attn_c(LAS unsigned char* lds) {
    const Ctx c = mkctx(); unsigned char* ws = WSP();
    const bf16* QKV = (const bf16*)(ws + WS_QKV); const bf16* KMEAN = (const bf16*)(ws + WS_KMEAN); bf16* const Ob = (bf16*)(ws + WS_O);
    const int tid = c.tid, lane = c.lane, G = c.G, bid = c.bid;
    const int rounds = (2048 + G - 1) / G;
    for (int rd = 0; rd < rounds; ++rd) {
        const int L = rd * G + ((rd & 1) ? (G - 1 - bid) : bid);
        if (L >= 2048) continue;
        const int qt = 127 - (L >> 4), h = L & 15, qblk = qt >> 1, t0 = qt * 128;
        const int w = tid >> 6, fr = lane & 15, g = lane >> 4;
        const int iq = t0 + 16 * w + fr;
        const bf16* qb = QKV + h * 64; const bf16* kb = QKV + 1024 + h * 64; const bf16* vb = QKV + 2048 + h * 64;
        const float slope2 = exp2f(-0.5f * (float)(h + 1)) * LOG2E;
        bf16x8 qf[2]; att::load_q(qf, qb + (size_t)iq * 3072, g);
        unsigned long long selmask = 0ull, bunion = 0ull;
        if (qblk > 0) {
            __syncthreads();
            { const int row = tid >> 3, ch = tid & 7; *(LAS v4u*)(lds + row * att::KP + ch * 16) = *(const v4u*)(KMEAN + row * 1024 + h * 64 + ch * 8); }
            __syncthreads();
            f32x4 s[4]; att::qk(s, lds, qf, fr, g);
            const int nsel = qblk < 3 ? qblk : 3;
            for (int sr = 0; sr < nsel; ++sr) {
                float best = -INFINITY; int bi = 64;
#pragma unroll
                for (int mt = 0; mt < 4; ++mt)
#pragma unroll
                    for (int r = 0; r < 4; ++r) { const int n = mt * 16 + 4 * g + r; const bool ok = n < qblk && !((selmask >> n) & 1ull);
                        if (ok && (s[mt][r] > best || bi == 64)) { best = s[mt][r]; bi = n; } }
#pragma unroll
                for (int x = 16; x <= 32; x <<= 1) { const float ob = __shfl_xor(best, x); const int oi = __shfl_xor(bi, x);
                    if (oi < 64 && (bi == 64 || ob > best || (ob == best && oi < bi))) { best = ob; bi = oi; } }
                selmask |= 1ull << bi;
            }
            unsigned lo = (unsigned)selmask, hi = (unsigned)(selmask >> 32);
#pragma unroll
            for (int x = 1; x < 16; x <<= 1) { lo |= __shfl_xor(lo, x); hi |= __shfl_xor(hi, x); }
            LAS unsigned* wun = (LAS unsigned*)(lds + att::MISC_OFF);
            if (lane == 0) { wun[2 * w] = lo; wun[2 * w + 1] = hi; }
            __syncthreads();
            unsigned ul = 0, uh = 0;
#pragma unroll
            for (int x = 0; x < 8; ++x) { ul |= wun[2 * x]; uh |= wun[2 * x + 1]; }
            bunion = ((unsigned long long)uh << 32) | ul;
        }
        float m = -1e30f, l = 0.f; f32x4 o[4];
#pragma unroll
        for (int dt = 0; dt < 4; ++dt) o[dt] = (f32x4){0.f, 0.f, 0.f, 0.f};
        const int nown = (t0 + 128 - qblk * 256) / 64;
        unsigned long long todo = bunion;
        int kbcur = todo ? (__ffsll((long long)todo) - 1) : qblk, sub = 0;
        if (todo) todo &= todo - 1;
        att::Stage st = att::gload(kb, vb, 3072, 0, 1, kbcur * 256, tid);
        for (;;) {
            const int jd0 = kbcur * 256 + sub * 64;
            const bool own = kbcur == qblk;
            int nkb = kbcur, nsub = sub + 1; bool more = true;
            if (!own) { if (nsub == 4) { nsub = 0; if (todo) { nkb = __ffsll((long long)todo) - 1; todo &= todo - 1; } else nkb = qblk; } }
            else if (nsub == nown) more = false;
            __syncthreads();
            att::lstore(lds, st, tid);
            __syncthreads();
            if (more) st = att::gload(kb, vb, 3072, 0, 1, nkb * 256 + nsub * 64, tid);
            const bool lane_ok = own ? (jd0 <= iq) : (((selmask >> kbcur) & 1ull) != 0ull);
            if (__any(lane_ok)) att::tile_compute(lds, qf, m, l, o, iq - jd0 - 4 * g, lane_ok, 0x3fffffff, 0.125f * LOG2E, slope2, fr, g);
            if (!more) break;
            kbcur = nkb; sub = nsub;
        }
        l += __shfl_xor(l, 16); l += __shfl_xor(l, 32);
        att::store_o(Ob + (size_t)iq * 1024 + h * 64, o, 1.0f / l, g);
    }
}
__device__ __forceinline__ void ph_oproj(LAS unsigned char* lds, int li) {
    unsigned char* ws = WSP(); const int kind = li % 3, lj = li / 3;
    const bf16* wo = kind == 0 ? (const bf16*)(ws + WS_WO_A) + (size_t)lj * 1024 * 1024 : (kind == 1 ? (const bf16*)(ws + WS_WO_B) : (const bf16*)(ws + WS_WO_C));
    const float* xin = li == 0 ? INP(I_X) : (const float*)(ws + WS_F0);
    pg8::Gemm g{(const bf16*)(ws + WS_O), wo, S, D, D}; pg8::StaticOrder So; So.init(S, D, (int)gridDim.x, (int)blockIdx.x);
    pg8::EpiResid E{xin, (float*)(ws + WS_F1), D, DN_ALPHA};
    pg8::gemm_phase<pg8::EpiResid, pg8::StaticOrder, PG8_ALIGN, PG8_SP2>(lds, g, So, E);
}
__device__ __forceinline__ void ph_ln1(LAS unsigned char* lds, int li) {
    const Ctx c = mkctx(); unsigned char* ws = WSP();
    float* const F1 = (float*)(ws + WS_F1); bf16* const Bc = bcur(ws, li);
    const float* g1 = INP(I_LN1G) + li * D; const float* b1 = INP(I_LN1B) + li * D;
    for (int r = c.gw; r < S; r += c.NGW) ln_row(F1 + (size_t)r * D, g1, b1, F1 + (size_t)r * D, Bc + (size_t)r * D, c.lane);
}
__device__ __forceinline__ void ph_sc(LAS unsigned char* lds, int li) {
    unsigned char* ws = WSP();
    pg8::Gemm g{bcur(ws, li), (const bf16*)(ws + WS_WEFF) + (size_t)li * 2048 * 1024, S, 2048, D}; pg8::StaticOrder So; So.init(S, 2048, (int)gridDim.x, (int)blockIdx.x);
    pg8::EpiF32 E{(float*)(ws + WS_QKV), 2048};
    pg8::gemm_phase<pg8::EpiF32, pg8::StaticOrder, PG8_ALIGN, PG8_SP2>(lds, g, So, E);
}
__device__ __forceinline__ void ph_peer(LAS unsigned char* lds, int li) {
    const Ctx c = mkctx(); unsigned char* ws = WSP();
    const int lane = c.lane, gw = c.gw, NGW = c.NGW;
    const float* SC = (const float*)(ws + WS_QKV); float* const F0 = (float*)(ws + WS_F0); const float* F1 = (const float*)(ws + WS_F1); bf16* const Bcur = bcur(ws, li);
    const bf16* U = (const bf16*)(ws + WS_U) + (size_t)li * PEER_E * D; const bf16* V = (const bf16*)(ws + WS_V) + (size_t)li * PEER_E * D;
    const float* g2 = INP(I_LN2G) + li * D; const float* b2 = INP(I_LN2B) + li * D;
    const int seg = lane >> 4, r = lane & 15;
#pragma unroll 1
    for (int t = gw; t < S; t += NGW) {
        const float* scr = SC + (size_t)t * 2048;
        float tv[4]; int ti[4];
#pragma unroll
        for (int p = 0; p < 4; ++p) {
            const int Gp = 4 * p + seg;
            const float* b = scr + Gp * 128 + r * 8;
            const f32x4 a0 = *(const f32x4*)b, a1 = *(const f32x4*)(b + 4);
            unsigned kk[8];
#pragma unroll
            for (int j = 0; j < 4; ++j) { kk[j] = (sortable(a0[j]) & ~127u) | (unsigned)(127 - (r * 8 + j)); kk[4 + j] = (sortable(a1[j]) & ~127u) | (unsigned)(127 - (r * 8 + 4 + j)); }
#define CE(i, j) { const unsigned hi_ = kk[i] > kk[j] ? kk[i] : kk[j], lo_ = kk[i] > kk[j] ? kk[j] : kk[i]; kk[i] = hi_; kk[j] = lo_; }
            CE(0, 1) CE(2, 3) CE(4, 5) CE(6, 7)  CE(0, 2) CE(1, 3) CE(4, 6) CE(5, 7)  CE(1, 2) CE(5, 6)  CE(0, 4) CE(1, 5) CE(2, 6) CE(3, 7)  CE(2, 4) CE(3, 5)  CE(1, 2) CE(3, 4) CE(5, 6)
#undef CE
            unsigned win = 0u;
#pragma unroll
            for (int rd = 0; rd < 16; ++rd) {
                const unsigned head = kk[0], wk = row_max_u32(head); const bool pop = head == wk;
#pragma unroll
                for (int j = 0; j < 7; ++j) kk[j] = pop ? kk[j + 1] : kk[j];
                kk[7] = pop ? 0u : kk[7];
                if (r == rd) win = wk;
            }
            const int idx = 127 - (int)(win & 127u);
            ti[p] = idx; tv[p] = scr[Gp * 128 + idx];
        }
        float gate[4]; int expert[4];
#pragma unroll
        for (int p = 0; p < 4; ++p) {
            const float v1 = tv[p]; const int i1 = ti[p];
            int pa = 0; float bestv = 0.f; int beste = 0;
            const int srcb = (seg | 1) << 4, myb = seg << 4;
#pragma unroll
            for (int rd = 0; rd < 16; ++rd) {
                const float v2 = __shfl(tv[p], srcb + pa); const int i2 = __shfl(ti[p], srcb + pa);
                const float cand = v1 + v2; const unsigned key = (sortable(cand) & ~15u) | (unsigned)(15 - r);
                const unsigned wk = row_max_u32(key); const int a = 15 - (int)(wk & 15u);
                const int eid = i1 * 128 + i2;
                const float bw = __shfl(cand, myb + a); const int ew = __shfl(eid, myb + a);
                if (r == rd) { bestv = bw; beste = ew; }
                if (r == a) ++pa;
            }
            const float mx = row_max_f32(bestv), e = __expf(bestv - mx), sm = row_sum_f32(e);
            gate[p] = e / sm; expert[p] = beste;
        }
        const v4u xq0 = *(const v4u*)(Bcur + (size_t)t * D + lane * 8), xq1 = *(const v4u*)(Bcur + (size_t)t * D + 512 + lane * 8);
        float hv[4] = {0.f, 0.f, 0.f, 0.f};
#pragma unroll
        for (int p = 0; p < 4; ++p)
#pragma unroll 1
            for (int bb = 0; bb < 4; ++bb) {
                const int L0 = (bb >> 1) * 32 + (bb & 1) * 8;
                v4u ua[8], ub[8];
#pragma unroll
                for (int j = 0; j < 8; ++j) { const int e = __builtin_amdgcn_readlane(expert[p], L0 + j); const bf16* up = U + ((size_t)e << 10) + lane * 8; ua[j] = *(const v4u*)up; ub[j] = *(const v4u*)(up + 512); }
#pragma unroll
                for (int j = 0; j < 8; ++j) {
                    float acc = dot16bf(ua[j], ub[j], xq0, xq1);
                    acc = row_sum_f32(acc); acc += __shfl_xor(acc, 16); acc += __shfl_xor(acc, 32);
                    if (lane == L0 + j) hv[p] = acc;
                }
            }
        float av[4];
#pragma unroll
        for (int p = 0; p < 4; ++p) av[p] = 0.5f * hv[p] * (1.0f + erff(hv[p] * 0.70710678118654752f)) * gate[p];

        float y[16];
#pragma unroll
        for (int q = 0; q < 16; ++q) y[q] = 0.f;
#pragma unroll
        for (int p = 0; p < 4; ++p)
#pragma unroll 1
            for (int bb = 0; bb < 4; ++bb) {
                const int L0 = (bb >> 1) * 32 + (bb & 1) * 8;
                v4u va[8], vb[8];
#pragma unroll
                for (int j = 0; j < 8; ++j) { const int e = __builtin_amdgcn_readlane(expert[p], L0 + j); const bf16* vp = V + ((size_t)e << 10) + lane * 8; va[j] = *(const v4u*)vp; vb[j] = *(const v4u*)(vp + 512); }
#pragma unroll
                for (int j = 0; j < 8; ++j) { const float a = __int_as_float(__builtin_amdgcn_readlane(__float_as_int(av[p]), L0 + j));
#pragma unroll
                    for (int q = 0; q < 4; ++q) { y[2 * q] += a * bflo(va[j][q]); y[2 * q + 1] += a * bfhi(va[j][q]); y[8 + 2 * q] += a * bflo(vb[j][q]); y[8 + 2 * q + 1] += a * bfhi(vb[j][q]); } }
            }
        const float* x1r = F1 + (size_t)t * D;
        float z[16]; float s = 0.f;
#pragma unroll
        for (int hh = 0; hh < 2; ++hh)
#pragma unroll
            for (int q = 0; q < 2; ++q) { const f32x4 xv = *(const f32x4*)(x1r + hh * 512 + lane * 8 + q * 4);
#pragma unroll
                for (int e = 0; e < 4; ++e) {
#ifdef EXP_NOPEER
#ifdef EXP_NONDET
                    const float zz = DN_ALPHA * xv[e] + 0.05f * (float)(__builtin_amdgcn_s_memrealtime() & 15ull);
#else
                    const float zz = DN_ALPHA * xv[e];
#endif
#else
                    const float zz = DN_ALPHA * xv[e] + y[hh * 8 + q * 4 + e];
#endif
 z[hh * 8 + q * 4 + e] = zz; s += zz; } }
        const float mean = wave_sum(s) * (1.f / D); float s2 = 0.f;
#pragma unroll
        for (int q = 0; q < 16; ++q) { z[q] -= mean; s2 += z[q] * z[q]; }
        const float rstd = 1.f / sqrtf(wave_sum(s2) * (1.f / D) + LN_EPS);
#pragma unroll
        for (int hh = 0; hh < 2; ++hh) {
            float ov[8];
#pragma unroll
            for (int q = 0; q < 2; ++q) { const int c0 = hh * 512 + lane * 8 + q * 4; const f32x4 gg = *(const f32x4*)(g2 + c0), bb2 = *(const f32x4*)(b2 + c0); f32x4 ovv;
#pragma unroll
                for (int e = 0; e < 4; ++e) { ovv[e] = z[hh * 8 + q * 4 + e] * rstd * gg[e] + bb2[e]; ov[q * 4 + e] = ovv[e]; }
                *(f32x4*)(F0 + (size_t)t * D + c0) = ovv; }
            v4u w; w.x = pk2(ov[0], ov[1]); w.y = pk2(ov[2], ov[3]); w.z = pk2(ov[4], ov[5]); w.w = pk2(ov[6], ov[7]);
            *(v4u*)(Bcur + (size_t)t * D + hh * 512 + lane * 8) = w;
        }
    }

}
__device__ __forceinline__ void ph_ple_pw(LAS unsigned char* lds, int li) {
    unsigned char* ws = WSP();
    pg8::Gemm g{(const bf16*)(ws + WS_P) + (size_t)li * S * 256, (const bf16*)(ws + WS_PLEW) + (size_t)li * 1024 * 256, S, D, 256}; pg8::StaticOrder So; So.init(S, D, (int)gridDim.x, (int)blockIdx.x);
    pg8::EpiF32 E{(float*)(ws + WS_F1), D};
    pg8::gemm_phase<pg8::EpiF32, pg8::StaticOrder, PG8_ALIGN, PG8_SP2>(lds, g, So, E);
}
__device__ __forceinline__ void ph_ple_gate(LAS unsigned char* lds, int li) {
    unsigned char* ws = WSP();
    float* const F0 = (float*)(ws + WS_F0);
    float* outp = li == DEPTH - 1 ? (float*)ldp(lds, I_OUT) : F0;
    pg8::Gemm g{bcur(ws, li), (const bf16*)(ws + WS_PLEG) + (size_t)li * 1024 * 1024, S, D, D}; pg8::StaticOrder So; So.init(S, D, (int)gridDim.x, (int)blockIdx.x);
    pg8::EpiPle E{F0, (const float*)(ws + WS_F1), INP(I_PLEGB) + li * D, outp, both(ws, li), D};
    pg8::gemm_phase<pg8::EpiPle, pg8::StaticOrder, PG8_ALIGN, PG8_SP2>(lds, g, So, E);
}

#define GRID_SYNC_CG() do { asm volatile("s_waitcnt vmcnt(0)" ::: "memory"); __syncthreads(); grid.sync(); __builtin_amdgcn_fence(__ATOMIC_ACQUIRE, "agent"); asm volatile("s_waitcnt vmcnt(0)" ::: "memory"); __syncthreads(); } while (0)
#define GRID_SYNC() do { XcdBarrier xb_; xb_.bar = (unsigned*)(WSP() + WS_CTL) + 4096; xb_.x = xb_xcc_id(); xb_.st = (volatile LAS unsigned*)(lds + XBST_OFF); xcd_barrier(xb_); } while (0)
__global__ void __launch_bounds__(NTHR, 2) fwd_kernel(Args args) {
    extern __shared__ __attribute__((aligned(16))) unsigned char lds_raw[];
    LAS unsigned char* lds = (LAS unsigned char*)lds_raw;
    cg::grid_group grid = cg::this_grid();
    if (threadIdx.x == 0) {
        LAS unsigned long long* t = (LAS unsigned long long*)(lds + PTAB_OFF);
        t[0] = (unsigned long long)args.in[0]; t[1] = (unsigned long long)args.in[1]; t[2] = (unsigned long long)args.in[2]; t[3] = (unsigned long long)args.in[3];
        t[4] = (unsigned long long)args.in[4]; t[5] = (unsigned long long)args.in[5]; t[6] = (unsigned long long)args.in[6]; t[7] = (unsigned long long)args.in[7];
        t[8] = (unsigned long long)args.in[8]; t[9] = (unsigned long long)args.in[9]; t[10] = (unsigned long long)args.in[10]; t[11] = (unsigned long long)args.in[11];
        t[12] = (unsigned long long)args.in[12]; t[13] = (unsigned long long)args.in[13]; t[14] = (unsigned long long)args.in[14]; t[15] = (unsigned long long)args.in[15];
        t[16] = (unsigned long long)args.in[16]; t[17] = (unsigned long long)args.in[17]; t[18] = (unsigned long long)args.in[18]; t[19] = (unsigned long long)args.in[19];
        t[20] = (unsigned long long)args.out; t[21] = (unsigned long long)args.ws;
    }
    if (threadIdx.x < 2) ((volatile LAS unsigned*)(lds + XBST_OFF))[threadIdx.x] = 0u;
    __syncthreads();
    (void)xcd_barrier_post((unsigned*)args.ws + 4096, (volatile LAS unsigned*)(lds + XBST_OFF));
#ifndef SKIP_PRO
    ph_prologue(lds);
#endif
    GRID_SYNC_CG();
#pragma unroll 1
    for (int li0 = 0; li0 < DEPTH; ++li0) {
        int li = li0;
        LAUNDER(li); ph_qkv(lds, li);
        GRID_SYNC();
#ifndef SKIP_ATT
        LAUNDER(li);
        const int kind = li % 3;
        if (kind == 0) {
#ifndef SKIP_A
            ph_attn_a(lds, li);
#endif
        } else if (kind == 1) {
#ifndef SKIP_B
            ph_attn_b(lds); GRID_SYNC(); ph_merge_b(lds);
#endif
        } else {
#ifndef SKIP_C
            ph_kmean(lds); GRID_SYNC(); ph_attn_c(lds);
#endif
        }
#endif
        GRID_SYNC();
        LAUNDER(li); ph_oproj(lds, li);
        GRID_SYNC();
        LAUNDER(li); ph_ln1(lds, li);
        GRID_SYNC();
        LAUNDER(li); ph_sc(lds, li);
        GRID_SYNC();
#ifndef SKIP_PEER
        LAUNDER(li); ph_peer(lds, li);
#endif
        GRID_SYNC();
        LAUNDER(li); ph_ple_pw(lds, li);
        asm volatile("s_waitcnt vmcnt(0)" ::: "memory"); __syncthreads();
        LAUNDER(li); ph_ple_gate(lds, li);
        if (li0 + 1 < DEPTH) GRID_SYNC();
    }
}

extern "C" void kernel_launch(void* const* d_in, const int* in_sizes, int n_in, void* d_out, int out_size, void* d_ws, size_t ws_size, hipStream_t stream) {
    static int grid = 0;
    if (grid == 0) {
        if (n_in != 20 || out_size != S * D || ws_size < WS_END) { fprintf(stderr, "kernel_launch: unexpected shapes: n_in %d out %d ws %zu (need %zu)\n", n_in, out_size, ws_size, (size_t)WS_END); grid = -1; return; }
        int dev = 0, cus = 0, per_cu = 0;
        hipGetDevice(&dev); hipDeviceGetAttribute(&cus, hipDeviceAttributeMultiprocessorCount, dev);
        if (hipFuncSetAttribute((const void*)fwd_kernel, hipFuncAttributeMaxDynamicSharedMemorySize, LDS_BYTES) != hipSuccess) { fprintf(stderr, "kernel_launch: hipFuncSetAttribute failed\n"); grid = -1; return; }
        if (hipOccupancyMaxActiveBlocksPerMultiprocessor(&per_cu, (const void*)fwd_kernel, NTHR, LDS_BYTES) != hipSuccess || per_cu < 1) { fprintf(stderr, "kernel_launch: occupancy query says %d\n", per_cu); per_cu = 1; }
        (void)hipGetLastError();
        grid = cus;
        fprintf(stderr, "kernel_launch: grid %d (cus %d, per_cu %d)\n", grid, cus, per_cu);
    }
    if (grid < 0) return;
    if (hipMemsetAsync((char*)d_ws + WS_CTL, 0, 65536, stream) != hipSuccess) { fprintf(stderr, "kernel_launch: memset failed\n"); return; }
    Args a{};
    for (int i = 0; i < 20; ++i) a.in[i] = (const float*)d_in[i];
    a.out = (float*)d_out; a.ws = (unsigned char*)d_ws;
    void* kargs[] = {&a};
    const hipError_t e = hipLaunchCooperativeKernel((const void*)fwd_kernel, dim3(grid), dim3(NTHR), kargs, LDS_BYTES, stream);
    if (e != hipSuccess) fprintf(stderr, "kernel_launch: cooperative launch failed: %s (grid %d)\n", hipGetErrorString(e), grid);
}
```

```cpp
#include <hip/hip_runtime.h>
#include <hip/hip_cooperative_groups.h>
#include <cstdio>
#include <cstdint>
namespace cg = cooperative_groups;
namespace pg8 {
#define PG8_LAS __attribute__((address_space(3)))
typedef unsigned short bf16_t;
typedef short bf16x8 __attribute__((ext_vector_type(8)));
typedef float f32x4 __attribute__((ext_vector_type(4)));
typedef unsigned u32x4 __attribute__((ext_vector_type(4)));
constexpr int BM = 256, BK = 64, HALF = 128, HTB = HALF * BK * 2  , STAGE_BYTES = 8 * HTB, NXCD = 8, WGM = 8;

__host__ __device__ __forceinline__ int lds_byte(int r, int c) { const int st = (r >> 4) * 2 + (c >> 5), rr = r & 15, cc = c & 31, ob = rr * 64 + cc * 2; return st * 1024 + (ob ^ (((ob >> 9) & 1) << 5)); }
__host__ __device__ __forceinline__ void stage_rc(int b, int& R, int& C) { const int st = b / 1024, sb = b % 1024, swz = sb ^ (((sb >> 9) & 1) << 5); R = (st >> 1) * 16 + swz / 64; C = (st & 1) * 32 + (swz % 64) / 2; }
__host__ __device__ __forceinline__ int perm32(int rho) { const int n = rho >> 4, i = rho & 15; return 8 * (i >> 2) + 4 * n + (i & 3); }

struct Unit { int pm, pn; };
struct Gemm { const bf16_t* A; const bf16_t* Bt; int M, N, K; };

struct StaticOrder {
    int nM, nN, nwg, G, c;
    __host__ __device__ void init(int M, int N, int G_, int c_) { nM = M / BM; nN = N / BM; nwg = nM * nN; G = G_; c = c_; }
    __host__ __device__ bool next(int i, Unit& u) const {
        const long L = (long)i * G + c; if (L >= nwg) return false;
        int wgid = (int)L; { const int q = nwg / NXCD, r = nwg % NXCD, xcd = wgid % NXCD, off = wgid / NXCD; wgid = (xcd < r ? xcd * (q + 1) : r * (q + 1) + (xcd - r) * q) + off; }
        const int nig = WGM * nN, gid = wgid / nig, fm = gid * WGM, gsz = (nM - fm) < WGM ? (nM - fm) : WGM;
        u.pm = fm + ((wgid % nig) % gsz); u.pn = (wgid % nig) / gsz; return true;
    }
    __device__ __forceinline__ void a_ready(const Unit&) const {}
    __device__ __forceinline__ void done(const Unit&) const {}
};

__device__ __forceinline__ unsigned cvt_pk_bf16(float lo, float hi) { unsigned r; asm volatile("v_cvt_pk_bf16_f32 %0, %1, %2" : "=v"(r) : "v"(lo), "v"(hi)); return r; }
typedef float f32x2 __attribute__((ext_vector_type(2)));
__device__ __forceinline__ f32x2 gelu_pk(f32x2 v) {
    const f32x2 av = __builtin_elementwise_abs(v), d = av * 0.2316418882f + 1.0f;
    f32x2 t; t.x = __builtin_amdgcn_rcpf(d.x); t.y = __builtin_amdgcn_rcpf(d.y);
    f32x2 q = t * 0.5307027145f + (-0.7265760135f); q = q * t + 0.7107068705f; q = q * t + (-0.142248368f); q = q * t + 0.127414796f; q = q * t;
    const f32x2 s = (v * v) * (-0.72134752044f);
    f32x2 e; e.x = __builtin_amdgcn_exp2f(s.x); e.y = __builtin_amdgcn_exp2f(s.y);
    const f32x2 m = v * (q * e), r = v - m;
    f32x2 o; o.x = v.x < 0.f ? m.x : r.x; o.y = v.y < 0.f ? m.y : r.y; return o;
}

template <int ACT  > struct EpiBf16 {
    static constexpr bool PERM = true, AFTER_DRAIN = false; static_assert(ACT == 0 || ACT == 1, "EpiBf16: ACT is 0 (none) or 1 (gelu_pk)");
    bf16_t* O; int ldc; const float* bias; int split_cols; size_t split_stride; float scale0;
    __device__ __forceinline__ void operator()(const f32x4 (&acc)[2][2][4][2], const Unit& u, int wr, int wc, int fr, int fq) const {
        const int row0 = u.pm * BM + wr * 64 + fr; int colt = u.pn * BM; bf16_t* base = O;
        float sc = 1.f; if (split_cols) { const int t = colt / split_cols; base += (size_t)t * split_stride; colt -= t * split_cols; if (t == 0) sc = scale0; }
        const int col0 = colt + wc * 32 + 8 * fq, bcol0 = u.pn * BM + wc * 32 + 8 * fq;
        f32x4 bv[2][2];
#pragma unroll
        for (int bj = 0; bj < 2; ++bj)
#pragma unroll
            for (int n = 0; n < 2; ++n) bv[bj][n] = bias ? *(const f32x4*)(bias + bcol0 + bj * HALF + 4 * n) : (f32x4){0.f, 0.f, 0.f, 0.f};
#pragma unroll
        for (int ai = 0; ai < 2; ++ai)
#pragma unroll
            for (int m = 0; m < 4; ++m) { bf16_t* rowp = base + (size_t)(row0 + ai * HALF + m * 16) * ldc + col0;
#pragma unroll
                for (int bj = 0; bj < 2; ++bj) { f32x4 v0 = acc[ai][bj][m][0] + bv[bj][0], v1 = acc[ai][bj][m][1] + bv[bj][1];
                    if (ACT == 1) { f32x2 a = gelu_pk((f32x2){v0[0], v0[1]}), b = gelu_pk((f32x2){v0[2], v0[3]}), c = gelu_pk((f32x2){v1[0], v1[1]}), d = gelu_pk((f32x2){v1[2], v1[3]});
                        v0 = (f32x4){a.x, a.y, b.x, b.y}; v1 = (f32x4){c.x, c.y, d.x, d.y}; }
                    v0 = v0 * sc; v1 = v1 * sc; u32x4 w; w.x = cvt_pk_bf16(v0[0], v0[1]); w.y = cvt_pk_bf16(v0[2], v0[3]); w.z = cvt_pk_bf16(v1[0], v1[1]); w.w = cvt_pk_bf16(v1[2], v1[3]);
                    *(u32x4*)(rowp + bj * HALF) = w; } }
    }
};
typedef unsigned u32x2e __attribute__((ext_vector_type(2)));
struct EpiF32 {
    static constexpr bool PERM = false, AFTER_DRAIN = false;
    float* O; int ldc;
    __device__ __forceinline__ void operator()(const f32x4 (&acc)[2][2][4][2], const Unit& u, int wr, int wc, int fr, int fq) const {
        const int col0 = u.pn * BM + wc * 32 + 4 * fq;
#pragma unroll
        for (int ai = 0; ai < 2; ++ai)
#pragma unroll
            for (int m = 0; m < 4; ++m) { const size_t off = (size_t)(u.pm * BM + ai * HALF + wr * 64 + m * 16 + fr) * ldc + col0;
#pragma unroll
                for (int bj = 0; bj < 2; ++bj)
#pragma unroll
                    for (int n = 0; n < 2; ++n) *(f32x4*)(O + off + bj * HALF + n * 16) = acc[ai][bj][m][n]; }
    }
};
struct EpiResid {
    static constexpr bool PERM = false, AFTER_DRAIN = false;
    const float* X; float* Z; int ldc; float alpha;
    __device__ __forceinline__ void operator()(const f32x4 (&acc)[2][2][4][2], const Unit& u, int wr, int wc, int fr, int fq) const {
        const int col0 = u.pn * BM + wc * 32 + 4 * fq;
#pragma unroll
        for (int ai = 0; ai < 2; ++ai)
#pragma unroll
            for (int m = 0; m < 4; ++m) { const size_t off = (size_t)(u.pm * BM + ai * HALF + wr * 64 + m * 16 + fr) * ldc + col0;
#pragma unroll
                for (int bj = 0; bj < 2; ++bj)
#pragma unroll
                    for (int n = 0; n < 2; ++n) { const f32x4 xv = *(const f32x4*)(X + off + bj * HALF + n * 16); *(f32x4*)(Z + off + bj * HALF + n * 16) = xv * alpha + acc[ai][bj][m][n]; } }
    }
};
struct EpiPle {
    static constexpr bool PERM = false, AFTER_DRAIN = false;
    const float* X2; const float* PW; const float* bg; float* OUT; bf16_t* OUTB; int ldc;
    __device__ __forceinline__ void operator()(const f32x4 (&acc)[2][2][4][2], const Unit& u, int wr, int wc, int fr, int fq) const {
        const int col0 = u.pn * BM + wc * 32 + 4 * fq;
#pragma unroll
        for (int ai = 0; ai < 2; ++ai)
#pragma unroll
            for (int m = 0; m < 4; ++m) { const size_t off = (size_t)(u.pm * BM + ai * HALF + wr * 64 + m * 16 + fr) * ldc + col0;
#pragma unroll
                for (int bj = 0; bj < 2; ++bj)
#pragma unroll
                    for (int n = 0; n < 2; ++n) { const int co = bj * HALF + n * 16;
                        const f32x4 xv = *(const f32x4*)(X2 + off + co), pw = *(const f32x4*)(PW + off + co), bv = *(const f32x4*)(bg + col0 + co);
                        const f32x4 a = acc[ai][bj][m][n] + bv; f32x4 o;
#pragma unroll
                        for (int e = 0; e < 4; ++e) { const float sg = 1.0f / (1.0f + __expf(-a[e])); o[e] = xv[e] + sg * pw[e]; }
                        *(f32x4*)(OUT + off + co) = o;
                        u32x2e w; w.x = cvt_pk_bf16(o[0], o[1]); w.y = cvt_pk_bf16(o[2], o[3]); *(u32x2e*)(OUTB + off + co) = w; } }
    }
};
template <class Epi, class Sched, bool ALIGN_EPI = false, bool SP2 = false>
__device__ __forceinline__ void gemm_phase(PG8_LAS unsigned char* lds, const Gemm g, const Sched& S, const Epi& E) {
    int tid_ = threadIdx.x; asm volatile("" : "+v"(tid_));
    const int tid = tid_, wid = __builtin_amdgcn_readfirstlane(tid >> 6), lane = tid & 63, wr = wid >> 2, wc = wid & 3, fr = lane & 15, fq = lane >> 4;
    const int K = g.K, nt = K / BK;
    unsigned voffA[2], voffB[2];
#pragma unroll
    for (int i = 0; i < 2; ++i) { int R, C; stage_rc(tid * 16 + i * 8192, R, C); const int Rb = Epi::PERM ? ((R & ~31) + perm32(R & 31)) : R;
        voffA[i] = (unsigned)(R * K + C) * 2u; voffB[i] = (unsigned)(Rb * K + C) * 2u; }
    const size_t kstep = (size_t)(BK * 2);
    const size_t hstep = (size_t)HALF * K * 2;
    const size_t tstep = 2 * hstep;
    const unsigned ldsw = (unsigned)wid * 1024u;
    const int aoff = lds_byte(wr * 64 + fr, fq * 8), boff = lds_byte(wc * 32 + fr, fq * 8);
#define PG8_SA(b, h) (((b) * 2 + (h)) * HTB)
#define PG8_SB(b, h) ((4 + (b) * 2 + (h)) * HTB)
#define PG8_STAGE(bufoff, gbase, voff) do { _Pragma("unroll") for (int _i = 0; _i < 2; ++_i) \
        __builtin_amdgcn_global_load_lds((const unsigned*)((const char*)(gbase) + (voff)[_i]), (PG8_LAS unsigned*)(lds + (bufoff) + ldsw + _i * 8192), 16, 0, 0); } while (0)
#define PG8_LDA(dst, b, h) do { _Pragma("unroll") for (int m = 0; m < 4; ++m) _Pragma("unroll") for (int k = 0; k < 2; ++k) dst[m][k] = *(const PG8_LAS bf16x8*)(lds + PG8_SA(b, h) + aoff + m * 2048 + k * 1024); } while (0)
#define PG8_LDB(dst, b, h) do { _Pragma("unroll") for (int n = 0; n < 2; ++n) _Pragma("unroll") for (int k = 0; k < 2; ++k) dst[n][k] = *(const PG8_LAS bf16x8*)(lds + PG8_SB(b, h) + boff + n * 2048 + k * 1024); } while (0)
#define PG8_MMA(ai, bj, At, Bt) do { __builtin_amdgcn_s_setprio(1); _Pragma("unroll") for (int m = 0; m < 4; ++m) _Pragma("unroll") for (int n = 0; n < 2; ++n) _Pragma("unroll") for (int k = 0; k < 2; ++k) \
        acc[ai][bj][m][n] = __builtin_amdgcn_mfma_f32_16x16x32_bf16(Bt[n][k], At[m][k], acc[ai][bj][m][n], 0, 0, 0); __builtin_amdgcn_s_setprio(0); } while (0)
#define PG8_WAIT_V(n) asm volatile("s_waitcnt vmcnt(" #n ")" ::: "memory")
#define PG8_WAIT_L(n) asm volatile("s_waitcnt lgkmcnt(" #n ")" ::: "memory")
#define PG8_BAR __builtin_amdgcn_s_barrier()
#define PG8_SCHED __builtin_amdgcn_sched_barrier(0)
    Unit cur, nxt; int ui = 0;
    if (!S.next(0, cur)) return;
    f32x4 acc[2][2][4][2];
#pragma unroll
    for (int a = 0; a < 2; ++a)
#pragma unroll
        for (int b = 0; b < 2; ++b)
#pragma unroll
            for (int m = 0; m < 4; ++m)
#pragma unroll
                for (int n = 0; n < 2; ++n) acc[a][b][m][n] = (f32x4){0.f, 0.f, 0.f, 0.f};
    bf16x8 At[4][2], B0[2][2], B1[2][2];
    const char* cA = (const char*)g.A + (size_t)cur.pm * tstep; const char* cB = (const char*)g.Bt + (size_t)cur.pn * tstep;
    S.a_ready(cur);
    if constexpr (SP2) {
        PG8_STAGE(PG8_SB(0, 0), cB, voffB); PG8_STAGE(PG8_SB(0, 1), cB + hstep, voffB); PG8_STAGE(PG8_SA(0, 0), cA, voffA); PG8_STAGE(PG8_SA(0, 1), cA + hstep, voffA);
        if (wr == 1) PG8_BAR;
        PG8_WAIT_V(2); PG8_BAR;
        PG8_STAGE(PG8_SB(1, 0), cB + kstep, voffB); PG8_STAGE(PG8_SA(1, 0), cA + kstep, voffA); PG8_STAGE(PG8_SB(1, 1), cB + hstep + kstep, voffB);
        PG8_WAIT_V(6); PG8_BAR;
    } else {
        PG8_STAGE(PG8_SB(0, 0), cB, voffB); PG8_STAGE(PG8_SA(0, 0), cA, voffA); PG8_STAGE(PG8_SB(0, 1), cB + hstep, voffB); PG8_STAGE(PG8_SA(0, 1), cA + hstep, voffA);
        if (wr == 1) PG8_BAR;
        PG8_WAIT_V(4); PG8_BAR;
        PG8_STAGE(PG8_SB(1, 0), cB + kstep, voffB); PG8_STAGE(PG8_SA(1, 0), cA + kstep, voffA); PG8_STAGE(PG8_SB(1, 1), cB + hstep + kstep, voffB);
        PG8_WAIT_V(6); PG8_BAR;
    }
    for (;;) {
        const bool has_next = S.next(ui + 1, nxt);
        const char* nA = has_next ? (const char*)g.A + (size_t)nxt.pm * tstep : cA; const char* nB = has_next ? (const char*)g.Bt + (size_t)nxt.pn * tstep : cB;
        for (int t = 0; t < nt; t += 2) {
            const bool last = (t == nt - 2);
            const char* a1 = cA + (size_t)(t + 1) * kstep;
            const char* a2 = last ? nA : cA + (size_t)(t + 2) * kstep; const char* b2 = last ? nB : cB + (size_t)(t + 2) * kstep;
            const char* a3 = a2 + kstep; const char* b3 = b2 + kstep;
            if (last && has_next) S.a_ready(nxt);
            if constexpr (SP2) {
            PG8_LDB(B0, 0, 0); PG8_LDB(B1, 0, 1); PG8_SCHED; PG8_LDA(At, 0, 0); PG8_STAGE(PG8_SA(1, 1), a1 + hstep, voffA);
            PG8_WAIT_V(8); PG8_WAIT_L(0); PG8_BAR; PG8_MMA(0, 0, At, B0); PG8_MMA(0, 1, At, B1); PG8_BAR; PG8_SCHED;
            PG8_LDA(At, 0, 1); PG8_STAGE(PG8_SB(0, 0), b2, voffB); PG8_STAGE(PG8_SB(0, 1), b2 + hstep, voffB); PG8_STAGE(PG8_SA(0, 0), a2, voffA);
            PG8_WAIT_V(8); PG8_WAIT_L(0); PG8_BAR; PG8_MMA(1, 0, At, B0); PG8_MMA(1, 1, At, B1); PG8_BAR; PG8_SCHED;
            PG8_LDB(B0, 1, 0); PG8_LDB(B1, 1, 1); PG8_SCHED; PG8_LDA(At, 1, 0); PG8_STAGE(PG8_SA(0, 1), a2 + hstep, voffA);
            PG8_WAIT_V(8); PG8_WAIT_L(0); PG8_BAR; PG8_MMA(0, 0, At, B0); PG8_MMA(0, 1, At, B1); PG8_BAR; PG8_SCHED;
            PG8_LDA(At, 1, 1); PG8_STAGE(PG8_SB(1, 0), b3, voffB); PG8_STAGE(PG8_SB(1, 1), b3 + hstep, voffB); PG8_STAGE(PG8_SA(1, 0), a3, voffA);
            PG8_WAIT_V(8); PG8_WAIT_L(0); PG8_BAR; PG8_MMA(1, 0, At, B0); PG8_MMA(1, 1, At, B1); PG8_BAR; PG8_SCHED;
            } else {
            PG8_LDB(B0, 0, 0); PG8_SCHED; PG8_LDA(At, 0, 0); PG8_STAGE(PG8_SA(1, 1), a1 + hstep, voffA);
            PG8_WAIT_L(8); PG8_BAR; PG8_WAIT_L(0); PG8_MMA(0, 0, At, B0); PG8_BAR; PG8_SCHED;
            PG8_LDB(B1, 0, 1); PG8_STAGE(PG8_SB(0, 0), b2, voffB);
            PG8_BAR; PG8_WAIT_L(0); PG8_MMA(0, 1, At, B1); PG8_BAR;
            PG8_LDA(At, 0, 1); PG8_STAGE(PG8_SA(0, 0), a2, voffA);
            PG8_BAR; PG8_WAIT_L(0); PG8_MMA(1, 0, At, B0); PG8_BAR; PG8_SCHED;
            PG8_STAGE(PG8_SB(0, 1), b2 + hstep, voffB);
            PG8_WAIT_V(6); PG8_BAR; PG8_MMA(1, 1, At, B1); PG8_BAR;
            PG8_LDB(B0, 1, 0); PG8_SCHED; PG8_LDA(At, 1, 0); PG8_STAGE(PG8_SA(0, 1), a2 + hstep, voffA);
            PG8_WAIT_L(8); PG8_BAR; PG8_WAIT_L(0); PG8_MMA(0, 0, At, B0); PG8_BAR; PG8_SCHED;
            PG8_LDB(B1, 1, 1); PG8_STAGE(PG8_SB(1, 0), b3, voffB);
            PG8_BAR; PG8_WAIT_L(0); PG8_MMA(0, 1, At, B1); PG8_BAR;
            PG8_LDA(At, 1, 1); PG8_STAGE(PG8_SA(1, 0), a3, voffA);
            PG8_BAR; PG8_WAIT_L(0); PG8_MMA(1, 0, At, B0); PG8_BAR; PG8_SCHED;
            PG8_STAGE(PG8_SB(1, 1), b3 + hstep, voffB);
            PG8_WAIT_V(6); PG8_BAR; PG8_MMA(1, 1, At, B1); PG8_BAR;
            }
        }
        if constexpr (ALIGN_EPI) { if (wr == 0) PG8_BAR; }
        if constexpr (!Epi::AFTER_DRAIN) { E(acc, cur, wr, wc, fr, fq); S.done(cur); }
        if (!has_next) break;
#pragma unroll
        for (int a = 0; a < 2; ++a)
#pragma unroll
            for (int b = 0; b < 2; ++b)
#pragma unroll
                for (int m = 0; m < 4; ++m)
#pragma unroll
                    for (int n = 0; n < 2; ++n) acc[a][b][m][n] = (f32x4){0.f, 0.f, 0.f, 0.f};
        cur = nxt; cA = nA; cB = nB; ++ui;
        if constexpr (ALIGN_EPI) { if (wr == 1) PG8_BAR; }
    }
    PG8_WAIT_V(0);
    if constexpr (!ALIGN_EPI) { if (wr == 0) PG8_BAR; }
    PG8_BAR;
    if constexpr (Epi::AFTER_DRAIN) { E.fused(acc, cur, wr, wc, fr, fq, lds, wid, lane); S.done(cur); }
#undef PG8_SA
#undef PG8_SB
#undef PG8_STAGE
#undef PG8_LDA
#undef PG8_LDB
#undef PG8_MMA
#undef PG8_WAIT_V
#undef PG8_WAIT_L
#undef PG8_BAR
#undef PG8_SCHED
}
}
#ifndef PG8_SP2
#define PG8_SP2 true
#endif
#ifndef PG8_ALIGN
#define PG8_ALIGN true
#endif
constexpr int S = 16384, D = 1024, DEPTH = 4, NW = 8, NTHR = 512;
constexpr int PEER_E = 16384;
constexpr float LN_EPS = 1e-5f;
constexpr float DN_ALPHA = 1.681792830507429f;
constexpr float LOG2E = 1.4426950408889634f, LN2F = 0.6931471805599453f;
constexpr size_t MiB = 1u << 20;
constexpr size_t WS_CTL = 0;
constexpr size_t WS_WQKV_A = 1 * MiB;
constexpr size_t WS_WO_A = WS_WQKV_A + 5 * MiB;
constexpr size_t WS_WQKV_B = WS_WO_A + 4 * MiB;
constexpr size_t WS_WO_B = WS_WQKV_B + 10 * MiB;
constexpr size_t WS_WQKV_C = WS_WO_B + 2 * MiB;
constexpr size_t WS_WO_C = WS_WQKV_C + 6 * MiB;
constexpr size_t WS_WEFF = WS_WO_C + 2 * MiB;
constexpr size_t WS_PLEW = WS_WEFF + 16 * MiB;
constexpr size_t WS_PLEG = WS_PLEW + 2 * MiB;
constexpr size_t WS_KMEAN = WS_PLEG + 8 * MiB;
constexpr size_t WS_LSE = WS_KMEAN + 1 * MiB;
constexpr size_t WS_U = 64 * MiB;
constexpr size_t WS_V = WS_U + 128 * MiB;
constexpr size_t WS_P = WS_V + 128 * MiB;
constexpr size_t WS_F0 = WS_P + 32 * MiB;
constexpr size_t WS_F1 = WS_F0 + 64 * MiB;
constexpr size_t WS_B0 = WS_F1 + 64 * MiB;
constexpr size_t WS_B1 = WS_B0 + 32 * MiB;
constexpr size_t WS_QKV = WS_B1 + 32 * MiB;
constexpr size_t WS_O = WS_QKV + 160 * MiB;
constexpr size_t WS_OG = WS_O + 32 * MiB;
constexpr size_t WS_END = WS_OG + 96 * MiB;
static_assert(WS_LSE + 4 * MiB <= WS_U, "ws map");

constexpr int LDS_BYTES = 147456;

#define GAS __attribute__((address_space(1)))
#define LAS __attribute__((address_space(3)))
typedef unsigned short bf16;
typedef unsigned v4u __attribute__((ext_vector_type(4)));
typedef unsigned v2u __attribute__((ext_vector_type(2)));
typedef float f32x4 __attribute__((ext_vector_type(4)));
typedef short bf16x8 __attribute__((ext_vector_type(8)));
typedef float f32x2 __attribute__((ext_vector_type(2)));
typedef __bf16 bf2_t __attribute__((ext_vector_type(2)));

__device__ __forceinline__ unsigned f2bf(float f) { unsigned u = __builtin_bit_cast(unsigned, f); return (u + 0x7fffu + ((u >> 16) & 1u)) >> 16; }
__device__ __forceinline__ unsigned pk2(float lo, float hi) { return f2bf(lo) | (f2bf(hi) << 16); }
__device__ __forceinline__ float bflo(unsigned w) { return __uint_as_float(w << 16); }
__device__ __forceinline__ float bfhi(unsigned w) { return __uint_as_float(w & 0xffff0000u); }
__device__ __forceinline__ float wave_sum(float v) {
#pragma unroll
    for (int o = 1; o < 64; o <<= 1) v += __shfl_xor(v, o);
    return v;
}
#define DPPI(x, ctl) __builtin_amdgcn_update_dpp(0, (int)(x), (ctl), 0xF, 0xF, true)
__device__ __forceinline__ unsigned row_max_u32(unsigned x) {
    unsigned y;
    y = (unsigned)DPPI(x, 0xB1); x = x > y ? x : y;
    y = (unsigned)DPPI(x, 0x4E); x = x > y ? x : y;
    y = (unsigned)DPPI(x, 0x141); x = x > y ? x : y;
    y = (unsigned)DPPI(x, 0x140); x = x > y ? x : y;
    return x;
}
__device__ __forceinline__ float row_max_f32(float x) {
    x = fmaxf(x, __int_as_float(DPPI(__float_as_int(x), 0xB1)));
    x = fmaxf(x, __int_as_float(DPPI(__float_as_int(x), 0x4E)));
    x = fmaxf(x, __int_as_float(DPPI(__float_as_int(x), 0x141)));
    x = fmaxf(x, __int_as_float(DPPI(__float_as_int(x), 0x140)));
    return x;
}
__device__ __forceinline__ float row_sum_f32(float x) {
    x += __int_as_float(DPPI(__float_as_int(x), 0xB1));
    x += __int_as_float(DPPI(__float_as_int(x), 0x4E));
    x += __int_as_float(DPPI(__float_as_int(x), 0x141));
    x += __int_as_float(DPPI(__float_as_int(x), 0x140));
    return x;
}
__device__ __forceinline__ float dot16bf(v4u a0, v4u a1, v4u b0, v4u b1) {
    float acc = 0.f;
    asm volatile("s_nop 1\n\tv_dot2c_f32_bf16 %0, %1, %9\n\tv_dot2c_f32_bf16 %0, %2, %10\n\tv_dot2c_f32_bf16 %0, %3, %11\n\tv_dot2c_f32_bf16 %0, %4, %12\n\t"
                 "v_dot2c_f32_bf16 %0, %5, %13\n\tv_dot2c_f32_bf16 %0, %6, %14\n\tv_dot2c_f32_bf16 %0, %7, %15\n\tv_dot2c_f32_bf16 %0, %8, %16\n\ts_nop 2"
                 : "+v"(acc)
                 : "v"(a0.x), "v"(a0.y), "v"(a0.z), "v"(a0.w), "v"(a1.x), "v"(a1.y), "v"(a1.z), "v"(a1.w),
                   "v"(b0.x), "v"(b0.y), "v"(b0.z), "v"(b0.w), "v"(b1.x), "v"(b1.y), "v"(b1.z), "v"(b1.w));
    return acc;
}
__device__ __forceinline__ unsigned sortable(float f) { const unsigned u = __float_as_uint(f); return (u & 0x80000000u) ? ~u : (u | 0x80000000u); }

__device__ __forceinline__ void p0_transpose_item(const float* W, int K, int N, bf16* WT, LAS float* scr, int item, int lane) {
    const int nblk = N / 32, kb = item / nblk, nb = item % nblk, k0 = 64 * kb, n0 = 32 * nb;
#pragma unroll 8
    for (int i = 0; i < 32; ++i) { const int kk = 2 * i + (lane >> 5); scr[kk * 33 + (lane & 31)] = W[(size_t)(k0 + kk) * N + n0 + (lane & 31)]; }
    asm volatile("s_waitcnt lgkmcnt(0)" ::: "memory");
    const int c = lane & 7;
#pragma unroll
    for (int j = 0; j < 4; ++j) { const int n = (lane >> 3) + 8 * j; const LAS float* s = scr + (8 * c) * 33 + n;
        v4u o; o.x = pk2(s[0 * 33], s[1 * 33]); o.y = pk2(s[2 * 33], s[3 * 33]); o.z = pk2(s[4 * 33], s[5 * 33]); o.w = pk2(s[6 * 33], s[7 * 33]);
        *(v4u*)(WT + (size_t)(n0 + n) * K + k0 + 8 * c) = o; }
    asm volatile("s_waitcnt lgkmcnt(0)" ::: "memory");
}
__device__ __forceinline__ void p0_transpose(const float* W, int K, int N, bf16* WT, LAS float* scr, int gw, int NGW, int lane) {
    const int items = (K / 64) * (N / 32);
    for (int it = gw; it < items; it += NGW) p0_transpose_item(W, K, N, WT, scr, it, lane);
}
__device__ __forceinline__ void p0_convert(const float* src, bf16* dst, size_t n, size_t gtid, size_t nthr) {
    const size_t n8 = n / 8;
    for (size_t i = gtid; i < n8; i += nthr) {
        const f32x4 a = *(const f32x4*)(src + i * 8), b = *(const f32x4*)(src + i * 8 + 4);
        v4u o; o.x = pk2(a.x, a.y); o.y = pk2(a.z, a.w); o.z = pk2(b.x, b.y); o.w = pk2(b.z, b.w);
        *(v4u*)(dst + i * 8) = o;
    }
}
__device__ __forceinline__ void p0_convert8(const float* src, unsigned char* dst, size_t n, float scale, size_t gtid, size_t nthr) {
    const size_t n16 = n / 16;
    for (size_t i = gtid; i < n16; i += nthr) {
        v4u o;
#pragma unroll
        for (int q = 0; q < 4; ++q) { const f32x4 a = *(const f32x4*)(src + i * 16 + q * 4);
            int w = __builtin_amdgcn_cvt_pk_fp8_f32(a.x * scale, a.y * scale, 0, false); w = __builtin_amdgcn_cvt_pk_fp8_f32(a.z * scale, a.w * scale, w, true); o[q] = (unsigned)w; }
        *(v4u*)(dst + i * 16) = o;
    }
}
__device__ __forceinline__ void p0_weff(const float* wq, const float* subk, bf16* weff, LAS unsigned char* lds, int bid, int G, int tid) {
    LAS float* SK = (LAS float*)lds;
    LAS float* WQ = SK + 128 * 129;
    for (int unit = bid; unit < 256; unit += G) {
        const int i = unit >> 6, hc = (unit >> 2) & 15, kq = unit & 3, c = hc & 1;
        __syncthreads();
        const float* sk = subk + ((size_t)(i * 2 + c) * 128) * 128;
        for (int idx = tid; idx < 128 * 128; idx += NTHR) SK[(idx >> 7) * 129 + (idx & 127)] = sk[idx];
        const int k = tid & 127, kg = tid >> 7;
        for (int kt = 0; kt < 8; ++kt) {
            const int kk0 = kq * 256 + kt * 32;
            __syncthreads();
            for (int idx = tid; idx < 32 * 128; idx += NTHR) WQ[(idx >> 7) * 129 + (idx & 127)] = wq[((size_t)i * 1024 + kk0 + (idx >> 7)) * 2048 + hc * 128 + (idx & 127)];
            __syncthreads();
            float acc[8];
#pragma unroll
            for (int j = 0; j < 8; ++j) acc[j] = 0.f;
            for (int d = 0; d < 128; ++d) { const float a = SK[k * 129 + d];
#pragma unroll
                for (int j = 0; j < 8; ++j) acc[j] += a * WQ[(kg * 8 + j) * 129 + d]; }
            v4u o; o.x = pk2(acc[0], acc[1]); o.y = pk2(acc[2], acc[3]); o.z = pk2(acc[4], acc[5]); o.w = pk2(acc[6], acc[7]);
            *(v4u*)(weff + ((size_t)i * 2048 + hc * 128 + k) * 1024 + kk0 + kg * 8) = o;
        }
    }
    __syncthreads();
}

__device__ __forceinline__ void ln_row(const float* zrow, const float* g, const float* b, float* orow, bf16* obrow, int lane) {
    const f32x4* zr = (const f32x4*)zrow + lane;
    f32x4 v[4]; float s = 0.f;
#pragma unroll
    for (int j = 0; j < 4; ++j) { v[j] = zr[64 * j]; s += (v[j].x + v[j].y) + (v[j].z + v[j].w); }
    const float mean = wave_sum(s) * (1.f / D); float s2 = 0.f;
#pragma unroll
    for (int j = 0; j < 4; ++j) { v[j] = v[j] - mean; s2 += (v[j].x * v[j].x + v[j].y * v[j].y) + (v[j].z * v[j].z + v[j].w * v[j].w); }
    const float rstd = 1.f / sqrtf(wave_sum(s2) * (1.f / D) + LN_EPS);
#pragma unroll
    for (int j = 0; j < 4; ++j) { const f32x4 gg = ((const f32x4*)g + lane)[64 * j], bb = ((const f32x4*)b + lane)[64 * j];
        const f32x4 o = v[j] * rstd * gg + bb; ((f32x4*)orow + lane)[64 * j] = o;
        v2u w; w.x = pk2(o.x, o.y); w.y = pk2(o.z, o.w); ((v2u*)obrow + lane)[64 * j] = w; }
}

namespace att {
constexpr int KP = 144;
constexpr int VT_OFF = 64 * KP;
constexpr int MISC_OFF = 2 * 64 * KP;
struct Stage { v4u k, v; };
__device__ __forceinline__ Stage gload(const bf16* kb, const bf16* vb, int pitch, int tok0, int tstride, int jd0, int tid) {
    Stage s; const int row = tid >> 3, ch = tid & 7, key = tid & 63, vc = tid >> 6;
    s.k = *(const v4u*)(kb + (size_t)(tok0 + tstride * (jd0 + row)) * pitch + ch * 8);
    s.v = *(const v4u*)(vb + (size_t)(tok0 + tstride * (jd0 + key)) * pitch + vc * 8);
    return s;
}
__device__ __forceinline__ void lstore(LAS unsigned char* lds, const Stage& s, int tid) {
    const int row = tid >> 3, ch = tid & 7, key = tid & 63, vc = tid >> 6;
    *(LAS v4u*)(lds + row * KP + ch * 16) = s.k;
    LAS unsigned short* vt = (LAS unsigned short*)(lds + VT_OFF);
#pragma unroll
    for (int i = 0; i < 8; ++i) vt[(vc * 8 + i) * (KP / 2) + key] = (unsigned short)(s.v[i >> 1] >> ((i & 1) * 16));
}
__device__ __forceinline__ void qk(f32x4 (&s)[4], LAS const unsigned char* lds, const bf16x8 (&qf)[2], int fr, int g) {
#pragma unroll
    for (int mt = 0; mt < 4; ++mt) { s[mt] = (f32x4){0.f, 0.f, 0.f, 0.f};
#pragma unroll
        for (int ks = 0; ks < 2; ++ks) { const bf16x8 kf = *(const LAS bf16x8*)(lds + (mt * 16 + fr) * KP + (ks * 32 + 8 * g) * 2);
            s[mt] = __builtin_amdgcn_mfma_f32_16x16x32_bf16(kf, qf[ks], s[mt], 0, 0, 0); } }
}
__device__ __forceinline__ void tile_compute(LAS const unsigned char* lds, const bf16x8 (&qf)[2], float& m, float& l, f32x4 (&o)[4], int dist0, bool lane_ok, int maxd, float sc2, float slope2, int fr, int g) {
    f32x4 s[4];
    qk(s, lds, qf, fr, g);
    float tmax = -1e30f;
#pragma unroll
    for (int mt = 0; mt < 4; ++mt)
#pragma unroll
        for (int r = 0; r < 4; ++r) { const int d = dist0 - mt * 16 - r; const bool valid = lane_ok && d >= 0 && d <= maxd;
            const float val = valid ? (s[mt][r] * sc2 - slope2 * (float)d) : -1e30f; s[mt][r] = val; tmax = fmaxf(tmax, val); }
    tmax = fmaxf(tmax, __shfl_xor(tmax, 16)); tmax = fmaxf(tmax, __shfl_xor(tmax, 32));
    const float mnew = fmaxf(m, tmax), alpha = exp2f(m - mnew);
    float psum = 0.f;
#pragma unroll
    for (int mt = 0; mt < 4; ++mt)
#pragma unroll
        for (int r = 0; r < 4; ++r) { const float p = (s[mt][r] > -1e29f) ? exp2f(s[mt][r] - mnew) : 0.f; psum += p; s[mt][r] = p; }
    l = l * alpha + psum; m = mnew;
#pragma unroll
    for (int dt = 0; dt < 4; ++dt) o[dt] = o[dt] * alpha;
    bf16x8 pb[2];
#pragma unroll
    for (int kk = 0; kk < 2; ++kk) { v4u w; w.x = pk2(s[2 * kk][0], s[2 * kk][1]); w.y = pk2(s[2 * kk][2], s[2 * kk][3]); w.z = pk2(s[2 * kk + 1][0], s[2 * kk + 1][1]); w.w = pk2(s[2 * kk + 1][2], s[2 * kk + 1][3]);
        pb[kk] = __builtin_bit_cast(bf16x8, w); }
#pragma unroll
    for (int dt = 0; dt < 4; ++dt)
#pragma unroll
        for (int kk = 0; kk < 2; ++kk) { LAS const unsigned char* vp = lds + VT_OFF + (dt * 16 + fr) * KP + (32 * kk + 4 * g) * 2;
            const v2u lo = *(const LAS v2u*)vp, hi = *(const LAS v2u*)(vp + 32);
            v4u w; w.x = lo.x; w.y = lo.y; w.z = hi.x; w.w = hi.y;
            o[dt] = __builtin_amdgcn_mfma_f32_16x16x32_bf16(__builtin_bit_cast(bf16x8, w), pb[kk], o[dt], 0, 0, 0); }
}
__device__ __forceinline__ void load_q(bf16x8 (&qf)[2], const bf16* qrow, int g) {
    qf[0] = *(const bf16x8*)(qrow + 8 * g); qf[1] = *(const bf16x8*)(qrow + 32 + 8 * g);
}
__device__ __forceinline__ void store_o(bf16* orow, const f32x4 (&o)[4], float scale, int g) {
#ifdef EXP_NOATT
    scale = 0.f;
#endif
#pragma unroll
    for (int dt = 0; dt < 4; ++dt) { v2u w; w.x = pk2(o[dt][0] * scale, o[dt][1] * scale); w.y = pk2(o[dt][2] * scale, o[dt][3] * scale); *(v2u*)(orow + dt * 16 + 4 * g) = w; }
}

__device__ __forceinline__ void banded_unit(LAS unsigned char* lds, const bf16* qb, const bf16* kb, const bf16* vb, int pitch, int tok0, int tstride, int idil0, int maxd, float slope2,
                                            float& m, float& l, f32x4 (&o)[4], int tid) {
    const int lane = tid & 63, w = tid >> 6, fr = lane & 15, g = lane >> 4;
    const int iq = idil0 + 16 * w + fr;
    bf16x8 qf[2]; load_q(qf, qb + (size_t)(tok0 + tstride * iq) * pitch, g);
    m = -1e30f; l = 0.f;
#pragma unroll
    for (int dt = 0; dt < 4; ++dt) o[dt] = (f32x4){0.f, 0.f, 0.f, 0.f};
    const int kt0 = idil0 >= 128 ? 0 : 2;
    Stage st = gload(kb, vb, pitch, tok0, tstride, idil0 - 128 + 64 * kt0, tid);
    for (int kt = kt0; kt < 4; ++kt) {
        const int jd0 = idil0 - 128 + 64 * kt;
        __syncthreads();
        lstore(lds, st, tid);
        __syncthreads();
        if (kt + 1 < 4) st = gload(kb, vb, pitch, tok0, tstride, jd0 + 64, tid);
        const bool poss = (jd0 <= iq) && (jd0 + 63 >= iq - maxd);
        if (__any(poss)) tile_compute(lds, qf, m, l, o, iq - jd0 - 4 * g, true, maxd, 0.125f * LOG2E, slope2, fr, g);
    }
    l += __shfl_xor(l, 16); l += __shfl_xor(l, 32);
}
}

#define XB_TMO      128
#define XB_XCNT(j)  (256  + 64 * (j))
#define XB_XSUB(j)  (1280 + 64 * (j))
#define XB_XGEN(j)  (2304 + 64 * (j))
#define XB_TOP      3328
#define XB_TOPGEN   3392
#define XCD_BAR_WORDS 3456
#define XB_SPIN_CAP (1u << 18)

__device__ __forceinline__ unsigned xb_ld(unsigned* p)              { return __hip_atomic_load(p, __ATOMIC_RELAXED, __HIP_MEMORY_SCOPE_AGENT); }
__device__ __forceinline__ unsigned xb_add(unsigned* p, unsigned v) { return __hip_atomic_fetch_add(p, v, __ATOMIC_RELAXED, __HIP_MEMORY_SCOPE_AGENT); }
__device__ __forceinline__ unsigned xb_xcc_id() { return (unsigned)__builtin_amdgcn_s_getreg((3 << 11) | 20) & 0xFu; }
#define XB_SPIN(cond, bar) do { unsigned _sp = 0; while (cond) { __builtin_amdgcn_s_sleep(1); \
    if ((++_sp & 255u) == 0u) { if (xb_ld(&(bar)[XB_TMO])) break; if (_sp > XB_SPIN_CAP) { atomicAdd(&(bar)[XB_TMO], 1u); break; } } } } while (0)

struct XcdBarrier {
    unsigned* bar; unsigned x;
    volatile LAS unsigned* st;
};

__device__ __forceinline__ XcdBarrier xcd_barrier_post(unsigned* bar, volatile LAS unsigned* st) {
    XcdBarrier b; b.bar = bar; b.x = xb_xcc_id(); b.st = st;
    if (threadIdx.x == 0) (void)xb_add(&bar[XB_XCNT(b.x)], 1u);
    return b;
}
__device__ __forceinline__ void xcd_barrier_complete(unsigned* bar, unsigned x, unsigned& nloc, unsigned& nx) {
    const unsigned G = gridDim.x * gridDim.y * gridDim.z;
    unsigned sum, cnt, mine, sp = 0u;
    for (;;) {
        sum = 0u; cnt = 0u; mine = 0u;
#pragma unroll
        for (unsigned j = 0; j < 16; ++j) { const unsigned c = xb_ld(&bar[XB_XCNT(j)]); sum += c; cnt += (c > 0u) ? 1u : 0u; mine = (j == x) ? c : mine; }
        if (sum == G) break;
        __builtin_amdgcn_s_sleep(1);
        if ((++sp & 255u) == 0u) { if (xb_ld(&bar[XB_TMO])) break; if (sp > XB_SPIN_CAP) { atomicAdd(&bar[XB_TMO], 1u); break; } }
    }
    nloc = mine > 0u ? mine : 1u; nx = cnt > 0u ? cnt : 1u;
}

__device__ __forceinline__ void xcd_barrier(const XcdBarrier& b) {
    asm volatile("s_waitcnt vmcnt(0)" ::: "memory");
    __syncthreads();
    if (threadIdx.x == 0) {
        unsigned* bar = b.bar;
        __builtin_amdgcn_s_waitcnt(0);
        unsigned nloc = b.st[0], nx = b.st[1];
        if (nloc == 0u) { xcd_barrier_complete(bar, b.x, nloc, nx); b.st[0] = nloc; b.st[1] = nx; }
        const unsigned old = xb_add(&bar[XB_XSUB(b.x)], 1u);
        const unsigned gen = old / nloc;
        if (old + 1u == (gen + 1u) * nloc) {
            __builtin_amdgcn_fence(__ATOMIC_RELEASE, "agent");
            asm volatile("s_waitcnt vmcnt(0)" ::: "memory");
            const unsigned og = xb_add(&bar[XB_TOP], 1u);
            const unsigned tg = og / nx;
            if (og + 1u == (tg + 1u) * nx) xb_add(&bar[XB_TOPGEN], 1u);
            else XB_SPIN(xb_ld(&bar[XB_TOPGEN]) == tg, bar);
            __builtin_amdgcn_fence(__ATOMIC_ACQUIRE, "agent");
            xb_add(&bar[XB_XGEN(b.x)], 1u);
            asm volatile("s_waitcnt vmcnt(0)" ::: "memory");
        } else {
            XB_SPIN(xb_ld(&bar[XB_XGEN(b.x)]) == gen, bar);
            __builtin_amdgcn_fence(__ATOMIC_ACQUIRE, "agent");
            asm volatile("s_waitcnt vmcnt(0)" ::: "memory");
        }
    }
    __syncthreads();
}

struct Args { const float* in[20]; float* out; unsigned char* ws; };
enum { I_X = 0, I_P, I_AWQKV, I_ASINK, I_AWO, I_BWQKV, I_BWO, I_CWQKV, I_CWO, I_LN1G, I_LN1B, I_LN2G, I_LN2B, I_PWQ, I_PSUBK, I_PU, I_PV, I_PLEW, I_PLEGW, I_PLEGB, I_OUT, I_WS };
constexpr int PTAB_OFF = 131072 + 1024, XBST_OFF = 131072 + 2048;
__device__ __forceinline__ unsigned long long ldp(LAS unsigned char* lds, int i) {
    volatile LAS unsigned* t = (volatile LAS unsigned*)(lds + PTAB_OFF);
    const unsigned lo = __builtin_amdgcn_readfirstlane(t[2 * i]), hi = __builtin_amdgcn_readfirstlane(t[2 * i + 1]);
    return ((unsigned long long)hi << 32) | lo;
}
#define INP(i) ((const float*)ldp(lds, (i)))
#define WSP() ((unsigned char*)ldp(lds, I_WS))
#define LAUNDER(v) asm volatile("" : "+s"(v))
struct Ctx { int tid, lane, wave, G, bid, gw, NGW; };
__device__ __forceinline__ Ctx mkctx() { Ctx c; int t_ = threadIdx.x; asm volatile("" : "+v"(t_)); c.tid = t_; c.lane = c.tid & 63; c.wave = __builtin_amdgcn_readfirstlane(c.tid >> 6); c.G = gridDim.x; c.bid = blockIdx.x; c.gw = c.bid * NW + c.wave; c.NGW = c.G * NW; return c; }

__device__ __forceinline__ void ph_prologue(LAS unsigned char* lds) {
    const Ctx c = mkctx(); unsigned char* ws = WSP();
    const size_t gtid = (size_t)c.bid * NTHR + c.tid, nthr = (size_t)c.G * NTHR;
    LAS float* scr = (LAS float*)(lds + c.wave * 16384);
    for (int j = 0; j < 2; ++j) {
        p0_transpose(INP(I_AWQKV) + (size_t)j * 1024 * 1280, 1024, 1280, (bf16*)(ws + WS_WQKV_A) + (size_t)j * 1280 * 1024, scr, c.gw, c.NGW, c.lane);
        p0_transpose(INP(I_AWO) + (size_t)j * 1024 * 1024, 1024, 1024, (bf16*)(ws + WS_WO_A) + (size_t)j * 1024 * 1024, scr, c.gw, c.NGW, c.lane);
    }
    p0_transpose(INP(I_BWQKV), 1024, 5120, (bf16*)(ws + WS_WQKV_B), scr, c.gw, c.NGW, c.lane);
    p0_transpose(INP(I_BWO), 1024, 1024, (bf16*)(ws + WS_WO_B), scr, c.gw, c.NGW, c.lane);
    p0_transpose(INP(I_CWQKV), 1024, 3072, (bf16*)(ws + WS_WQKV_C), scr, c.gw, c.NGW, c.lane);
    p0_transpose(INP(I_CWO), 1024, 1024, (bf16*)(ws + WS_WO_C), scr, c.gw, c.NGW, c.lane);
    for (int i = 0; i < DEPTH; ++i) {
        p0_transpose(INP(I_PLEW) + (size_t)i * 256 * 1024, 256, 1024, (bf16*)(ws + WS_PLEW) + (size_t)i * 1024 * 256, scr, c.gw, c.NGW, c.lane);
        p0_transpose(INP(I_PLEGW) + (size_t)i * 1024 * 1024, 1024, 1024, (bf16*)(ws + WS_PLEG) + (size_t)i * 1024 * 1024, scr, c.gw, c.NGW, c.lane);
    }
    p0_convert(INP(I_X), (bf16*)(ws + WS_B0), (size_t)S * D, gtid, nthr);
    p0_convert(INP(I_P), (bf16*)(ws + WS_P), (size_t)DEPTH * S * 256, gtid, nthr);
    p0_convert8(INP(I_PU), ws + WS_U, (size_t)DEPTH * PEER_E * D, 32.0f, gtid, nthr);
    p0_convert8(INP(I_PV), ws + WS_V, (size_t)DEPTH * PEER_E * D, 8.0f, gtid, nthr);
    p0_weff(INP(I_PWQ), INP(I_PSUBK), (bf16*)(ws + WS_WEFF), lds, c.bid, c.G, c.tid);
}
__device__ __forceinline__ bf16* bcur(unsigned char* ws, int li) { return (bf16*)(ws + ((li & 1) ? WS_B1 : WS_B0)); }
__device__ __forceinline__ bf16* both(unsigned char* ws, int li) { return (bf16*)(ws + ((li & 1) ? WS_B0 : WS_B1)); }

__device__ __forceinline__ void ph_qkv(LAS unsigned char* lds, int li) {
    unsigned char* ws = WSP(); const int kind = li % 3, lj = li / 3;
    const int NQKV = kind == 0 ? 1280 : (kind == 1 ? 5120 : 3072);
    const bf16* wqkv = kind == 0 ? (const bf16*)(ws + WS_WQKV_A) + (size_t)lj * 1280 * 1024 : (kind == 1 ? (const bf16*)(ws + WS_WQKV_B) : (const bf16*)(ws + WS_WQKV_C));
    pg8::Gemm g{bcur(ws, li), wqkv, S, NQKV, D}; pg8::StaticOrder So; So.init(S, NQKV, (int)gridDim.x, (int)blockIdx.x);
    pg8::EpiBf16<0> E{(bf16*)(ws + WS_QKV), NQKV, nullptr, 0, 0, 1.f};
    pg8::gemm_phase<pg8::EpiBf16<0>, pg8::StaticOrder, PG8_ALIGN, PG8_SP2>(lds, g, So, E);
}
__device__ __forceinline__ void ph_attn_a(LAS unsigned char* lds, int li) {
    const Ctx c = mkctx(); unsigned char* ws = WSP(); const int lj = li / 3;
    bf16* const QKV = (bf16*)(ws + WS_QKV); bf16* const Ob = (bf16*)(ws + WS_O);
    const float* sinks = INP(I_ASINK) + lj * 16;
    for (int u = c.bid; u < 16 * 128; u += c.G) {
        const int h = u >> 7, qb = u & 127, kvh = h >> 3;
        const float slope = exp2f(-0.5f * (float)(h + 1));
        float m, l; f32x4 o[4];
        att::banded_unit(lds, QKV + h * 64, QKV + 1024 + kvh * 64, QKV + 1152 + kvh * 64, 1280, 0, 1, qb * 128, 127, slope * LOG2E, m, l, o, c.tid);
        const float sk2 = sinks[h] * LOG2E, mf = fmaxf(m, sk2), lf = l * exp2f(m - mf) + exp2f(sk2 - mf);
        const int tok = qb * 128 + 16 * (c.tid >> 6) + (c.lane & 15);
        att::store_o(Ob + (size_t)tok * 1024 + h * 64, o, exp2f(m - mf) / lf, c.lane >> 4);
    }
}
__device__ __forceinline__ void ph_attn_b(LAS unsigned char* lds) {
    const Ctx c = mkctx(); unsigned char* ws = WSP();
    bf16* const QKV = (bf16*)(ws + WS_QKV); bf16* const OG = (bf16*)(ws + WS_OG); float* const LSE = (float*)(ws + WS_LSE);
    for (int u = c.bid; u < 3 * 16 * 128; u += c.G) {
        const int gi = u >> 11, h = (u >> 7) & 15, uu = u & 127;
        const int r = gi == 0 ? 1 : (gi == 1 ? 4 : 16);
        const int cc = uu % r, b = uu / r;
        const float slope = exp2f(-0.5f * (float)(h + 1));
        float m, l; f32x4 o[4];
        att::banded_unit(lds, QKV + gi * 1024 + h * 64, QKV + 3072 + h * 64, QKV + 4096 + h * 64, 5120, cc, r, b * 128, 128, slope * (float)r * LOG2E, m, l, o, c.tid);
        const int tok = cc + r * (b * 128 + 16 * (c.tid >> 6) + (c.lane & 15));
        att::store_o(OG + ((size_t)gi * S + tok) * 1024 + h * 64, o, 1.0f / l, c.lane >> 4);
        if ((c.lane >> 4) == 0) LSE[((size_t)gi * S + tok) * 16 + h] = (m + log2f(l)) * LN2F;
    }
}
__device__ __forceinline__ void ph_merge_b(LAS unsigned char* lds) {
    const Ctx c = mkctx(); unsigned char* ws = WSP();
    const bf16* OG = (const bf16*)(ws + WS_OG); const float* LSE = (const float*)(ws + WS_LSE); bf16* const Ob = (bf16*)(ws + WS_O);
    const size_t gtid = (size_t)c.bid * NTHR + c.tid, nthr = (size_t)c.G * NTHR;
    for (size_t idx = gtid; idx < (size_t)S * 16 * 8; idx += nthr) {
        const int t = (int)(idx >> 7), h = (int)(idx >> 3) & 15, cch = (int)idx & 7;
        const float l0 = LSE[((size_t)0 * S + t) * 16 + h], l1 = LSE[((size_t)1 * S + t) * 16 + h], l2 = LSE[((size_t)2 * S + t) * 16 + h];
        const float mx = fmaxf(l0, fmaxf(l1, l2)); float w0 = __expf(l0 - mx), w1 = __expf(l1 - mx), w2 = __expf(l2 - mx); const float inv = 1.0f / (w0 + w1 + w2);
        w0 *= inv; w1 *= inv; w2 *= inv;
        const size_t off = (size_t)t * 1024 + h * 64 + cch * 8;
        const v4u a = *(const v4u*)(OG + off), bq = *(const v4u*)(OG + (size_t)S * 1024 + off), cq = *(const v4u*)(OG + (size_t)2 * S * 1024 + off);
        v4u o;
#pragma unroll
        for (int e = 0; e < 4; ++e) o[e] = pk2(w0 * bflo(a[e]) + w1 * bflo(bq[e]) + w2 * bflo(cq[e]), w0 * bfhi(a[e]) + w1 * bfhi(bq[e]) + w2 * bfhi(cq[e]));
        *(v4u*)(Ob + off) = o;
    }
}
__device__ __forceinline__ void ph_kmean(LAS unsigned char* lds) {
    const Ctx c = mkctx(); unsigned char* ws = WSP();
    const bf16* QKV = (const bf16*)(ws + WS_QKV); bf16* const KMEAN = (bf16*)(ws + WS_KMEAN);
    const size_t gtid = (size_t)c.bid * NTHR + c.tid, nthr = (size_t)c.G * NTHR;
    for (size_t idx = gtid; idx < 64 * 512; idx += nthr) {
        const int blk = (int)(idx >> 9), cp = (int)idx & 511;
        const bf16* kp = QKV + (size_t)blk * 256 * 3072 + 1024 + cp * 2;
        float s0 = 0.f, s1 = 0.f;
        for (int r = 0; r < 256; ++r) { const unsigned w = *(const unsigned*)(kp + (size_t)r * 3072); s0 += bflo(w); s1 += bfhi(w); }
        *(unsigned*)(KMEAN + blk * 1024 + cp * 2) = pk2(s0 * (1.f / 256.f), s1 * (1.f / 256.f));
    }
}
__device__ __forceinline__ void ph_attn_c(LAS unsigned char* lds) {
    const Ctx c = mkctx(); unsigned char* ws = WSP();
    const bf16* QKV = (const bf16*)(ws + WS_QKV); const bf16* KMEAN = (const bf16*)(ws + WS_KMEAN); bf16* const Ob = (bf16*)(ws + WS_O);
    const int tid = c.tid, lane = c.lane, G = c.G, bid = c.bid;
    const int rounds = (2048 + G - 1) / G;
    for (int rd = 0; rd < rounds; ++rd) {
        const int L = rd * G + ((rd & 1) ? (G - 1 - bid) : bid);
        if (L >= 2048) continue;
        const int qt = 127 - (L >> 4), h = L & 15, qblk = qt >> 1, t0 = qt * 128;
        const int w = tid >> 6, fr = lane & 15, g = lane >> 4;
        const int iq = t0 + 16 * w + fr;
        const bf16* qb = QKV + h * 64; const bf16* kb = QKV + 1024 + h * 64; const bf16* vb = QKV + 2048 + h * 64;
        const float slope2 = exp2f(-0.5f * (float)(h + 1)) * LOG2E;
        bf16x8 qf[2]; att::load_q(qf, qb + (size_t)iq * 3072, g);
        unsigned long long selmask = 0ull, bunion = 0ull;
        if (qblk > 0) {
            __syncthreads();
            { const int row = tid >> 3, ch = tid & 7; *(LAS v4u*)(lds + row * att::KP + ch * 16) = *(const v4u*)(KMEAN + row * 1024 + h * 64 + ch * 8); }
            __syncthreads();
            f32x4 s[4]; att::qk(s, lds, qf, fr, g);
            const int nsel = qblk < 3 ? qblk : 3;
            for (int sr = 0; sr < nsel; ++sr) {
                float best = -INFINITY; int bi = 64;
#pragma unroll
                for (int mt = 0; mt < 4; ++mt)
#pragma unroll
                    for (int r = 0; r < 4; ++r) { const int n = mt * 16 + 4 * g + r; const bool ok = n < qblk && !((selmask >> n) & 1ull);
                        if (ok && (s[mt][r] > best || bi == 64)) { best = s[mt][r]; bi = n; } }
#pragma unroll
                for (int x = 16; x <= 32; x <<= 1) { const float ob = __shfl_xor(best, x); const int oi = __shfl_xor(bi, x);
                    if (oi < 64 && (bi == 64 || ob > best || (ob == best && oi < bi))) { best = ob; bi = oi; } }
                selmask |= 1ull << bi;
            }
            unsigned lo = (unsigned)selmask, hi = (unsigned)(selmask >> 32);
#pragma unroll
            for (int x = 1; x < 16; x <<= 1) { lo |= __shfl_xor(lo, x); hi |= __shfl_xor(hi, x); }
            LAS unsigned* wun = (LAS unsigned*)(lds + att::MISC_OFF);
            if (lane == 0) { wun[2 * w] = lo; wun[2 * w + 1] = hi; }
            __syncthreads();
            unsigned ul = 0, uh = 0;
#pragma unroll
            for (int x = 0; x < 8; ++x) { ul |= wun[2 * x]; uh |= wun[2 * x + 1]; }
            bunion = ((unsigned long long)uh << 32) | ul;
        }
        float m = -1e30f, l = 0.f; f32x4 o[4];
#pragma unroll
        for (int dt = 0; dt < 4; ++dt) o[dt] = (f32x4){0.f, 0.f, 0.f, 0.f};
        const int nown = (t0 + 128 - qblk * 256) / 64;
        unsigned long long todo = bunion;
        int kbcur = todo ? (__ffsll((long long)todo) - 1) : qblk, sub = 0;
        if (todo) todo &= todo - 1;
        att::Stage st = att::gload(kb, vb, 3072, 0, 1, kbcur * 256, tid);
        for (;;) {
            const int jd0 = kbcur * 256 + sub * 64;
            const bool own = kbcur == qblk;
            int nkb = kbcur, nsub = sub + 1; bool more = true;
            if (!own) { if (nsub == 4) { nsub = 0; if (todo) { nkb = __ffsll((long long)todo) - 1; todo &= todo - 1; } else nkb = qblk; } }
            else if (nsub == nown) more = false;
            __syncthreads();
            att::lstore(lds, st, tid);
            __syncthreads();
            if (more) st = att::gload(kb, vb, 3072, 0, 1, nkb * 256 + nsub * 64, tid);
            const bool lane_ok = own ? (jd0 <= iq) : (((selmask >> kbcur) & 1ull) != 0ull);
            if (__any(lane_ok)) att::tile_compute(lds, qf, m, l, o, iq - jd0 - 4 * g, lane_ok, 0x3fffffff, 0.125f * LOG2E, slope2, fr, g);
            if (!more) break;
            kbcur = nkb; sub = nsub;
        }
        l += __shfl_xor(l, 16); l += __shfl_xor(l, 32);
        att::store_o(Ob + (size_t)iq * 1024 + h * 64, o, 1.0f / l, g);
    }
}
__device__ __forceinline__ void ph_oproj(LAS unsigned char* lds, int li) {
    unsigned char* ws = WSP(); const int kind = li % 3, lj = li / 3;
    const bf16* wo = kind == 0 ? (const bf16*)(ws + WS_WO_A) + (size_t)lj * 1024 * 1024 : (kind == 1 ? (const bf16*)(ws + WS_WO_B) : (const bf16*)(ws + WS_WO_C));
    const float* xin = li == 0 ? INP(I_X) : (const float*)(ws + WS_F0);
    pg8::Gemm g{(const bf16*)(ws + WS_O), wo, S, D, D}; pg8::StaticOrder So; So.init(S, D, (int)gridDim.x, (int)blockIdx.x);
    pg8::EpiResid E{xin, (float*)(ws + WS_F1), D, DN_ALPHA};
    pg8::gemm_phase<pg8::EpiResid, pg8::StaticOrder, PG8_ALIGN, PG8_SP2>(lds, g, So, E);
}
__device__ __forceinline__ void ph_ln1(LAS unsigned char* lds, int li) {
    const Ctx c = mkctx(); unsigned char* ws = WSP();
    float* const F1 = (float*)(ws + WS_F1); bf16* const Bc = bcur(ws, li);
    const float* g1 = INP(I_LN1G) + li * D; const float* b1 = INP(I_LN1B) + li * D;
    for (int r = c.gw; r < S; r += c.NGW) ln_row(F1 + (size_t)r * D, g1, b1, F1 + (size_t)r * D, Bc + (size_t)r * D, c.lane);
}
__device__ __forceinline__ void ph_sc(LAS unsigned char* lds, int li) {
    unsigned char* ws = WSP();
    pg8::Gemm g{bcur(ws, li), (const bf16*)(ws + WS_WEFF) + (size_t)li * 2048 * 1024, S, 2048, D}; pg8::StaticOrder So; So.init(S, 2048, (int)gridDim.x, (int)blockIdx.x);
    pg8::EpiF32 E{(float*)(ws + WS_QKV), 2048};
    pg8::gemm_phase<pg8::EpiF32, pg8::StaticOrder, PG8_ALIGN, PG8_SP2>(lds, g, So, E);
}
__device__ __forceinline__ void ph_peer(LAS unsigned char* lds, int li, bool dry = false) {
    const Ctx c = mkctx(); unsigned char* ws = WSP();
    const int lane = c.lane, gw = c.gw, NGW = c.NGW;
    const GAS float* SC = (const GAS float*)(ws + WS_QKV); GAS float* const F0 = (GAS float*)(ws + (dry ? WS_OG : WS_F0)); const GAS float* F1 = (const GAS float*)(ws + WS_F1); GAS bf16* const Bout = dry ? (GAS bf16*)(ws + WS_OG + 64 * MiB) : (GAS bf16*)bcur(ws, li);
    const GAS unsigned char* U8 = (const GAS unsigned char*)(ws + WS_U + (size_t)li * PEER_E * D); const GAS unsigned char* V8 = (const GAS unsigned char*)(ws + WS_V + (size_t)li * PEER_E * D);
    const GAS float* g2 = (const GAS float*)(INP(I_LN2G) + li * D); const GAS float* b2 = (const GAS float*)(INP(I_LN2B) + li * D);
    const int seg = lane >> 4, r = lane & 15;
#pragma unroll 1
    for (int t = gw; t < S; t += NGW) {
        const GAS float* scr = SC + (size_t)t * 2048;
        float tv[4]; int ti[4];
#pragma unroll
        for (int p = 0; p < 4; ++p) {
            const int Gp = 4 * p + seg;
            const GAS float* b = scr + Gp * 128 + r * 8;
            const f32x4 a0 = *(const GAS f32x4*)b, a1 = *(const GAS f32x4*)(b + 4);
            unsigned kk[8];
#pragma unroll
            for (int j = 0; j < 4; ++j) { kk[j] = (sortable(a0[j]) & ~127u) | (unsigned)(127 - (r * 8 + j)); kk[4 + j] = (sortable(a1[j]) & ~127u) | (unsigned)(127 - (r * 8 + 4 + j)); }
#define CE(i, j) { const unsigned hi_ = kk[i] > kk[j] ? kk[i] : kk[j], lo_ = kk[i] > kk[j] ? kk[j] : kk[i]; kk[i] = hi_; kk[j] = lo_; }
            CE(0, 1) CE(2, 3) CE(4, 5) CE(6, 7)  CE(0, 2) CE(1, 3) CE(4, 6) CE(5, 7)  CE(1, 2) CE(5, 6)  CE(0, 4) CE(1, 5) CE(2, 6) CE(3, 7)  CE(2, 4) CE(3, 5)  CE(1, 2) CE(3, 4) CE(5, 6)
#undef CE
            unsigned win = 0u;
#pragma unroll
            for (int rd = 0; rd < 16; ++rd) {
                const unsigned head = kk[0], wk = row_max_u32(head); const bool pop = head == wk;
#pragma unroll
                for (int j = 0; j < 7; ++j) kk[j] = pop ? kk[j + 1] : kk[j];
                kk[7] = pop ? 0u : kk[7];
                if (r == rd) win = wk;
            }
            const int idx = 127 - (int)(win & 127u);
            ti[p] = idx; tv[p] = scr[Gp * 128 + idx];
        }
        float gate[4]; int expert[4];
#pragma unroll
        for (int p = 0; p < 4; ++p) {
            const float v1 = tv[p]; const int i1 = ti[p];
            int pa = 0; float bestv = 0.f; int beste = 0;
            const int srcb = (seg | 1) << 4, myb = seg << 4;
#pragma unroll
            for (int rd = 0; rd < 16; ++rd) {
                const float v2 = __shfl(tv[p], srcb + pa); const int i2 = __shfl(ti[p], srcb + pa);
                const float cand = v1 + v2; const unsigned key = (sortable(cand) & ~15u) | (unsigned)(15 - r);
                const unsigned wk = row_max_u32(key); const int a = 15 - (int)(wk & 15u);
                const int eid = i1 * 128 + i2;
                const float bw = __shfl(cand, myb + a); const int ew = __shfl(eid, myb + a);
                if (r == rd) { bestv = bw; beste = ew; }
                if (r == a) ++pa;
            }
            const float mx = row_max_f32(bestv), e = __expf(bestv - mx), sm = row_sum_f32(e);
            gate[p] = e / sm; expert[p] = beste;
        }
        int E0, E1; float G0, G1;
        { const int s0 = lane & 15, s1 = 32 + (lane & 15), pp = lane >> 4;
          const int a0 = __shfl(expert[0], s0), a1 = __shfl(expert[1], s0), a2 = __shfl(expert[2], s0), a3 = __shfl(expert[3], s0);
          const int c0 = __shfl(expert[0], s1), c1 = __shfl(expert[1], s1), c2 = __shfl(expert[2], s1), c3 = __shfl(expert[3], s1);
          const float g0 = __shfl(gate[0], s0), g1 = __shfl(gate[1], s0), g2_ = __shfl(gate[2], s0), g3 = __shfl(gate[3], s0);
          const float d0 = __shfl(gate[0], s1), d1 = __shfl(gate[1], s1), d2 = __shfl(gate[2], s1), d3 = __shfl(gate[3], s1);
          E0 = pp == 0 ? a0 : (pp == 1 ? a1 : (pp == 2 ? a2 : a3)); E1 = pp == 0 ? c0 : (pp == 1 ? c1 : (pp == 2 ? c2 : c3));
          G0 = pp == 0 ? g0 : (pp == 1 ? g1 : (pp == 2 ? g2_ : g3)); G1 = pp == 0 ? d0 : (pp == 1 ? d1 : (pp == 2 ? d2 : d3)); }
        const GAS float* x1r = F1 + (size_t)t * D + lane * 16;
        f32x2 xv[8];
#pragma unroll
        for (int q = 0; q < 4; ++q) { const f32x4 v = *(const GAS f32x4*)(x1r + 4 * q); xv[2 * q] = (f32x2){v.x, v.y}; xv[2 * q + 1] = (f32x2){v.z, v.w}; }
#define PEER_LOADB(dst, TAB, EREG, LB) _Pragma("unroll") for (int j = 0; j < PNB; ++j) { const int e_ = __builtin_amdgcn_readlane(EREG, (LB) + j); dst[j] = *(const GAS v4u*)(TAB + ((size_t)e_ << 10) + lane * 16); }
#define PEER_DOTB(src, HREG, LB) _Pragma("unroll") for (int j = 0; j < PNB; ++j) { const v4u w = src[j]; f32x2 a2 = (f32x2){0.f, 0.f}; \
            _Pragma("unroll") for (int q = 0; q < 4; ++q) { const f32x2 lo = __builtin_amdgcn_cvt_pk_f32_fp8((int)w[q], false), hi = __builtin_amdgcn_cvt_pk_f32_fp8((int)w[q], true); \
                a2 = __builtin_elementwise_fma(lo, xv[2 * q], a2); a2 = __builtin_elementwise_fma(hi, xv[2 * q + 1], a2); } \
            float acc = a2.x + a2.y; acc = row_sum_f32(acc); acc += __shfl_xor(acc, 16); acc += __shfl_xor(acc, 32); if (lane == (LB) + j) HREG = acc; }
#define PEER_AXB(src, AREG, LB) _Pragma("unroll") for (int j = 0; j < PNB; ++j) { const v4u w = src[j]; const float a_ = __int_as_float(__builtin_amdgcn_readlane(__float_as_int(AREG), (LB) + j)); const f32x2 aa = (f32x2){a_, a_}; \
            _Pragma("unroll") for (int q = 0; q < 4; ++q) { const f32x2 lo = __builtin_amdgcn_cvt_pk_f32_fp8((int)w[q], false), hi = __builtin_amdgcn_cvt_pk_f32_fp8((int)w[q], true); \
                y2[2 * q] = __builtin_elementwise_fma(lo, aa, y2[2 * q]); y2[2 * q + 1] = __builtin_elementwise_fma(hi, aa, y2[2 * q + 1]); } }
        constexpr int PNB = 8;
        float H0 = 0.f, H1 = 0.f;
        {
            v4u bA[PNB], bB[PNB];
            PEER_LOADB(bA, U8, E0, 0)
#pragma unroll 1
            for (int k = 0; k < 64 / PNB; ++k) {
                const int LB = PNB * k;
                PEER_LOADB(bB, U8, E1, LB)
                PEER_DOTB(bA, H0, LB)
                if (k + 1 < 64 / PNB) { PEER_LOADB(bA, U8, E0, LB + PNB) }
                PEER_DOTB(bB, H1, LB)
            }
        }
        H0 *= (1.0f / 32.0f); H1 *= (1.0f / 32.0f);
        const float A0 = 0.5f * H0 * (1.0f + erff(H0 * 0.70710678118654752f)) * G0 * 0.125f;
        const float A1 = 0.5f * H1 * (1.0f + erff(H1 * 0.70710678118654752f)) * G1 * 0.125f;
        f32x2 y2[8];
#pragma unroll
        for (int q = 0; q < 8; ++q) y2[q] = (f32x2){0.f, 0.f};
        {
            v4u bA[PNB], bB[PNB];
            PEER_LOADB(bA, V8, E0, 0)
#pragma unroll 1
            for (int k = 0; k < 64 / PNB; ++k) {
                const int LB = PNB * k;
                PEER_LOADB(bB, V8, E1, LB)
                PEER_AXB(bA, A0, LB)
                if (k + 1 < 64 / PNB) { PEER_LOADB(bA, V8, E0, LB + PNB) }
                PEER_AXB(bB, A1, LB)
            }
        }
#undef PEER_LOADB
#undef PEER_DOTB
#undef PEER_AXB
        float z[16]; float s = 0.f;
#pragma unroll
        for (int q = 0; q < 8; ++q) { z[2 * q] = DN_ALPHA * xv[q].x + y2[q].x; z[2 * q + 1] = DN_ALPHA * xv[q].y + y2[q].y; s += z[2 * q] + z[2 * q + 1]; }
        const float mean = wave_sum(s) * (1.f / D); float s2 = 0.f;
#pragma unroll
        for (int q = 0; q < 16; ++q) { z[q] -= mean; s2 += z[q] * z[q]; }
        const float rstd = 1.f / sqrtf(wave_sum(s2) * (1.f / D) + LN_EPS);
        float ov[16];
#pragma unroll
        for (int q = 0; q < 4; ++q) { const int c0 = lane * 16 + q * 4; const f32x4 gg = *(const GAS f32x4*)(g2 + c0), bb2 = *(const GAS f32x4*)(b2 + c0); f32x4 ovv;
#pragma unroll
            for (int e = 0; e < 4; ++e) { ovv[e] = z[q * 4 + e] * rstd * gg[e] + bb2[e]; ov[q * 4 + e] = ovv[e]; }
            *(GAS f32x4*)(F0 + (size_t)t * D + c0) = ovv; }
#pragma unroll
        for (int hh = 0; hh < 2; ++hh) { v4u w; w.x = pk2(ov[hh * 8 + 0], ov[hh * 8 + 1]); w.y = pk2(ov[hh * 8 + 2], ov[hh * 8 + 3]); w.z = pk2(ov[hh * 8 + 4], ov[hh * 8 + 5]); w.w = pk2(ov[hh * 8 + 6], ov[hh * 8 + 7]);
            *(GAS v4u*)(Bout + (size_t)t * D + lane * 16 + hh * 8) = w; }
    }
}
__device__ __forceinline__ void ph_ple_pw(LAS unsigned char* lds, int li) {
    unsigned char* ws = WSP();
    pg8::Gemm g{(const bf16*)(ws + WS_P) + (size_t)li * S * 256, (const bf16*)(ws + WS_PLEW) + (size_t)li * 1024 * 256, S, D, 256}; pg8::StaticOrder So; So.init(S, D, (int)gridDim.x, (int)blockIdx.x);
    pg8::EpiF32 E{(float*)(ws + WS_F1), D};
    pg8::gemm_phase<pg8::EpiF32, pg8::StaticOrder, PG8_ALIGN, PG8_SP2>(lds, g, So, E);
}
__device__ __forceinline__ void ph_ple_gate(LAS unsigned char* lds, int li) {
    unsigned char* ws = WSP();
    float* const F0 = (float*)(ws + WS_F0);
    float* outp = li == DEPTH - 1 ? (float*)ldp(lds, I_OUT) : F0;
    pg8::Gemm g{bcur(ws, li), (const bf16*)(ws + WS_PLEG) + (size_t)li * 1024 * 1024, S, D, D}; pg8::StaticOrder So; So.init(S, D, (int)gridDim.x, (int)blockIdx.x);
    pg8::EpiPle E{F0, (const float*)(ws + WS_F1), INP(I_PLEGB) + li * D, outp, both(ws, li), D};
    pg8::gemm_phase<pg8::EpiPle, pg8::StaticOrder, PG8_ALIGN, PG8_SP2>(lds, g, So, E);
}

#define GRID_SYNC_CG() do { asm volatile("s_waitcnt vmcnt(0)" ::: "memory"); __syncthreads(); grid.sync(); __builtin_amdgcn_fence(__ATOMIC_ACQUIRE, "agent"); asm volatile("s_waitcnt vmcnt(0)" ::: "memory"); __syncthreads(); } while (0)
#define GRID_SYNC() do { XcdBarrier xb_; xb_.bar = (unsigned*)(WSP() + WS_CTL) + 4096; xb_.x = xb_xcc_id(); xb_.st = (volatile LAS unsigned*)(lds + XBST_OFF); xcd_barrier(xb_); } while (0)
__global__ void __launch_bounds__(NTHR, 2) fwd_kernel(Args args) {
    extern __shared__ __attribute__((aligned(16))) unsigned char lds_raw[];
    LAS unsigned char* lds = (LAS unsigned char*)lds_raw;
    cg::grid_group grid = cg::this_grid();
    if (threadIdx.x == 0) {
        LAS unsigned long long* t = (LAS unsigned long long*)(lds + PTAB_OFF);
        t[0] = (unsigned long long)args.in[0]; t[1] = (unsigned long long)args.in[1]; t[2] = (unsigned long long)args.in[2]; t[3] = (unsigned long long)args.in[3];
        t[4] = (unsigned long long)args.in[4]; t[5] = (unsigned long long)args.in[5]; t[6] = (unsigned long long)args.in[6]; t[7] = (unsigned long long)args.in[7];
        t[8] = (unsigned long long)args.in[8]; t[9] = (unsigned long long)args.in[9]; t[10] = (unsigned long long)args.in[10]; t[11] = (unsigned long long)args.in[11];
        t[12] = (unsigned long long)args.in[12]; t[13] = (unsigned long long)args.in[13]; t[14] = (unsigned long long)args.in[14]; t[15] = (unsigned long long)args.in[15];
        t[16] = (unsigned long long)args.in[16]; t[17] = (unsigned long long)args.in[17]; t[18] = (unsigned long long)args.in[18]; t[19] = (unsigned long long)args.in[19];
        t[20] = (unsigned long long)args.out; t[21] = (unsigned long long)args.ws;
    }
    if (threadIdx.x < 2) ((volatile LAS unsigned*)(lds + XBST_OFF))[threadIdx.x] = 0u;
    __syncthreads();
    (void)xcd_barrier_post((unsigned*)args.ws + 4096, (volatile LAS unsigned*)(lds + XBST_OFF));
#ifndef SKIP_PRO
    ph_prologue(lds);
#endif
    GRID_SYNC_CG();
#pragma unroll 1
    for (int li0 = 0; li0 < DEPTH; ++li0) {
        int li = li0;
        LAUNDER(li); ph_qkv(lds, li);
        GRID_SYNC();
#ifndef SKIP_ATT
        LAUNDER(li);
        const int kind = li % 3;
        if (kind == 0) {
#ifndef SKIP_A
            ph_attn_a(lds, li);
#endif
        } else if (kind == 1) {
#ifndef SKIP_B
            ph_attn_b(lds); GRID_SYNC(); ph_merge_b(lds);
#endif
        } else {
#ifndef SKIP_C
            ph_kmean(lds); GRID_SYNC(); ph_attn_c(lds);
#ifdef REP_C
            ph_attn_c(lds);
#endif
#endif
        }
#endif
        GRID_SYNC();
        LAUNDER(li); ph_oproj(lds, li);
        GRID_SYNC();
        LAUNDER(li); ph_ln1(lds, li);
        GRID_SYNC();
        LAUNDER(li); ph_sc(lds, li);
        GRID_SYNC();
#ifndef SKIP_PEER
#ifdef REP_PEER
        LAUNDER(li); ph_peer(lds, li, true);
#endif
        LAUNDER(li); ph_peer(lds, li);
#endif
        GRID_SYNC();
        LAUNDER(li); ph_ple_pw(lds, li);
        asm volatile("s_waitcnt vmcnt(0)" ::: "memory"); __syncthreads();
        LAUNDER(li); ph_ple_gate(lds, li);
        if (li0 + 1 < DEPTH) GRID_SYNC();
    }
}

extern "C" void kernel_launch(void* const* d_in, const int* in_sizes, int n_in, void* d_out, int out_size, void* d_ws, size_t ws_size, hipStream_t stream) {
    static int grid = 0;
    if (grid == 0) {
        if (n_in != 20 || out_size != S * D || ws_size < WS_END) { fprintf(stderr, "kernel_launch: unexpected shapes: n_in %d out %d ws %zu (need %zu)\n", n_in, out_size, ws_size, (size_t)WS_END); grid = -1; return; }
        int dev = 0, cus = 0, per_cu = 0;
        hipGetDevice(&dev); hipDeviceGetAttribute(&cus, hipDeviceAttributeMultiprocessorCount, dev);
        if (hipFuncSetAttribute((const void*)fwd_kernel, hipFuncAttributeMaxDynamicSharedMemorySize, LDS_BYTES) != hipSuccess) { fprintf(stderr, "kernel_launch: hipFuncSetAttribute failed\n"); grid = -1; return; }
        if (hipOccupancyMaxActiveBlocksPerMultiprocessor(&per_cu, (const void*)fwd_kernel, NTHR, LDS_BYTES) != hipSuccess || per_cu < 1) { fprintf(stderr, "kernel_launch: occupancy query says %d\n", per_cu); per_cu = 1; }
        (void)hipGetLastError();
        grid = cus;
        fprintf(stderr, "kernel_launch: grid %d (cus %d, per_cu %d)\n", grid, cus, per_cu);
    }
    if (grid < 0) return;
    if (hipMemsetAsync((char*)d_ws + WS_CTL, 0, 65536, stream) != hipSuccess) { fprintf(stderr, "kernel_launch: memset failed\n"); return; }
    Args a{};
    for (int i = 0; i < 20; ++i) a.in[i] = (const float*)d_in[i];
    a.out = (float*)d_out; a.ws = (unsigned char*)d_ws;
    void* kargs[] = {&a};
    const hipError_t e = hipLaunchCooperativeKernel((const void*)fwd_kernel, dim3(grid), dim3(NTHR), kargs, LDS_BYTES, stream);
    if (e != hipSuccess) fprintf(stderr, "kernel_launch: cooperative launch failed: %s (grid %d)\n", hipGetErrorString(e), grid);
}
```

```cpp
#include <hip/hip_runtime.h>
#include <hip/hip_cooperative_groups.h>
#include <cstdio>
#include <cstdint>
namespace cg = cooperative_groups;
namespace pg8 {
#define PG8_LAS __attribute__((address_space(3)))
typedef unsigned short bf16_t;
typedef short bf16x8 __attribute__((ext_vector_type(8)));
typedef float f32x4 __attribute__((ext_vector_type(4)));
typedef unsigned u32x4 __attribute__((ext_vector_type(4)));
constexpr int BM = 256, BK = 64, HALF = 128, HTB = HALF * BK * 2  , STAGE_BYTES = 8 * HTB, NXCD = 8, WGM = 8;

__host__ __device__ __forceinline__ int lds_byte(int r, int c) { const int st = (r >> 4) * 2 + (c >> 5), rr = r & 15, cc = c & 31, ob = rr * 64 + cc * 2; return st * 1024 + (ob ^ (((ob >> 9) & 1) << 5)); }
__host__ __device__ __forceinline__ void stage_rc(int b, int& R, int& C) { const int st = b / 1024, sb = b % 1024, swz = sb ^ (((sb >> 9) & 1) << 5); R = (st >> 1) * 16 + swz / 64; C = (st & 1) * 32 + (swz % 64) / 2; }
__host__ __device__ __forceinline__ int perm32(int rho) { const int n = rho >> 4, i = rho & 15; return 8 * (i >> 2) + 4 * n + (i & 3); }

struct Unit { int pm, pn; };
struct Gemm { const bf16_t* A; const bf16_t* Bt; int M, N, K; };

struct StaticOrder {
    int nM, nN, nwg, G, c;
    __host__ __device__ void init(int M, int N, int G_, int c_) { nM = M / BM; nN = N / BM; nwg = nM * nN; G = G_; c = c_; }
    __host__ __device__ bool next(int i, Unit& u) const {
        const long L = (long)i * G + c; if (L >= nwg) return false;
        int wgid = (int)L; { const int q = nwg / NXCD, r = nwg % NXCD, xcd = wgid % NXCD, off = wgid / NXCD; wgid = (xcd < r ? xcd * (q + 1) : r * (q + 1) + (xcd - r) * q) + off; }
        const int nig = WGM * nN, gid = wgid / nig, fm = gid * WGM, gsz = (nM - fm) < WGM ? (nM - fm) : WGM;
        u.pm = fm + ((wgid % nig) % gsz); u.pn = (wgid % nig) / gsz; return true;
    }
    __device__ __forceinline__ void a_ready(const Unit&) const {}
    __device__ __forceinline__ void done(const Unit&) const {}
};

__device__ __forceinline__ unsigned cvt_pk_bf16(float lo, float hi) { unsigned r; asm volatile("v_cvt_pk_bf16_f32 %0, %1, %2" : "=v"(r) : "v"(lo), "v"(hi)); return r; }
typedef float f32x2 __attribute__((ext_vector_type(2)));
__device__ __forceinline__ f32x2 gelu_pk(f32x2 v) {
    const f32x2 av = __builtin_elementwise_abs(v), d = av * 0.2316418882f + 1.0f;
    f32x2 t; t.x = __builtin_amdgcn_rcpf(d.x); t.y = __builtin_amdgcn_rcpf(d.y);
    f32x2 q = t * 0.5307027145f + (-0.7265760135f); q = q * t + 0.7107068705f; q = q * t + (-0.142248368f); q = q * t + 0.127414796f; q = q * t;
    const f32x2 s = (v * v) * (-0.72134752044f);
    f32x2 e; e.x = __builtin_amdgcn_exp2f(s.x); e.y = __builtin_amdgcn_exp2f(s.y);
    const f32x2 m = v * (q * e), r = v - m;
    f32x2 o; o.x = v.x < 0.f ? m.x : r.x; o.y = v.y < 0.f ? m.y : r.y; return o;
}

template <int ACT  > struct EpiBf16 {
    static constexpr bool PERM = true, AFTER_DRAIN = false; static_assert(ACT == 0 || ACT == 1, "EpiBf16: ACT is 0 (none) or 1 (gelu_pk)");
    bf16_t* O; int ldc; const float* bias; int split_cols; size_t split_stride; float scale0;
    __device__ __forceinline__ void operator()(const f32x4 (&acc)[2][2][4][2], const Unit& u, int wr, int wc, int fr, int fq) const {
        const int row0 = u.pm * BM + wr * 64 + fr; int colt = u.pn * BM; bf16_t* base = O;
        float sc = 1.f; if (split_cols) { const int t = colt / split_cols; base += (size_t)t * split_stride; colt -= t * split_cols; if (t == 0) sc = scale0; }
        const int col0 = colt + wc * 32 + 8 * fq, bcol0 = u.pn * BM + wc * 32 + 8 * fq;
        f32x4 bv[2][2];
#pragma unroll
        for (int bj = 0; bj < 2; ++bj)
#pragma unroll
            for (int n = 0; n < 2; ++n) bv[bj][n] = bias ? *(const f32x4*)(bias + bcol0 + bj * HALF + 4 * n) : (f32x4){0.f, 0.f, 0.f, 0.f};
#pragma unroll
        for (int ai = 0; ai < 2; ++ai)
#pragma unroll
            for (int m = 0; m < 4; ++m) { bf16_t* rowp = base + (size_t)(row0 + ai * HALF + m * 16) * ldc + col0;
#pragma unroll
                for (int bj = 0; bj < 2; ++bj) { f32x4 v0 = acc[ai][bj][m][0] + bv[bj][0], v1 = acc[ai][bj][m][1] + bv[bj][1];
                    if (ACT == 1) { f32x2 a = gelu_pk((f32x2){v0[0], v0[1]}), b = gelu_pk((f32x2){v0[2], v0[3]}), c = gelu_pk((f32x2){v1[0], v1[1]}), d = gelu_pk((f32x2){v1[2], v1[3]});
                        v0 = (f32x4){a.x, a.y, b.x, b.y}; v1 = (f32x4){c.x, c.y, d.x, d.y}; }
                    v0 = v0 * sc; v1 = v1 * sc; u32x4 w; w.x = cvt_pk_bf16(v0[0], v0[1]); w.y = cvt_pk_bf16(v0[2], v0[3]); w.z = cvt_pk_bf16(v1[0], v1[1]); w.w = cvt_pk_bf16(v1[2], v1[3]);
                    *(u32x4*)(rowp + bj * HALF) = w; } }
    }
};
typedef unsigned u32x2e __attribute__((ext_vector_type(2)));
struct EpiF32 {
    static constexpr bool PERM = false, AFTER_DRAIN = false;
    float* O; int ldc;
    __device__ __forceinline__ void operator()(const f32x4 (&acc)[2][2][4][2], const Unit& u, int wr, int wc, int fr, int fq) const {
        const int col0 = u.pn * BM + wc * 32 + 4 * fq;
#pragma unroll
        for (int ai = 0; ai < 2; ++ai)
#pragma unroll
            for (int m = 0; m < 4; ++m) { const size_t off = (size_t)(u.pm * BM + ai * HALF + wr * 64 + m * 16 + fr) * ldc + col0;
#pragma unroll
                for (int bj = 0; bj < 2; ++bj)
#pragma unroll
                    for (int n = 0; n < 2; ++n) *(f32x4*)(O + off + bj * HALF + n * 16) = acc[ai][bj][m][n]; }
    }
};
struct EpiResid {
    static constexpr bool PERM = false, AFTER_DRAIN = false;
    const float* X; float* Z; int ldc; float alpha;
    __device__ __forceinline__ void operator()(const f32x4 (&acc)[2][2][4][2], const Unit& u, int wr, int wc, int fr, int fq) const {
        const int col0 = u.pn * BM + wc * 32 + 4 * fq;
#pragma unroll
        for (int ai = 0; ai < 2; ++ai)
#pragma unroll
            for (int m = 0; m < 4; ++m) { const size_t off = (size_t)(u.pm * BM + ai * HALF + wr * 64 + m * 16 + fr) * ldc + col0;
#pragma unroll
                for (int bj = 0; bj < 2; ++bj)
#pragma unroll
                    for (int n = 0; n < 2; ++n) { const f32x4 xv = *(const f32x4*)(X + off + bj * HALF + n * 16); *(f32x4*)(Z + off + bj * HALF + n * 16) = xv * alpha + acc[ai][bj][m][n]; } }
    }
};
struct EpiPle {
    static constexpr bool PERM = false, AFTER_DRAIN = false;
    const float* X2; const float* PW; const float* bg; float* OUT; bf16_t* OUTB; int ldc;
    __device__ __forceinline__ void operator()(const f32x4 (&acc)[2][2][4][2], const Unit& u, int wr, int wc, int fr, int fq) const {
        const int col0 = u.pn * BM + wc * 32 + 4 * fq;
#pragma unroll
        for (int ai = 0; ai < 2; ++ai)
#pragma unroll
            for (int m = 0; m < 4; ++m) { const size_t off = (size_t)(u.pm * BM + ai * HALF + wr * 64 + m * 16 + fr) * ldc + col0;
#pragma unroll
                for (int bj = 0; bj < 2; ++bj)
#pragma unroll
                    for (int n = 0; n < 2; ++n) { const int co = bj * HALF + n * 16;
                        const f32x4 xv = *(const f32x4*)(X2 + off + co), pw = *(const f32x4*)(PW + off + co), bv = *(const f32x4*)(bg + col0 + co);
                        const f32x4 a = acc[ai][bj][m][n] + bv; f32x4 o;
#pragma unroll
                        for (int e = 0; e < 4; ++e) { const float sg = 1.0f / (1.0f + __expf(-a[e])); o[e] = xv[e] + sg * pw[e]; }
                        *(f32x4*)(OUT + off + co) = o;
                        u32x2e w; w.x = cvt_pk_bf16(o[0], o[1]); w.y = cvt_pk_bf16(o[2], o[3]); *(u32x2e*)(OUTB + off + co) = w; } }
    }
};
template <class Epi, class Sched, bool ALIGN_EPI = false, bool SP2 = false>
__device__ __forceinline__ void gemm_phase(PG8_LAS unsigned char* lds, const Gemm g, const Sched& S, const Epi& E) {
    int tid_ = threadIdx.x; asm volatile("" : "+v"(tid_));
    const int tid = tid_, wid = __builtin_amdgcn_readfirstlane(tid >> 6), lane = tid & 63, wr = wid >> 2, wc = wid & 3, fr = lane & 15, fq = lane >> 4;
    const int K = g.K, nt = K / BK;
    unsigned voffA[2], voffB[2];
#pragma unroll
    for (int i = 0; i < 2; ++i) { int R, C; stage_rc(tid * 16 + i * 8192, R, C); const int Rb = Epi::PERM ? ((R & ~31) + perm32(R & 31)) : R;
        voffA[i] = (unsigned)(R * K + C) * 2u; voffB[i] = (unsigned)(Rb * K + C) * 2u; }
    const size_t kstep = (size_t)(BK * 2);
    const size_t hstep = (size_t)HALF * K * 2;
    const size_t tstep = 2 * hstep;
    const unsigned ldsw = (unsigned)wid * 1024u;
    const int aoff = lds_byte(wr * 64 + fr, fq * 8), boff = lds_byte(wc * 32 + fr, fq * 8);
#define PG8_SA(b, h) (((b) * 2 + (h)) * HTB)
#define PG8_SB(b, h) ((4 + (b) * 2 + (h)) * HTB)
#define PG8_STAGE(bufoff, gbase, voff) do { _Pragma("unroll") for (int _i = 0; _i < 2; ++_i) \
        __builtin_amdgcn_global_load_lds((const unsigned*)((const char*)(gbase) + (voff)[_i]), (PG8_LAS unsigned*)(lds + (bufoff) + ldsw + _i * 8192), 16, 0, 0); } while (0)
#define PG8_LDA(dst, b, h) do { _Pragma("unroll") for (int m = 0; m < 4; ++m) _Pragma("unroll") for (int k = 0; k < 2; ++k) dst[m][k] = *(const PG8_LAS bf16x8*)(lds + PG8_SA(b, h) + aoff + m * 2048 + k * 1024); } while (0)
#define PG8_LDB(dst, b, h) do { _Pragma("unroll") for (int n = 0; n < 2; ++n) _Pragma("unroll") for (int k = 0; k < 2; ++k) dst[n][k] = *(const PG8_LAS bf16x8*)(lds + PG8_SB(b, h) + boff + n * 2048 + k * 1024); } while (0)
#define PG8_MMA(ai, bj, At, Bt) do { __builtin_amdgcn_s_setprio(1); _Pragma("unroll") for (int m = 0; m < 4; ++m) _Pragma("unroll") for (int n = 0; n < 2; ++n) _Pragma("unroll") for (int k = 0; k < 2; ++k) \
        acc[ai][bj][m][n] = __builtin_amdgcn_mfma_f32_16x16x32_bf16(Bt[n][k], At[m][k], acc[ai][bj][m][n], 0, 0, 0); __builtin_amdgcn_s_setprio(0); } while (0)
#define PG8_WAIT_V(n) asm volatile("s_waitcnt vmcnt(" #n ")" ::: "memory")
#define PG8_WAIT_L(n) asm volatile("s_waitcnt lgkmcnt(" #n ")" ::: "memory")
#define PG8_BAR __builtin_amdgcn_s_barrier()
#define PG8_SCHED __builtin_amdgcn_sched_barrier(0)
    Unit cur, nxt; int ui = 0;
    if (!S.next(0, cur)) return;
    f32x4 acc[2][2][4][2];
#pragma unroll
    for (int a = 0; a < 2; ++a)
#pragma unroll
        for (int b = 0; b < 2; ++b)
#pragma unroll
            for (int m = 0; m < 4; ++m)
#pragma unroll
                for (int n = 0; n < 2; ++n) acc[a][b][m][n] = (f32x4){0.f, 0.f, 0.f, 0.f};
    bf16x8 At[4][2], B0[2][2], B1[2][2];
    const char* cA = (const char*)g.A + (size_t)cur.pm * tstep; const char* cB = (const char*)g.Bt + (size_t)cur.pn * tstep;
    S.a_ready(cur);
    if constexpr (SP2) {
        PG8_STAGE(PG8_SB(0, 0), cB, voffB); PG8_STAGE(PG8_SB(0, 1), cB + hstep, voffB); PG8_STAGE(PG8_SA(0, 0), cA, voffA); PG8_STAGE(PG8_SA(0, 1), cA + hstep, voffA);
        if (wr == 1) PG8_BAR;
        PG8_WAIT_V(2); PG8_BAR;
        PG8_STAGE(PG8_SB(1, 0), cB + kstep, voffB); PG8_STAGE(PG8_SA(1, 0), cA + kstep, voffA); PG8_STAGE(PG8_SB(1, 1), cB + hstep + kstep, voffB);
        PG8_WAIT_V(6); PG8_BAR;
    } else {
        PG8_STAGE(PG8_SB(0, 0), cB, voffB); PG8_STAGE(PG8_SA(0, 0), cA, voffA); PG8_STAGE(PG8_SB(0, 1), cB + hstep, voffB); PG8_STAGE(PG8_SA(0, 1), cA + hstep, voffA);
        if (wr == 1) PG8_BAR;
        PG8_WAIT_V(4); PG8_BAR;
        PG8_STAGE(PG8_SB(1, 0), cB + kstep, voffB); PG8_STAGE(PG8_SA(1, 0), cA + kstep, voffA); PG8_STAGE(PG8_SB(1, 1), cB + hstep + kstep, voffB);
        PG8_WAIT_V(6); PG8_BAR;
    }
    for (;;) {
        const bool has_next = S.next(ui + 1, nxt);
        const char* nA = has_next ? (const char*)g.A + (size_t)nxt.pm * tstep : cA; const char* nB = has_next ? (const char*)g.Bt + (size_t)nxt.pn * tstep : cB;
        for (int t = 0; t < nt; t += 2) {
            const bool last = (t == nt - 2);
            const char* a1 = cA + (size_t)(t + 1) * kstep;
            const char* a2 = last ? nA : cA + (size_t)(t + 2) * kstep; const char* b2 = last ? nB : cB + (size_t)(t + 2) * kstep;
            const char* a3 = a2 + kstep; const char* b3 = b2 + kstep;
            if (last && has_next) S.a_ready(nxt);
            if constexpr (SP2) {
            PG8_LDB(B0, 0, 0); PG8_LDB(B1, 0, 1); PG8_SCHED; PG8_LDA(At, 0, 0); PG8_STAGE(PG8_SA(1, 1), a1 + hstep, voffA);
            PG8_WAIT_V(8); PG8_WAIT_L(0); PG8_BAR; PG8_MMA(0, 0, At, B0); PG8_MMA(0, 1, At, B1); PG8_BAR; PG8_SCHED;
            PG8_LDA(At, 0, 1); PG8_STAGE(PG8_SB(0, 0), b2, voffB); PG8_STAGE(PG8_SB(0, 1), b2 + hstep, voffB); PG8_STAGE(PG8_SA(0, 0), a2, voffA);
            PG8_WAIT_V(8); PG8_WAIT_L(0); PG8_BAR; PG8_MMA(1, 0, At, B0); PG8_MMA(1, 1, At, B1); PG8_BAR; PG8_SCHED;
            PG8_LDB(B0, 1, 0); PG8_LDB(B1, 1, 1); PG8_SCHED; PG8_LDA(At, 1, 0); PG8_STAGE(PG8_SA(0, 1), a2 + hstep, voffA);
            PG8_WAIT_V(8); PG8_WAIT_L(0); PG8_BAR; PG8_MMA(0, 0, At, B0); PG8_MMA(0, 1, At, B1); PG8_BAR; PG8_SCHED;
            PG8_LDA(At, 1, 1); PG8_STAGE(PG8_SB(1, 0), b3, voffB); PG8_STAGE(PG8_SB(1, 1), b3 + hstep, voffB); PG8_STAGE(PG8_SA(1, 0), a3, voffA);
            PG8_WAIT_V(8); PG8_WAIT_L(0); PG8_BAR; PG8_MMA(1, 0, At, B0); PG8_MMA(1, 1, At, B1); PG8_BAR; PG8_SCHED;
            } else {
            PG8_LDB(B0, 0, 0); PG8_SCHED; PG8_LDA(At, 0, 0); PG8_STAGE(PG8_SA(1, 1), a1 + hstep, voffA);
            PG8_WAIT_L(8); PG8_BAR; PG8_WAIT_L(0); PG8_MMA(0, 0, At, B0); PG8_BAR; PG8_SCHED;
            PG8_LDB(B1, 0, 1); PG8_STAGE(PG8_SB(0, 0), b2, voffB);
            PG8_BAR; PG8_WAIT_L(0); PG8_MMA(0, 1, At, B1); PG8_BAR;
            PG8_LDA(At, 0, 1); PG8_STAGE(PG8_SA(0, 0), a2, voffA);
            PG8_BAR; PG8_WAIT_L(0); PG8_MMA(1, 0, At, B0); PG8_BAR; PG8_SCHED;
            PG8_STAGE(PG8_SB(0, 1), b2 + hstep, voffB);
            PG8_WAIT_V(6); PG8_BAR; PG8_MMA(1, 1, At, B1); PG8_BAR;
            PG8_LDB(B0, 1, 0); PG8_SCHED; PG8_LDA(At, 1, 0); PG8_STAGE(PG8_SA(0, 1), a2 + hstep, voffA);
            PG8_WAIT_L(8); PG8_BAR; PG8_WAIT_L(0); PG8_MMA(0, 0, At, B0); PG8_BAR; PG8_SCHED;
            PG8_LDB(B1, 1, 1); PG8_STAGE(PG8_SB(1, 0), b3, voffB);
            PG8_BAR; PG8_WAIT_L(0); PG8_MMA(0, 1, At, B1); PG8_BAR;
            PG8_LDA(At, 1, 1); PG8_STAGE(PG8_SA(1, 0), a3, voffA);
            PG8_BAR; PG8_WAIT_L(0); PG8_MMA(1, 0, At, B0); PG8_BAR; PG8_SCHED;
            PG8_STAGE(PG8_SB(1, 1), b3 + hstep, voffB);
            PG8_WAIT_V(6); PG8_BAR; PG8_MMA(1, 1, At, B1); PG8_BAR;
            }
        }
        if constexpr (ALIGN_EPI) { if (wr == 0) PG8_BAR; }
        if constexpr (!Epi::AFTER_DRAIN) { E(acc, cur, wr, wc, fr, fq); S.done(cur); }
        if (!has_next) break;
#pragma unroll
        for (int a = 0; a < 2; ++a)
#pragma unroll
            for (int b = 0; b < 2; ++b)
#pragma unroll
                for (int m = 0; m < 4; ++m)
#pragma unroll
                    for (int n = 0; n < 2; ++n) acc[a][b][m][n] = (f32x4){0.f, 0.f, 0.f, 0.f};
        cur = nxt; cA = nA; cB = nB; ++ui;
        if constexpr (ALIGN_EPI) { if (wr == 1) PG8_BAR; }
    }
    PG8_WAIT_V(0);
    if constexpr (!ALIGN_EPI) { if (wr == 0) PG8_BAR; }
    PG8_BAR;
    if constexpr (Epi::AFTER_DRAIN) { E.fused(acc, cur, wr, wc, fr, fq, lds, wid, lane); S.done(cur); }
#undef PG8_SA
#undef PG8_SB
#undef PG8_STAGE
#undef PG8_LDA
#undef PG8_LDB
#undef PG8_MMA
#undef PG8_WAIT_V
#undef PG8_WAIT_L
#undef PG8_BAR
#undef PG8_SCHED
}
}
#ifndef PG8_SP2
#define PG8_SP2 true
#endif
#ifndef PG8_ALIGN
#define PG8_ALIGN true
#endif
constexpr int S = 16384, D = 1024, DEPTH = 4, NW = 8, NTHR = 512;
constexpr int PEER_E = 16384;
constexpr float LN_EPS = 1e-5f;
constexpr float DN_ALPHA = 1.681792830507429f;
constexpr float LOG2E = 1.4426950408889634f, LN2F = 0.6931471805599453f;
constexpr size_t MiB = 1u << 20;
constexpr size_t WS_CTL = 0;
constexpr size_t WS_WQKV_A = 1 * MiB;
constexpr size_t WS_WO_A = WS_WQKV_A + 5 * MiB;
constexpr size_t WS_WQKV_B = WS_WO_A + 4 * MiB;
constexpr size_t WS_WO_B = WS_WQKV_B + 10 * MiB;
constexpr size_t WS_WQKV_C = WS_WO_B + 2 * MiB;
constexpr size_t WS_WO_C = WS_WQKV_C + 6 * MiB;
constexpr size_t WS_WEFF = WS_WO_C + 2 * MiB;
constexpr size_t WS_PLEW = WS_WEFF + 16 * MiB;
constexpr size_t WS_PLEG = WS_PLEW + 2 * MiB;
constexpr size_t WS_KMEAN = WS_PLEG + 8 * MiB;
constexpr size_t WS_LSE = WS_KMEAN + 1 * MiB;
constexpr size_t WS_U = 64 * MiB;
constexpr size_t WS_V = WS_U + 128 * MiB;
constexpr size_t WS_P = WS_V + 128 * MiB;
constexpr size_t WS_F0 = WS_P + 32 * MiB;
constexpr size_t WS_F1 = WS_F0 + 64 * MiB;
constexpr size_t WS_B0 = WS_F1 + 64 * MiB;
constexpr size_t WS_B1 = WS_B0 + 32 * MiB;
constexpr size_t WS_QKV = WS_B1 + 32 * MiB;
constexpr size_t WS_O = WS_QKV + 160 * MiB;
constexpr size_t WS_OG = WS_O + 32 * MiB;
constexpr size_t WS_END = WS_OG + 96 * MiB;
static_assert(WS_LSE + 4 * MiB <= WS_U, "ws map");

constexpr int LDS_BYTES = 147456;

#define GAS __attribute__((address_space(1)))
#define LAS __attribute__((address_space(3)))
typedef unsigned short bf16;
typedef unsigned v4u __attribute__((ext_vector_type(4)));
typedef unsigned v2u __attribute__((ext_vector_type(2)));
typedef float f32x4 __attribute__((ext_vector_type(4)));
typedef short bf16x8 __attribute__((ext_vector_type(8)));
typedef float f32x2 __attribute__((ext_vector_type(2)));
typedef __bf16 bf2_t __attribute__((ext_vector_type(2)));

__device__ __forceinline__ unsigned f2bf(float f) { unsigned u = __builtin_bit_cast(unsigned, f); return (u + 0x7fffu + ((u >> 16) & 1u)) >> 16; }
__device__ __forceinline__ unsigned pk2(float lo, float hi) { return f2bf(lo) | (f2bf(hi) << 16); }
__device__ __forceinline__ float bflo(unsigned w) { return __uint_as_float(w << 16); }
__device__ __forceinline__ float bfhi(unsigned w) { return __uint_as_float(w & 0xffff0000u); }
__device__ __forceinline__ float wave_sum(float v) {
#pragma unroll
    for (int o = 1; o < 64; o <<= 1) v += __shfl_xor(v, o);
    return v;
}
#define DPPI(x, ctl) __builtin_amdgcn_update_dpp(0, (int)(x), (ctl), 0xF, 0xF, true)
__device__ __forceinline__ unsigned row_max_u32(unsigned x) {
    unsigned y;
    y = (unsigned)DPPI(x, 0xB1); x = x > y ? x : y;
    y = (unsigned)DPPI(x, 0x4E); x = x > y ? x : y;
    y = (unsigned)DPPI(x, 0x141); x = x > y ? x : y;
    y = (unsigned)DPPI(x, 0x140); x = x > y ? x : y;
    return x;
}
__device__ __forceinline__ float row_max_f32(float x) {
    x = fmaxf(x, __int_as_float(DPPI(__float_as_int(x), 0xB1)));
    x = fmaxf(x, __int_as_float(DPPI(__float_as_int(x), 0x4E)));
    x = fmaxf(x, __int_as_float(DPPI(__float_as_int(x), 0x141)));
    x = fmaxf(x, __int_as_float(DPPI(__float_as_int(x), 0x140)));
    return x;
}
__device__ __forceinline__ float row_sum_f32(float x) {
    x += __int_as_float(DPPI(__float_as_int(x), 0xB1));
    x += __int_as_float(DPPI(__float_as_int(x), 0x4E));
    x += __int_as_float(DPPI(__float_as_int(x), 0x141));
    x += __int_as_float(DPPI(__float_as_int(x), 0x140));
    return x;
}
__device__ __forceinline__ float dot16bf(v4u a0, v4u a1, v4u b0, v4u b1) {
    float acc = 0.f;
    asm volatile("s_nop 1\n\tv_dot2c_f32_bf16 %0, %1, %9\n\tv_dot2c_f32_bf16 %0, %2, %10\n\tv_dot2c_f32_bf16 %0, %3, %11\n\tv_dot2c_f32_bf16 %0, %4, %12\n\t"
                 "v_dot2c_f32_bf16 %0, %5, %13\n\tv_dot2c_f32_bf16 %0, %6, %14\n\tv_dot2c_f32_bf16 %0, %7, %15\n\tv_dot2c_f32_bf16 %0, %8, %16\n\ts_nop 2"
                 : "+v"(acc)
                 : "v"(a0.x), "v"(a0.y), "v"(a0.z), "v"(a0.w), "v"(a1.x), "v"(a1.y), "v"(a1.z), "v"(a1.w),
                   "v"(b0.x), "v"(b0.y), "v"(b0.z), "v"(b0.w), "v"(b1.x), "v"(b1.y), "v"(b1.z), "v"(b1.w));
    return acc;
}
__device__ __forceinline__ unsigned sortable(float f) { const unsigned u = __float_as_uint(f); return (u & 0x80000000u) ? ~u : (u | 0x80000000u); }

__device__ __forceinline__ void p0_transpose_item(const float* W, int K, int N, bf16* WT, LAS float* scr, int item, int lane) {
    const int nblk = N / 32, kb = item / nblk, nb = item % nblk, k0 = 64 * kb, n0 = 32 * nb;
#pragma unroll 8
    for (int i = 0; i < 32; ++i) { const int kk = 2 * i + (lane >> 5); scr[kk * 33 + (lane & 31)] = W[(size_t)(k0 + kk) * N + n0 + (lane & 31)]; }
    asm volatile("s_waitcnt lgkmcnt(0)" ::: "memory");
    const int c = lane & 7;
#pragma unroll
    for (int j = 0; j < 4; ++j) { const int n = (lane >> 3) + 8 * j; const LAS float* s = scr + (8 * c) * 33 + n;
        v4u o; o.x = pk2(s[0 * 33], s[1 * 33]); o.y = pk2(s[2 * 33], s[3 * 33]); o.z = pk2(s[4 * 33], s[5 * 33]); o.w = pk2(s[6 * 33], s[7 * 33]);
        *(v4u*)(WT + (size_t)(n0 + n) * K + k0 + 8 * c) = o; }
    asm volatile("s_waitcnt lgkmcnt(0)" ::: "memory");
}
__device__ __forceinline__ void p0_transpose(const float* W, int K, int N, bf16* WT, LAS float* scr, int gw, int NGW, int lane) {
    const int items = (K / 64) * (N / 32);
    for (int it = gw; it < items; it += NGW) p0_transpose_item(W, K, N, WT, scr, it, lane);
}
__device__ __forceinline__ void p0_convert(const float* src, bf16* dst, size_t n, size_t gtid, size_t nthr) {
    const size_t n8 = n / 8;
    for (size_t i = gtid; i < n8; i += nthr) {
        const f32x4 a = *(const f32x4*)(src + i * 8), b = *(const f32x4*)(src + i * 8 + 4);
        v4u o; o.x = pk2(a.x, a.y); o.y = pk2(a.z, a.w); o.z = pk2(b.x, b.y); o.w = pk2(b.z, b.w);
        *(v4u*)(dst + i * 8) = o;
    }
}
__device__ __forceinline__ void p0_convert8(const float* src, unsigned char* dst, size_t n, float scale, size_t gtid, size_t nthr) {
    const size_t n16 = n / 16;
    for (size_t i = gtid; i < n16; i += nthr) {
        v4u o;
#pragma unroll
        for (int q = 0; q < 4; ++q) { const f32x4 a = *(const f32x4*)(src + i * 16 + q * 4);
            int w = __builtin_amdgcn_cvt_pk_fp8_f32(a.x * scale, a.y * scale, 0, false); w = __builtin_amdgcn_cvt_pk_fp8_f32(a.z * scale, a.w * scale, w, true); o[q] = (unsigned)w; }
        *(v4u*)(dst + i * 16) = o;
    }
}
__device__ __forceinline__ void p0_weff(const float* wq, const float* subk, bf16* weff, LAS unsigned char* lds, int bid, int G, int tid) {
    LAS float* SK = (LAS float*)lds;
    LAS float* WQ = SK + 128 * 129;
    for (int unit = bid; unit < 256; unit += G) {
        const int i = unit >> 6, hc = (unit >> 2) & 15, kq = unit & 3, c = hc & 1;
        __syncthreads();
        const float* sk = subk + ((size_t)(i * 2 + c) * 128) * 128;
        for (int idx = tid; idx < 128 * 128; idx += NTHR) SK[(idx >> 7) * 129 + (idx & 127)] = sk[idx];
        const int k = tid & 127, kg = tid >> 7;
        for (int kt = 0; kt < 8; ++kt) {
            const int kk0 = kq * 256 + kt * 32;
            __syncthreads();
            for (int idx = tid; idx < 32 * 128; idx += NTHR) WQ[(idx >> 7) * 129 + (idx & 127)] = wq[((size_t)i * 1024 + kk0 + (idx >> 7)) * 2048 + hc * 128 + (idx & 127)];
            __syncthreads();
            float acc[8];
#pragma unroll
            for (int j = 0; j < 8; ++j) acc[j] = 0.f;
            for (int d = 0; d < 128; ++d) { const float a = SK[k * 129 + d];
#pragma unroll
                for (int j = 0; j < 8; ++j) acc[j] += a * WQ[(kg * 8 + j) * 129 + d]; }
            v4u o; o.x = pk2(acc[0], acc[1]); o.y = pk2(acc[2], acc[3]); o.z = pk2(acc[4], acc[5]); o.w = pk2(acc[6], acc[7]);
            *(v4u*)(weff + ((size_t)i * 2048 + hc * 128 + k) * 1024 + kk0 + kg * 8) = o;
        }
    }
    __syncthreads();
}

__device__ __forceinline__ void ln_row(const float* zrow, const float* g, const float* b, float* orow, bf16* obrow, int lane) {
    const f32x4* zr = (const f32x4*)zrow + lane;
    f32x4 v[4]; float s = 0.f;
#pragma unroll
    for (int j = 0; j < 4; ++j) { v[j] = zr[64 * j]; s += (v[j].x + v[j].y) + (v[j].z + v[j].w); }
    const float mean = wave_sum(s) * (1.f / D); float s2 = 0.f;
#pragma unroll
    for (int j = 0; j < 4; ++j) { v[j] = v[j] - mean; s2 += (v[j].x * v[j].x + v[j].y * v[j].y) + (v[j].z * v[j].z + v[j].w * v[j].w); }
    const float rstd = 1.f / sqrtf(wave_sum(s2) * (1.f / D) + LN_EPS);
#pragma unroll
    for (int j = 0; j < 4; ++j) { const f32x4 gg = ((const f32x4*)g + lane)[64 * j], bb = ((const f32x4*)b + lane)[64 * j];
        const f32x4 o = v[j] * rstd * gg + bb; ((f32x4*)orow + lane)[64 * j] = o;
        v2u w; w.x = pk2(o.x, o.y); w.y = pk2(o.z, o.w); ((v2u*)obrow + lane)[64 * j] = w; }
}

namespace att {
constexpr int KP = 144;
constexpr int VT_OFF = 64 * KP;
constexpr int MISC_OFF = 2 * 64 * KP;
struct Stage { v4u k, v; };
__device__ __forceinline__ Stage gload(const bf16* kb, const bf16* vb, int pitch, int tok0, int tstride, int jd0, int tid) {
    Stage s; const int row = tid >> 3, ch = tid & 7, key = tid & 63, vc = tid >> 6;
    s.k = *(const v4u*)(kb + (size_t)(tok0 + tstride * (jd0 + row)) * pitch + ch * 8);
    s.v = *(const v4u*)(vb + (size_t)(tok0 + tstride * (jd0 + key)) * pitch + vc * 8);
    return s;
}
__device__ __forceinline__ void lstore(LAS unsigned char* lds, const Stage& s, int tid) {
    const int row = tid >> 3, ch = tid & 7, key = tid & 63, vc = tid >> 6;
    *(LAS v4u*)(lds + row * KP + ch * 16) = s.k;
    LAS unsigned short* vt = (LAS unsigned short*)(lds + VT_OFF);
#pragma unroll
    for (int i = 0; i < 8; ++i) vt[(vc * 8 + i) * (KP / 2) + key] = (unsigned short)(s.v[i >> 1] >> ((i & 1) * 16));
}
__device__ __forceinline__ void qk(f32x4 (&s)[4], LAS const unsigned char* lds, const bf16x8 (&qf)[2], int fr, int g) {
#pragma unroll
    for (int mt = 0; mt < 4; ++mt) { s[mt] = (f32x4){0.f, 0.f, 0.f, 0.f};
#pragma unroll
        for (int ks = 0; ks < 2; ++ks) { const bf16x8 kf = *(const LAS bf16x8*)(lds + (mt * 16 + fr) * KP + (ks * 32 + 8 * g) * 2);
            s[mt] = __builtin_amdgcn_mfma_f32_16x16x32_bf16(kf, qf[ks], s[mt], 0, 0, 0); } }
}
typedef __bf16 bf16x2v __attribute__((ext_vector_type(2)));
__device__ __forceinline__ unsigned cvtpk(float lo, float hi) { const f32x2 v = {lo, hi}; return __builtin_bit_cast(unsigned, __builtin_convertvector(v, bf16x2v)); }
constexpr float M_INIT = -1e20f, M_MASK = -1e30f;
template <int VPITCH, bool FULL>
__device__ __forceinline__ void tile_compute_g(LAS const unsigned char* klds, LAS const unsigned char* vlds, const bf16x8 (&qf)[2], float& m, float& l, f32x4 (&o)[4], int dist0, bool lane_ok, int maxd, float sc2, float slope2, int fr, int g) {
    f32x4 s[4];
    qk(s, klds, qf, fr, g);
    float tmax = M_MASK;
    if (FULL) {
        const float base = lane_ok ? -slope2 * (float)dist0 : M_MASK;
#pragma unroll
        for (int mt = 0; mt < 4; ++mt)
#pragma unroll
            for (int r = 0; r < 4; ++r) { const float val = __builtin_fmaf(s[mt][r], sc2, __builtin_fmaf(slope2, (float)(mt * 16 + r), base)); s[mt][r] = val; tmax = fmaxf(tmax, val); }
    } else {
#pragma unroll
        for (int mt = 0; mt < 4; ++mt)
#pragma unroll
            for (int r = 0; r < 4; ++r) { const int d = dist0 - mt * 16 - r; const bool valid = lane_ok && d >= 0 && d <= maxd;
                const float val = valid ? (s[mt][r] * sc2 - slope2 * (float)d) : M_MASK; s[mt][r] = val; tmax = fmaxf(tmax, val); }
    }
    tmax = fmaxf(tmax, __shfl_xor(tmax, 16)); tmax = fmaxf(tmax, __shfl_xor(tmax, 32));
    const float mnew = fmaxf(m, tmax), alpha = __builtin_amdgcn_exp2f(m - mnew);
    float psum = 0.f;
#pragma unroll
    for (int mt = 0; mt < 4; ++mt)
#pragma unroll
        for (int r = 0; r < 4; ++r) { const float p = __builtin_amdgcn_exp2f(s[mt][r] - mnew); psum += p; s[mt][r] = p; }
    l = l * alpha + psum; m = mnew;
#pragma unroll
    for (int dt = 0; dt < 4; ++dt) o[dt] = o[dt] * alpha;
    bf16x8 pb[2];
#pragma unroll
    for (int kk = 0; kk < 2; ++kk) { v4u w; w.x = cvtpk(s[2 * kk][0], s[2 * kk][1]); w.y = cvtpk(s[2 * kk][2], s[2 * kk][3]); w.z = cvtpk(s[2 * kk + 1][0], s[2 * kk + 1][1]); w.w = cvtpk(s[2 * kk + 1][2], s[2 * kk + 1][3]);
        pb[kk] = __builtin_bit_cast(bf16x8, w); }
#pragma unroll
    for (int dt = 0; dt < 4; ++dt)
#pragma unroll
        for (int kk = 0; kk < 2; ++kk) { LAS const unsigned char* vp = vlds + (dt * 16 + fr) * VPITCH + (32 * kk + 4 * g) * 2;
            const v2u lo = *(const LAS v2u*)vp, hi = *(const LAS v2u*)(vp + 32);
            v4u w; w.x = lo.x; w.y = lo.y; w.z = hi.x; w.w = hi.y;
            o[dt] = __builtin_amdgcn_mfma_f32_16x16x32_bf16(__builtin_bit_cast(bf16x8, w), pb[kk], o[dt], 0, 0, 0); }
}
template <int VPITCH>
__device__ __forceinline__ void tile_compute_auto(LAS const unsigned char* klds, LAS const unsigned char* vlds, const bf16x8 (&qf)[2], float& m, float& l, f32x4 (&o)[4], int iq, int iq_lo, int jd0, bool lane_ok, int maxd, float sc2, float slope2, int fr, int g) {
    const bool full = (jd0 + 63 <= iq_lo) && (jd0 >= iq_lo + 15 - maxd);
    if (full) tile_compute_g<VPITCH, true>(klds, vlds, qf, m, l, o, iq - jd0 - 4 * g, lane_ok, maxd, sc2, slope2, fr, g);
    else tile_compute_g<VPITCH, false>(klds, vlds, qf, m, l, o, iq - jd0 - 4 * g, lane_ok, maxd, sc2, slope2, fr, g);
}
constexpr int VP4 = 528, VT4_OFF = 256 * KP, MISC4_OFF = VT4_OFF + 64 * VP4;
struct Stage4 { v4u k[4], v[4]; };
__device__ __forceinline__ void gload4(Stage4& s, const bf16* kb, const bf16* vb, int pitch, int tok0, int nsub, int tid) {
    const int row = tid >> 3, ch = tid & 7, key = tid & 63, vc = tid >> 6;
#pragma unroll
    for (int i = 0; i < 4; ++i) if (i < nsub) {
        s.k[i] = *(const GAS v4u*)(kb + (size_t)(tok0 + 64 * i + row) * pitch + ch * 8);
        s.v[i] = *(const GAS v4u*)(vb + (size_t)(tok0 + 64 * i + key) * pitch + vc * 8); }
}
__device__ __forceinline__ void lstore4(LAS unsigned char* lds, const Stage4& s, int nsub, int tid) {
    const int row = tid >> 3, ch = tid & 7, key = tid & 63, vc = tid >> 6;
    LAS unsigned short* vt = (LAS unsigned short*)(lds + VT4_OFF);
#pragma unroll
    for (int i = 0; i < 4; ++i) if (i < nsub) {
        *(LAS v4u*)(lds + (64 * i + row) * KP + ch * 16) = s.k[i];
#pragma unroll
        for (int e = 0; e < 8; ++e) vt[(vc * 8 + e) * (VP4 / 2) + 64 * i + key] = (unsigned short)(s.v[i][e >> 1] >> ((e & 1) * 16)); }
}
__device__ __forceinline__ void load_q(bf16x8 (&qf)[2], const bf16* qrow, int g) {
    qf[0] = *(const bf16x8*)(qrow + 8 * g); qf[1] = *(const bf16x8*)(qrow + 32 + 8 * g);
}
__device__ __forceinline__ void store_o(bf16* orow, const f32x4 (&o)[4], float scale, int g) {
#ifdef EXP_NOATT
    scale = 0.f;
#endif
#pragma unroll
    for (int dt = 0; dt < 4; ++dt) { v2u w; w.x = pk2(o[dt][0] * scale, o[dt][1] * scale); w.y = pk2(o[dt][2] * scale, o[dt][3] * scale); *(v2u*)(orow + dt * 16 + 4 * g) = w; }
}

__device__ __forceinline__ void banded_unit(LAS unsigned char* lds, const bf16* qb, const bf16* kb, const bf16* vb, int pitch, int tok0, int tstride, int idil0, int maxd, float slope2,
                                            float& m, float& l, f32x4 (&o)[4], int tid) {
    const int lane = tid & 63, w = tid >> 6, fr = lane & 15, g = lane >> 4;
    const int iq = idil0 + 16 * w + fr;
    bf16x8 qf[2]; load_q(qf, qb + (size_t)(tok0 + tstride * iq) * pitch, g);
    m = M_INIT; l = 0.f;
#pragma unroll
    for (int dt = 0; dt < 4; ++dt) o[dt] = (f32x4){0.f, 0.f, 0.f, 0.f};
    const int kt0 = idil0 >= 128 ? 0 : 2;
    Stage st = gload(kb, vb, pitch, tok0, tstride, idil0 - 128 + 64 * kt0, tid);
    for (int kt = kt0; kt < 4; ++kt) {
        const int jd0 = idil0 - 128 + 64 * kt;
        __syncthreads();
        lstore(lds, st, tid);
        __syncthreads();
        if (kt + 1 < 4) st = gload(kb, vb, pitch, tok0, tstride, jd0 + 64, tid);
        const bool poss = (jd0 <= iq) && (jd0 + 63 >= iq - maxd);
        if (__any(poss)) tile_compute_auto<KP>(lds, lds + VT_OFF, qf, m, l, o, iq, idil0 + 16 * w, jd0, true, maxd, 0.125f * LOG2E, slope2, fr, g);
    }
    l += __shfl_xor(l, 16); l += __shfl_xor(l, 32);
}
}

#define XB_TMO      128
#define XB_XCNT(j)  (256  + 64 * (j))
#define XB_XSUB(j)  (1280 + 64 * (j))
#define XB_XGEN(j)  (2304 + 64 * (j))
#define XB_TOP      3328
#define XB_TOPGEN   3392
#define XCD_BAR_WORDS 3456
#define XB_SPIN_CAP (1u << 18)

__device__ __forceinline__ unsigned xb_ld(unsigned* p)              { return __hip_atomic_load(p, __ATOMIC_RELAXED, __HIP_MEMORY_SCOPE_AGENT); }
__device__ __forceinline__ unsigned xb_add(unsigned* p, unsigned v) { return __hip_atomic_fetch_add(p, v, __ATOMIC_RELAXED, __HIP_MEMORY_SCOPE_AGENT); }
__device__ __forceinline__ unsigned xb_xcc_id() { return (unsigned)__builtin_amdgcn_s_getreg((3 << 11) | 20) & 0xFu; }
#define XB_SPIN(cond, bar) do { unsigned _sp = 0; while (cond) { __builtin_amdgcn_s_sleep(1); \
    if ((++_sp & 255u) == 0u) { if (xb_ld(&(bar)[XB_TMO])) break; if (_sp > XB_SPIN_CAP) { atomicAdd(&(bar)[XB_TMO], 1u); break; } } } } while (0)

struct XcdBarrier {
    unsigned* bar; unsigned x;
    volatile LAS unsigned* st;
};

__device__ __forceinline__ XcdBarrier xcd_barrier_post(unsigned* bar, volatile LAS unsigned* st) {
    XcdBarrier b; b.bar = bar; b.x = xb_xcc_id(); b.st = st;
    if (threadIdx.x == 0) (void)xb_add(&bar[XB_XCNT(b.x)], 1u);
    return b;
}
__device__ __forceinline__ void xcd_barrier_complete(unsigned* bar, unsigned x, unsigned& nloc, unsigned& nx) {
    const unsigned G = gridDim.x * gridDim.y * gridDim.z;
    unsigned sum, cnt, mine, sp = 0u;
    for (;;) {
        sum = 0u; cnt = 0u; mine = 0u;
#pragma unroll
        for (unsigned j = 0; j < 16; ++j) { const unsigned c = xb_ld(&bar[XB_XCNT(j)]); sum += c; cnt += (c > 0u) ? 1u : 0u; mine = (j == x) ? c : mine; }
        if (sum == G) break;
        __builtin_amdgcn_s_sleep(1);
        if ((++sp & 255u) == 0u) { if (xb_ld(&bar[XB_TMO])) break; if (sp > XB_SPIN_CAP) { atomicAdd(&bar[XB_TMO], 1u); break; } }
    }
    nloc = mine > 0u ? mine : 1u; nx = cnt > 0u ? cnt : 1u;
}

__device__ __forceinline__ void xcd_barrier(const XcdBarrier& b) {
    asm volatile("s_waitcnt vmcnt(0)" ::: "memory");
    __syncthreads();
    if (threadIdx.x == 0) {
        unsigned* bar = b.bar;
        __builtin_amdgcn_s_waitcnt(0);
        unsigned nloc = b.st[0], nx = b.st[1];
        if (nloc == 0u) { xcd_barrier_complete(bar, b.x, nloc, nx); b.st[0] = nloc; b.st[1] = nx; }
        const unsigned old = xb_add(&bar[XB_XSUB(b.x)], 1u);
        const unsigned gen = old / nloc;
        if (old + 1u == (gen + 1u) * nloc) {
            __builtin_amdgcn_fence(__ATOMIC_RELEASE, "agent");
            asm volatile("s_waitcnt vmcnt(0)" ::: "memory");
            const unsigned og = xb_add(&bar[XB_TOP], 1u);
            const unsigned tg = og / nx;
            if (og + 1u == (tg + 1u) * nx) xb_add(&bar[XB_TOPGEN], 1u);
            else XB_SPIN(xb_ld(&bar[XB_TOPGEN]) == tg, bar);
            __builtin_amdgcn_fence(__ATOMIC_ACQUIRE, "agent");
            xb_add(&bar[XB_XGEN(b.x)], 1u);
            asm volatile("s_waitcnt vmcnt(0)" ::: "memory");
        } else {
            XB_SPIN(xb_ld(&bar[XB_XGEN(b.x)]) == gen, bar);
            __builtin_amdgcn_fence(__ATOMIC_ACQUIRE, "agent");
            asm volatile("s_waitcnt vmcnt(0)" ::: "memory");
        }
    }
    __syncthreads();
}

struct Args { const float* in[20]; float* out; unsigned char* ws; };
enum { I_X = 0, I_P, I_AWQKV, I_ASINK, I_AWO, I_BWQKV, I_BWO, I_CWQKV, I_CWO, I_LN1G, I_LN1B, I_LN2G, I_LN2B, I_PWQ, I_PSUBK, I_PU, I_PV, I_PLEW, I_PLEGW, I_PLEGB, I_OUT, I_WS };
constexpr int PTAB_OFF = 131072 + 1024, XBST_OFF = 131072 + 2048;
__device__ __forceinline__ unsigned long long ldp(LAS unsigned char* lds, int i) {
    volatile LAS unsigned* t = (volatile LAS unsigned*)(lds + PTAB_OFF);
    const unsigned lo = __builtin_amdgcn_readfirstlane(t[2 * i]), hi = __builtin_amdgcn_readfirstlane(t[2 * i + 1]);
    return ((unsigned long long)hi << 32) | lo;
}
#define INP(i) ((const float*)ldp(lds, (i)))
#define WSP() ((unsigned char*)ldp(lds, I_WS))
#define LAUNDER(v) asm volatile("" : "+s"(v))
struct Ctx { int tid, lane, wave, G, bid, gw, NGW; };
__device__ __forceinline__ Ctx mkctx() { Ctx c; int t_ = threadIdx.x; asm volatile("" : "+v"(t_)); c.tid = t_; c.lane = c.tid & 63; c.wave = __builtin_amdgcn_readfirstlane(c.tid >> 6); c.G = gridDim.x; c.bid = blockIdx.x; c.gw = c.bid * NW + c.wave; c.NGW = c.G * NW; return c; }

__device__ __forceinline__ void ph_prologue(LAS unsigned char* lds) {
    const Ctx c = mkctx(); unsigned char* ws = WSP();
    const size_t gtid = (size_t)c.bid * NTHR + c.tid, nthr = (size_t)c.G * NTHR;
    LAS float* scr = (LAS float*)(lds + c.wave * 16384);
    for (int j = 0; j < 2; ++j) {
        p0_transpose(INP(I_AWQKV) + (size_t)j * 1024 * 1280, 1024, 1280, (bf16*)(ws + WS_WQKV_A) + (size_t)j * 1280 * 1024, scr, c.gw, c.NGW, c.lane);
        p0_transpose(INP(I_AWO) + (size_t)j * 1024 * 1024, 1024, 1024, (bf16*)(ws + WS_WO_A) + (size_t)j * 1024 * 1024, scr, c.gw, c.NGW, c.lane);
    }
    p0_transpose(INP(I_BWQKV), 1024, 5120, (bf16*)(ws + WS_WQKV_B), scr, c.gw, c.NGW, c.lane);
    p0_transpose(INP(I_BWO), 1024, 1024, (bf16*)(ws + WS_WO_B), scr, c.gw, c.NGW, c.lane);
    p0_transpose(INP(I_CWQKV), 1024, 3072, (bf16*)(ws + WS_WQKV_C), scr, c.gw, c.NGW, c.lane);
    p0_transpose(INP(I_CWO), 1024, 1024, (bf16*)(ws + WS_WO_C), scr, c.gw, c.NGW, c.lane);
    for (int i = 0; i < DEPTH; ++i) {
        p0_transpose(INP(I_PLEW) + (size_t)i * 256 * 1024, 256, 1024, (bf16*)(ws + WS_PLEW) + (size_t)i * 1024 * 256, scr, c.gw, c.NGW, c.lane);
        p0_transpose(INP(I_PLEGW) + (size_t)i * 1024 * 1024, 1024, 1024, (bf16*)(ws + WS_PLEG) + (size_t)i * 1024 * 1024, scr, c.gw, c.NGW, c.lane);
    }
    p0_convert(INP(I_X), (bf16*)(ws + WS_B0), (size_t)S * D, gtid, nthr);
    p0_convert(INP(I_P), (bf16*)(ws + WS_P), (size_t)DEPTH * S * 256, gtid, nthr);
    p0_convert8(INP(I_PU), ws + WS_U, (size_t)DEPTH * PEER_E * D, 32.0f, gtid, nthr);
    p0_convert8(INP(I_PV), ws + WS_V, (size_t)DEPTH * PEER_E * D, 8.0f, gtid, nthr);
    p0_weff(INP(I_PWQ), INP(I_PSUBK), (bf16*)(ws + WS_WEFF), lds, c.bid, c.G, c.tid);
}
__device__ __forceinline__ bf16* bcur(unsigned char* ws, int li) { return (bf16*)(ws + ((li & 1) ? WS_B1 : WS_B0)); }
__device__ __forceinline__ bf16* both(unsigned char* ws, int li) { return (bf16*)(ws + ((li & 1) ? WS_B0 : WS_B1)); }

__device__ __forceinline__ void ph_qkv(LAS unsigned char* lds, int li) {
    unsigned char* ws = WSP(); const int kind = li % 3, lj = li / 3;
    const int NQKV = kind == 0 ? 1280 : (kind == 1 ? 5120 : 3072);
    const bf16* wqkv = kind == 0 ? (const bf16*)(ws + WS_WQKV_A) + (size_t)lj * 1280 * 1024 : (kind == 1 ? (const bf16*)(ws + WS_WQKV_B) : (const bf16*)(ws + WS_WQKV_C));
    pg8::Gemm g{bcur(ws, li), wqkv, S, NQKV, D}; pg8::StaticOrder So; So.init(S, NQKV, (int)gridDim.x, (int)blockIdx.x);
    pg8::EpiBf16<0> E{(bf16*)(ws + WS_QKV), NQKV, nullptr, 0, 0, 1.f};
    pg8::gemm_phase<pg8::EpiBf16<0>, pg8::StaticOrder, PG8_ALIGN, PG8_SP2>(lds, g, So, E);
}
__device__ __forceinline__ void ph_attn_a(LAS unsigned char* lds, int li) {
    const Ctx c = mkctx(); unsigned char* ws = WSP(); const int lj = li / 3;
    bf16* const QKV = (bf16*)(ws + WS_QKV); bf16* const Ob = (bf16*)(ws + WS_O);
    const float* sinks = INP(I_ASINK) + lj * 16;
    for (int u = c.bid; u < 16 * 128; u += c.G) {
        const int h = u >> 7, qb = u & 127, kvh = h >> 3;
        const float slope = exp2f(-0.5f * (float)(h + 1));
        float m, l; f32x4 o[4];
        att::banded_unit(lds, QKV + h * 64, QKV + 1024 + kvh * 64, QKV + 1152 + kvh * 64, 1280, 0, 1, qb * 128, 127, slope * LOG2E, m, l, o, c.tid);
        const float sk2 = sinks[h] * LOG2E, mf = fmaxf(m, sk2), lf = l * exp2f(m - mf) + exp2f(sk2 - mf);
        const int tok = qb * 128 + 16 * (c.tid >> 6) + (c.lane & 15);
        att::store_o(Ob + (size_t)tok * 1024 + h * 64, o, exp2f(m - mf) / lf, c.lane >> 4);
    }
}
__device__ __forceinline__ void ph_attn_b(LAS unsigned char* lds) {
    const Ctx c = mkctx(); unsigned char* ws = WSP();
    bf16* const QKV = (bf16*)(ws + WS_QKV); bf16* const OG = (bf16*)(ws + WS_OG); float* const LSE = (float*)(ws + WS_LSE);
    for (int u = c.bid; u < 3 * 16 * 128; u += c.G) {
        const int gi = u >> 11, h = (u >> 7) & 15, uu = u & 127;
        const int r = gi == 0 ? 1 : (gi == 1 ? 4 : 16);
        const int cc = uu % r, b = uu / r;
        const float slope = exp2f(-0.5f * (float)(h + 1));
        float m, l; f32x4 o[4];
        att::banded_unit(lds, QKV + gi * 1024 + h * 64, QKV + 3072 + h * 64, QKV + 4096 + h * 64, 5120, cc, r, b * 128, 128, slope * (float)r * LOG2E, m, l, o, c.tid);
        const int tok = cc + r * (b * 128 + 16 * (c.tid >> 6) + (c.lane & 15));
        att::store_o(OG + ((size_t)gi * S + tok) * 1024 + h * 64, o, 1.0f / l, c.lane >> 4);
        if ((c.lane >> 4) == 0) LSE[((size_t)gi * S + tok) * 16 + h] = (m + log2f(l)) * LN2F;
    }
}
__device__ __forceinline__ void ph_merge_b(LAS unsigned char* lds) {
    const Ctx c = mkctx(); unsigned char* ws = WSP();
    const bf16* OG = (const bf16*)(ws + WS_OG); const float* LSE = (const float*)(ws + WS_LSE); bf16* const Ob = (bf16*)(ws + WS_O);
    const size_t gtid = (size_t)c.bid * NTHR + c.tid, nthr = (size_t)c.G * NTHR;
    for (size_t idx = gtid; idx < (size_t)S * 16 * 8; idx += nthr) {
        const int t = (int)(idx >> 7), h = (int)(idx >> 3) & 15, cch = (int)idx & 7;
        const float l0 = LSE[((size_t)0 * S + t) * 16 + h], l1 = LSE[((size_t)1 * S + t) * 16 + h], l2 = LSE[((size_t)2 * S + t) * 16 + h];
        const float mx = fmaxf(l0, fmaxf(l1, l2)); float w0 = __expf(l0 - mx), w1 = __expf(l1 - mx), w2 = __expf(l2 - mx); const float inv = 1.0f / (w0 + w1 + w2);
        w0 *= inv; w1 *= inv; w2 *= inv;
        const size_t off = (size_t)t * 1024 + h * 64 + cch * 8;
        const v4u a = *(const v4u*)(OG + off), bq = *(const v4u*)(OG + (size_t)S * 1024 + off), cq = *(const v4u*)(OG + (size_t)2 * S * 1024 + off);
        v4u o;
#pragma unroll
        for (int e = 0; e < 4; ++e) o[e] = pk2(w0 * bflo(a[e]) + w1 * bflo(bq[e]) + w2 * bflo(cq[e]), w0 * bfhi(a[e]) + w1 * bfhi(bq[e]) + w2 * bfhi(cq[e]));
        *(v4u*)(Ob + off) = o;
    }
}
__device__ __forceinline__ void ph_kmean(LAS unsigned char* lds) {
    const Ctx c = mkctx(); unsigned char* ws = WSP();
    const bf16* QKV = (const bf16*)(ws + WS_QKV); bf16* const KMEAN = (bf16*)(ws + WS_KMEAN);
    const size_t gtid = (size_t)c.bid * NTHR + c.tid, nthr = (size_t)c.G * NTHR;
    for (size_t idx = gtid; idx < 64 * 512; idx += nthr) {
        const int blk = (int)(idx >> 9), cp = (int)idx & 511;
        const bf16* kp = QKV + (size_t)blk * 256 * 3072 + 1024 + cp * 2;
        float s0 = 0.f, s1 = 0.f;
        for (int r = 0; r < 256; ++r) { const unsigned w = *(const unsigned*)(kp + (size_t)r * 3072); s0 += bflo(w); s1 += bfhi(w); }
        *(unsigned*)(KMEAN + blk * 1024 + cp * 2) = pk2(s0 * (1.f / 256.f), s1 * (1.f / 256.f));
    }
}
__device__ __forceinline__ void ph_attn_c(LAS unsigned char* lds) {
    const Ctx c = mkctx(); unsigned char* ws = WSP();
    const bf16* QKV = (const bf16*)(ws + WS_QKV); const bf16* KMEAN = (const bf16*)(ws + WS_KMEAN); bf16* const Ob = (bf16*)(ws + WS_O);
    const int tid = c.tid, lane = c.lane, G = c.G, bid = c.bid;
    const int rounds = (2048 + G - 1) / G;
    for (int rd = 0; rd < rounds; ++rd) {
        const int L = rd * G + ((rd & 1) ? (G - 1 - bid) : bid);
        if (L >= 2048) continue;
        const int qt = 127 - (L >> 4), h = L & 15, qblk = qt >> 1, t0 = qt * 128;
        const int w = tid >> 6, fr = lane & 15, g = lane >> 4;
        const int iq = t0 + 16 * w + fr;
        const bf16* qb = QKV + h * 64; const bf16* kb = QKV + 1024 + h * 64; const bf16* vb = QKV + 2048 + h * 64;
        const float slope2 = exp2f(-0.5f * (float)(h + 1)) * LOG2E;
        bf16x8 qf[2]; att::load_q(qf, qb + (size_t)iq * 3072, g);
        unsigned long long selmask = 0ull, bunion = 0ull;
        if (qblk > 0) {
            __syncthreads();
            { const int row = tid >> 3, ch = tid & 7; *(LAS v4u*)(lds + row * att::KP + ch * 16) = *(const v4u*)(KMEAN + row * 1024 + h * 64 + ch * 8); }
            __syncthreads();
            f32x4 s[4]; att::qk(s, lds, qf, fr, g);
            const int nsel = qblk < 3 ? qblk : 3;
            for (int sr = 0; sr < nsel; ++sr) {
                float best = -INFINITY; int bi = 64;
#pragma unroll
                for (int mt = 0; mt < 4; ++mt)
#pragma unroll
                    for (int r = 0; r < 4; ++r) { const int n = mt * 16 + 4 * g + r; const bool ok = n < qblk && !((selmask >> n) & 1ull);
                        if (ok && (s[mt][r] > best || bi == 64)) { best = s[mt][r]; bi = n; } }
#pragma unroll
                for (int x = 16; x <= 32; x <<= 1) { const float ob = __shfl_xor(best, x); const int oi = __shfl_xor(bi, x);
                    if (oi < 64 && (bi == 64 || ob > best || (ob == best && oi < bi))) { best = ob; bi = oi; } }
                selmask |= 1ull << bi;
            }
            unsigned lo = (unsigned)selmask, hi = (unsigned)(selmask >> 32);
#pragma unroll
            for (int x = 1; x < 16; x <<= 1) { lo |= __shfl_xor(lo, x); hi |= __shfl_xor(hi, x); }
            LAS unsigned* wun = (LAS unsigned*)(lds + att::MISC4_OFF);
            if (lane == 0) { wun[2 * w] = lo; wun[2 * w + 1] = hi; }
            __syncthreads();
            unsigned ul = 0, uh = 0;
#pragma unroll
            for (int x = 0; x < 8; ++x) { ul |= wun[2 * x]; uh |= wun[2 * x + 1]; }
            bunion = ((unsigned long long)uh << 32) | ul;
        }
        float m = att::M_INIT, l = 0.f; f32x4 o[4];
#pragma unroll
        for (int dt = 0; dt < 4; ++dt) o[dt] = (f32x4){0.f, 0.f, 0.f, 0.f};
        const int nown = (t0 + 128 - qblk * 256) / 64;
        unsigned long long todo = bunion;
        int kbcur = todo ? (__ffsll((long long)todo) - 1) : qblk;
        if (todo) todo &= todo - 1;
        att::Stage4 st; att::gload4(st, (const bf16*)kb, (const bf16*)vb, 3072, kbcur * 256, kbcur == qblk ? nown : 4, tid);
        for (;;) {
            const bool own = kbcur == qblk; const int nsub = own ? nown : 4;
            int nkb = qblk; bool more = !own;
            if (!own && todo) { nkb = __ffsll((long long)todo) - 1; todo &= todo - 1; }
            __syncthreads();
            att::lstore4(lds, st, nsub, tid);
            __syncthreads();
            if (more) att::gload4(st, (const bf16*)kb, (const bf16*)vb, 3072, nkb * 256, nkb == qblk ? nown : 4, tid);
            const bool sel_ok = own || (((selmask >> kbcur) & 1ull) != 0ull);
            if (__any(sel_ok)) {
#pragma unroll 1
                for (int sub = 0; sub < nsub; ++sub) { const int jd0 = kbcur * 256 + sub * 64; const bool lane_ok = sel_ok && (jd0 <= iq);
                    if (__any(lane_ok)) att::tile_compute_auto<att::VP4>(lds + sub * 64 * att::KP, lds + att::VT4_OFF + sub * 128, qf, m, l, o, iq, t0 + 16 * w, jd0, lane_ok, 0x3fffffff, 0.125f * LOG2E, slope2, fr, g); }
            }
            if (!more) break;
            kbcur = nkb;
        }
        l += __shfl_xor(l, 16); l += __shfl_xor(l, 32);
        att::store_o(Ob + (size_t)iq * 1024 + h * 64, o, 1.0f / l, g);
    }
}
__device__ __forceinline__ void ph_oproj(LAS unsigned char* lds, int li) {
    unsigned char* ws = WSP(); const int kind = li % 3, lj = li / 3;
    const bf16* wo = kind == 0 ? (const bf16*)(ws + WS_WO_A) + (size_t)lj * 1024 * 1024 : (kind == 1 ? (const bf16*)(ws + WS_WO_B) : (const bf16*)(ws + WS_WO_C));
    const float* xin = li == 0 ? INP(I_X) : (const float*)(ws + WS_F0);
    pg8::Gemm g{(const bf16*)(ws + WS_O), wo, S, D, D}; pg8::StaticOrder So; So.init(S, D, (int)gridDim.x, (int)blockIdx.x);
    pg8::EpiResid E{xin, (float*)(ws + WS_F1), D, DN_ALPHA};
    pg8::gemm_phase<pg8::EpiResid, pg8::StaticOrder, PG8_ALIGN, PG8_SP2>(lds, g, So, E);
}
__device__ __forceinline__ void ph_ln1(LAS unsigned char* lds, int li) {
    const Ctx c = mkctx(); unsigned char* ws = WSP();
    float* const F1 = (float*)(ws + WS_F1); bf16* const Bc = bcur(ws, li);
    const float* g1 = INP(I_LN1G) + li * D; const float* b1 = INP(I_LN1B) + li * D;
    for (int r = c.gw; r < S; r += c.NGW) ln_row(F1 + (size_t)r * D, g1, b1, F1 + (size_t)r * D, Bc + (size_t)r * D, c.lane);
}
__device__ __forceinline__ void ph_sc(LAS unsigned char* lds, int li) {
    unsigned char* ws = WSP();
    pg8::Gemm g{bcur(ws, li), (const bf16*)(ws + WS_WEFF) + (size_t)li * 2048 * 1024, S, 2048, D}; pg8::StaticOrder So; So.init(S, 2048, (int)gridDim.x, (int)blockIdx.x);
    pg8::EpiF32 E{(float*)(ws + WS_QKV), 2048};
    pg8::gemm_phase<pg8::EpiF32, pg8::StaticOrder, PG8_ALIGN, PG8_SP2>(lds, g, So, E);
}
__device__ __forceinline__ void ph_peer(LAS unsigned char* lds, int li, bool dry = false) {
    const Ctx c = mkctx(); unsigned char* ws = WSP();
    const int lane = c.lane, gw = c.gw, NGW = c.NGW;
    const GAS float* SC = (const GAS float*)(ws + WS_QKV); GAS float* const F0 = (GAS float*)(ws + (dry ? WS_OG : WS_F0)); const GAS float* F1 = (const GAS float*)(ws + WS_F1); GAS bf16* const Bout = dry ? (GAS bf16*)(ws + WS_OG + 64 * MiB) : (GAS bf16*)bcur(ws, li);
    const GAS unsigned char* U8 = (const GAS unsigned char*)(ws + WS_U + (size_t)li * PEER_E * D); const GAS unsigned char* V8 = (const GAS unsigned char*)(ws + WS_V + (size_t)li * PEER_E * D);
    const GAS float* g2 = (const GAS float*)(INP(I_LN2G) + li * D); const GAS float* b2 = (const GAS float*)(INP(I_LN2B) + li * D);
    const int seg = lane >> 4, r = lane & 15;
#pragma unroll 1
    for (int t = gw; t < S; t += NGW) {
        const GAS float* scr = SC + (size_t)t * 2048;
        float tv[4]; int ti[4];
#pragma unroll
        for (int p = 0; p < 4; ++p) {
            const int Gp = 4 * p + seg;
            const GAS float* b = scr + Gp * 128 + r * 8;
            const f32x4 a0 = *(const GAS f32x4*)b, a1 = *(const GAS f32x4*)(b + 4);
            unsigned kk[8];
#pragma unroll
            for (int j = 0; j < 4; ++j) { kk[j] = (sortable(a0[j]) & ~127u) | (unsigned)(127 - (r * 8 + j)); kk[4 + j] = (sortable(a1[j]) & ~127u) | (unsigned)(127 - (r * 8 + 4 + j)); }
#define CE(i, j) { const unsigned hi_ = kk[i] > kk[j] ? kk[i] : kk[j], lo_ = kk[i] > kk[j] ? kk[j] : kk[i]; kk[i] = hi_; kk[j] = lo_; }
            CE(0, 1) CE(2, 3) CE(4, 5) CE(6, 7)  CE(0, 2) CE(1, 3) CE(4, 6) CE(5, 7)  CE(1, 2) CE(5, 6)  CE(0, 4) CE(1, 5) CE(2, 6) CE(3, 7)  CE(2, 4) CE(3, 5)  CE(1, 2) CE(3, 4) CE(5, 6)
#undef CE
            unsigned win = 0u;
#pragma unroll
            for (int rd = 0; rd < 16; ++rd) {
                const unsigned head = kk[0], wk = row_max_u32(head); const bool pop = head == wk;
#pragma unroll
                for (int j = 0; j < 7; ++j) kk[j] = pop ? kk[j + 1] : kk[j];
                kk[7] = pop ? 0u : kk[7];
                if (r == rd) win = wk;
            }
            const int idx = 127 - (int)(win & 127u);
            ti[p] = idx; tv[p] = scr[Gp * 128 + idx];
        }
        float gate[4]; int expert[4];
#pragma unroll
        for (int p = 0; p < 4; ++p) {
            const float v1 = tv[p]; const int i1 = ti[p];
            int pa = 0; float bestv = 0.f; int beste = 0;
            const int srcb = (seg | 1) << 4, myb = seg << 4;
#pragma unroll
            for (int rd = 0; rd < 16; ++rd) {
                const float v2 = __shfl(tv[p], srcb + pa); const int i2 = __shfl(ti[p], srcb + pa);
                const float cand = v1 + v2; const unsigned key = (sortable(cand) & ~15u) | (unsigned)(15 - r);
                const unsigned wk = row_max_u32(key); const int a = 15 - (int)(wk & 15u);
                const int eid = i1 * 128 + i2;
                const float bw = __shfl(cand, myb + a); const int ew = __shfl(eid, myb + a);
                if (r == rd) { bestv = bw; beste = ew; }
                if (r == a) ++pa;
            }
            const float mx = row_max_f32(bestv), e = __expf(bestv - mx), sm = row_sum_f32(e);
            gate[p] = e / sm; expert[p] = beste;
        }
        int E0, E1; float G0, G1;
        { const int s0 = lane & 15, s1 = 32 + (lane & 15), pp = lane >> 4;
          const int a0 = __shfl(expert[0], s0), a1 = __shfl(expert[1], s0), a2 = __shfl(expert[2], s0), a3 = __shfl(expert[3], s0);
          const int c0 = __shfl(expert[0], s1), c1 = __shfl(expert[1], s1), c2 = __shfl(expert[2], s1), c3 = __shfl(expert[3], s1);
          const float g0 = __shfl(gate[0], s0), g1 = __shfl(gate[1], s0), g2_ = __shfl(gate[2], s0), g3 = __shfl(gate[3], s0);
          const float d0 = __shfl(gate[0], s1), d1 = __shfl(gate[1], s1), d2 = __shfl(gate[2], s1), d3 = __shfl(gate[3], s1);
          E0 = pp == 0 ? a0 : (pp == 1 ? a1 : (pp == 2 ? a2 : a3)); E1 = pp == 0 ? c0 : (pp == 1 ? c1 : (pp == 2 ? c2 : c3));
          G0 = pp == 0 ? g0 : (pp == 1 ? g1 : (pp == 2 ? g2_ : g3)); G1 = pp == 0 ? d0 : (pp == 1 ? d1 : (pp == 2 ? d2 : d3)); }
        const GAS float* x1r = F1 + (size_t)t * D + lane * 16;
        f32x2 xv[8];
#pragma unroll
        for (int q = 0; q < 4; ++q) { const f32x4 v = *(const GAS f32x4*)(x1r + 4 * q); xv[2 * q] = (f32x2){v.x, v.y}; xv[2 * q + 1] = (f32x2){v.z, v.w}; }
#define PEER_LOADB(dst, TAB, EREG, LB) _Pragma("unroll") for (int j = 0; j < PNB; ++j) { const int e_ = __builtin_amdgcn_readlane(EREG, (LB) + j); dst[j] = *(const GAS v4u*)(TAB + ((size_t)e_ << 10) + lane * 16); }
#define PEER_DOTB(src, HREG, LB) _Pragma("unroll") for (int j = 0; j < PNB; ++j) { const v4u w = src[j]; f32x2 a2 = (f32x2){0.f, 0.f}; \
            _Pragma("unroll") for (int q = 0; q < 4; ++q) { const f32x2 lo = __builtin_amdgcn_cvt_pk_f32_fp8((int)w[q], false), hi = __builtin_amdgcn_cvt_pk_f32_fp8((int)w[q], true); \
                a2 = __builtin_elementwise_fma(lo, xv[2 * q], a2); a2 = __builtin_elementwise_fma(hi, xv[2 * q + 1], a2); } \
            float acc = a2.x + a2.y; acc = row_sum_f32(acc); acc += __shfl_xor(acc, 16); acc += __shfl_xor(acc, 32); if (lane == (LB) + j) HREG = acc; }
#define PEER_AXB(src, AREG, LB) _Pragma("unroll") for (int j = 0; j < PNB; ++j) { const v4u w = src[j]; const float a_ = __int_as_float(__builtin_amdgcn_readlane(__float_as_int(AREG), (LB) + j)); const f32x2 aa = (f32x2){a_, a_}; \
            _Pragma("unroll") for (int q = 0; q < 4; ++q) { const f32x2 lo = __builtin_amdgcn_cvt_pk_f32_fp8((int)w[q], false), hi = __builtin_amdgcn_cvt_pk_f32_fp8((int)w[q], true); \
                y2[2 * q] = __builtin_elementwise_fma(lo, aa, y2[2 * q]); y2[2 * q + 1] = __builtin_elementwise_fma(hi, aa, y2[2 * q + 1]); } }
        constexpr int PNB = 8;
        float H0 = 0.f, H1 = 0.f;
        {
            v4u bA[PNB], bB[PNB];
            PEER_LOADB(bA, U8, E0, 0)
#pragma unroll 1
            for (int k = 0; k < 64 / PNB; ++k) {
                const int LB = PNB * k;
                PEER_LOADB(bB, U8, E1, LB)
                PEER_DOTB(bA, H0, LB)
                if (k + 1 < 64 / PNB) { PEER_LOADB(bA, U8, E0, LB + PNB) }
                PEER_DOTB(bB, H1, LB)
            }
        }
        H0 *= (1.0f / 32.0f); H1 *= (1.0f / 32.0f);
        const float A0 = 0.5f * H0 * (1.0f + erff(H0 * 0.70710678118654752f)) * G0 * 0.125f;
        const float A1 = 0.5f * H1 * (1.0f + erff(H1 * 0.70710678118654752f)) * G1 * 0.125f;
        f32x2 y2[8];
#pragma unroll
        for (int q = 0; q < 8; ++q) y2[q] = (f32x2){0.f, 0.f};
        {
            v4u bA[PNB], bB[PNB];
            PEER_LOADB(bA, V8, E0, 0)
#pragma unroll 1
            for (int k = 0; k < 64 / PNB; ++k) {
                const int LB = PNB * k;
                PEER_LOADB(bB, V8, E1, LB)
                PEER_AXB(bA, A0, LB)
                if (k + 1 < 64 / PNB) { PEER_LOADB(bA, V8, E0, LB + PNB) }
                PEER_AXB(bB, A1, LB)
            }
        }
#undef PEER_LOADB
#undef PEER_DOTB
#undef PEER_AXB
        float z[16]; float s = 0.f;
#pragma unroll
        for (int q = 0; q < 8; ++q) { z[2 * q] = DN_ALPHA * xv[q].x + y2[q].x; z[2 * q + 1] = DN_ALPHA * xv[q].y + y2[q].y; s += z[2 * q] + z[2 * q + 1]; }
        const float mean = wave_sum(s) * (1.f / D); float s2 = 0.f;
#pragma unroll
        for (int q = 0; q < 16; ++q) { z[q] -= mean; s2 += z[q] * z[q]; }
        const float rstd = 1.f / sqrtf(wave_sum(s2) * (1.f / D) + LN_EPS);
        float ov[16];
#pragma unroll
        for (int q = 0; q < 4; ++q) { const int c0 = lane * 16 + q * 4; const f32x4 gg = *(const GAS f32x4*)(g2 + c0), bb2 = *(const GAS f32x4*)(b2 + c0); f32x4 ovv;
#pragma unroll
            for (int e = 0; e < 4; ++e) { ovv[e] = z[q * 4 + e] * rstd * gg[e] + bb2[e]; ov[q * 4 + e] = ovv[e]; }
            *(GAS f32x4*)(F0 + (size_t)t * D + c0) = ovv; }
#pragma unroll
        for (int hh = 0; hh < 2; ++hh) { v4u w; w.x = pk2(ov[hh * 8 + 0], ov[hh * 8 + 1]); w.y = pk2(ov[hh * 8 + 2], ov[hh * 8 + 3]); w.z = pk2(ov[hh * 8 + 4], ov[hh * 8 + 5]); w.w = pk2(ov[hh * 8 + 6], ov[hh * 8 + 7]);
            *(GAS v4u*)(Bout + (size_t)t * D + lane * 16 + hh * 8) = w; }
    }
}
__device__ __forceinline__ void ph_ple_pw(LAS unsigned char* lds, int li) {
    unsigned char* ws = WSP();
    pg8::Gemm g{(const bf16*)(ws + WS_P) + (size_t)li * S * 256, (const bf16*)(ws + WS_PLEW) + (size_t)li * 1024 * 256, S, D, 256}; pg8::StaticOrder So; So.init(S, D, (int)gridDim.x, (int)blockIdx.x);
    pg8::EpiF32 E{(float*)(ws + WS_F1), D};
    pg8::gemm_phase<pg8::EpiF32, pg8::StaticOrder, PG8_ALIGN, PG8_SP2>(lds, g, So, E);
}
__device__ __forceinline__ void ph_ple_gate(LAS unsigned char* lds, int li) {
    unsigned char* ws = WSP();
    float* const F0 = (float*)(ws + WS_F0);
    float* outp = li == DEPTH - 1 ? (float*)ldp(lds, I_OUT) : F0;
    pg8::Gemm g{bcur(ws, li), (const bf16*)(ws + WS_PLEG) + (size_t)li * 1024 * 1024, S, D, D}; pg8::StaticOrder So; So.init(S, D, (int)gridDim.x, (int)blockIdx.x);
    pg8::EpiPle E{F0, (const float*)(ws + WS_F1), INP(I_PLEGB) + li * D, outp, both(ws, li), D};
    pg8::gemm_phase<pg8::EpiPle, pg8::StaticOrder, PG8_ALIGN, PG8_SP2>(lds, g, So, E);
}

#define GRID_SYNC_CG() do { asm volatile("s_waitcnt vmcnt(0)" ::: "memory"); __syncthreads(); grid.sync(); __builtin_amdgcn_fence(__ATOMIC_ACQUIRE, "agent"); asm volatile("s_waitcnt vmcnt(0)" ::: "memory"); __syncthreads(); } while (0)
#define GRID_SYNC() do { XcdBarrier xb_; xb_.bar = (unsigned*)(WSP() + WS_CTL) + 4096; xb_.x = xb_xcc_id(); xb_.st = (volatile LAS unsigned*)(lds + XBST_OFF); xcd_barrier(xb_); } while (0)
__global__ void __launch_bounds__(NTHR, 2) fwd_kernel(Args args) {
    extern __shared__ __attribute__((aligned(16))) unsigned char lds_raw[];
    LAS unsigned char* lds = (LAS unsigned char*)lds_raw;
    cg::grid_group grid = cg::this_grid();
    if (threadIdx.x == 0) {
        LAS unsigned long long* t = (LAS unsigned long long*)(lds + PTAB_OFF);
        t[0] = (unsigned long long)args.in[0]; t[1] = (unsigned long long)args.in[1]; t[2] = (unsigned long long)args.in[2]; t[3] = (unsigned long long)args.in[3];
        t[4] = (unsigned long long)args.in[4]; t[5] = (unsigned long long)args.in[5]; t[6] = (unsigned long long)args.in[6]; t[7] = (unsigned long long)args.in[7];
        t[8] = (unsigned long long)args.in[8]; t[9] = (unsigned long long)args.in[9]; t[10] = (unsigned long long)args.in[10]; t[11] = (unsigned long long)args.in[11];
        t[12] = (unsigned long long)args.in[12]; t[13] = (unsigned long long)args.in[13]; t[14] = (unsigned long long)args.in[14]; t[15] = (unsigned long long)args.in[15];
        t[16] = (unsigned long long)args.in[16]; t[17] = (unsigned long long)args.in[17]; t[18] = (unsigned long long)args.in[18]; t[19] = (unsigned long long)args.in[19];
        t[20] = (unsigned long long)args.out; t[21] = (unsigned long long)args.ws;
    }
    if (threadIdx.x < 2) ((volatile LAS unsigned*)(lds + XBST_OFF))[threadIdx.x] = 0u;
    __syncthreads();
    (void)xcd_barrier_post((unsigned*)args.ws + 4096, (volatile LAS unsigned*)(lds + XBST_OFF));
#ifndef SKIP_PRO
    ph_prologue(lds);
#endif
    GRID_SYNC_CG();
#pragma unroll 1
    for (int li0 = 0; li0 < DEPTH; ++li0) {
        int li = li0;
        LAUNDER(li); ph_qkv(lds, li);
        GRID_SYNC();
#ifndef SKIP_ATT
        LAUNDER(li);
        const int kind = li % 3;
        if (kind == 0) {
#ifndef SKIP_A
            ph_attn_a(lds, li);
#endif
        } else if (kind == 1) {
#ifndef SKIP_B
            ph_attn_b(lds); GRID_SYNC(); ph_merge_b(lds);
#endif
        } else {
#ifndef SKIP_C
            ph_kmean(lds); GRID_SYNC(); ph_attn_c(lds);
#ifdef REP_C
            ph_attn_c(lds);
#endif
#endif
        }
#endif
        GRID_SYNC();
        LAUNDER(li); ph_oproj(lds, li);
        GRID_SYNC();
        LAUNDER(li); ph_ln1(lds, li);
        GRID_SYNC();
        LAUNDER(li); ph_sc(lds, li);
        GRID_SYNC();
#ifndef SKIP_PEER
#ifdef REP_PEER
        LAUNDER(li); ph_peer(lds, li, true);
#endif
        LAUNDER(li); ph_peer(lds, li);
#endif
        GRID_SYNC();
        LAUNDER(li); ph_ple_pw(lds, li);
        asm volatile("s_waitcnt vmcnt(0)" ::: "memory"); __syncthreads();
        LAUNDER(li); ph_ple_gate(lds, li);
        if (li0 + 1 < DEPTH) GRID_SYNC();
    }
}

extern "C" void kernel_launch(void* const* d_in, const int* in_sizes, int n_in, void* d_out, int out_size, void* d_ws, size_t ws_size, hipStream_t stream) {
    static int grid = 0;
    if (grid == 0) {
        if (n_in != 20 || out_size != S * D || ws_size < WS_END) { fprintf(stderr, "kernel_launch: unexpected shapes: n_in %d out %d ws %zu (need %zu)\n", n_in, out_size, ws_size, (size_t)WS_END); grid = -1; return; }
        int dev = 0, cus = 0, per_cu = 0;
        hipGetDevice(&dev); hipDeviceGetAttribute(&cus, hipDeviceAttributeMultiprocessorCount, dev);
        if (hipFuncSetAttribute((const void*)fwd_kernel, hipFuncAttributeMaxDynamicSharedMemorySize, LDS_BYTES) != hipSuccess) { fprintf(stderr, "kernel_launch: hipFuncSetAttribute failed\n"); grid = -1; return; }
        if (hipOccupancyMaxActiveBlocksPerMultiprocessor(&per_cu, (const void*)fwd_kernel, NTHR, LDS_BYTES) != hipSuccess || per_cu < 1) { fprintf(stderr, "kernel_launch: occupancy query says %d\n", per_cu); per_cu = 1; }
        (void)hipGetLastError();
        grid = cus;
        fprintf(stderr, "kernel_launch: grid %d (cus %d, per_cu %d)\n", grid, cus, per_cu);
    }
    if (grid < 0) return;
    if (hipMemsetAsync((char*)d_ws + WS_CTL, 0, 65536, stream) != hipSuccess) { fprintf(stderr, "kernel_launch: memset failed\n"); return; }
    Args a{};
    for (int i = 0; i < 20; ++i) a.in[i] = (const float*)d_in[i];
    a.out = (float*)d_out; a.ws = (unsigned char*)d_ws;
    void* kargs[] = {&a};
    const hipError_t e = hipLaunchCooperativeKernel((const void*)fwd_kernel, dim3(grid), dim3(NTHR), kargs, LDS_BYTES, stream);
    if (e != hipSuccess) fprintf(stderr, "kernel_launch: cooperative launch failed: %s (grid %d)\n", hipGetErrorString(e), grid);
}
```

```cpp
#include <hip/hip_runtime.h>
#include <hip/hip_cooperative_groups.h>
#include <cstdio>
#include <cstdint>
namespace cg = cooperative_groups;
namespace pg8 {
#define PG8_LAS __attribute__((address_space(3)))
typedef unsigned short bf16_t;
typedef short bf16x8 __attribute__((ext_vector_type(8)));
typedef float f32x4 __attribute__((ext_vector_type(4)));
typedef unsigned u32x4 __attribute__((ext_vector_type(4)));
constexpr int BM = 256, BK = 64, HALF = 128, HTB = HALF * BK * 2  , STAGE_BYTES = 8 * HTB, NXCD = 8, WGM = 8;

__host__ __device__ __forceinline__ int lds_byte(int r, int c) { const int st = (r >> 4) * 2 + (c >> 5), rr = r & 15, cc = c & 31, ob = rr * 64 + cc * 2; return st * 1024 + (ob ^ (((ob >> 9) & 1) << 5)); }
__host__ __device__ __forceinline__ void stage_rc(int b, int& R, int& C) { const int st = b / 1024, sb = b % 1024, swz = sb ^ (((sb >> 9) & 1) << 5); R = (st >> 1) * 16 + swz / 64; C = (st & 1) * 32 + (swz % 64) / 2; }
__host__ __device__ __forceinline__ int perm32(int rho) { const int n = rho >> 4, i = rho & 15; return 8 * (i >> 2) + 4 * n + (i & 3); }

struct Unit { int pm, pn; };
struct Gemm { const bf16_t* A; const bf16_t* Bt; int M, N, K; };

struct StaticOrder {
    int nM, nN, nwg, G, c;
    __host__ __device__ void init(int M, int N, int G_, int c_) { nM = M / BM; nN = N / BM; nwg = nM * nN; G = G_; c = c_; }
    __host__ __device__ bool next(int i, Unit& u) const {
        const long L = (long)i * G + c; if (L >= nwg) return false;
        int wgid = (int)L; { const int q = nwg / NXCD, r = nwg % NXCD, xcd = wgid % NXCD, off = wgid / NXCD; wgid = (xcd < r ? xcd * (q + 1) : r * (q + 1) + (xcd - r) * q) + off; }
        const int nig = WGM * nN, gid = wgid / nig, fm = gid * WGM, gsz = (nM - fm) < WGM ? (nM - fm) : WGM;
        u.pm = fm + ((wgid % nig) % gsz); u.pn = (wgid % nig) / gsz; return true;
    }
    __device__ __forceinline__ void a_ready(const Unit&) const {}
    __device__ __forceinline__ void done(const Unit&) const {}
};

__device__ __forceinline__ unsigned cvt_pk_bf16(float lo, float hi) { unsigned r; asm volatile("v_cvt_pk_bf16_f32 %0, %1, %2" : "=v"(r) : "v"(lo), "v"(hi)); return r; }
typedef float f32x2 __attribute__((ext_vector_type(2)));
__device__ __forceinline__ f32x2 gelu_pk(f32x2 v) {
    const f32x2 av = __builtin_elementwise_abs(v), d = av * 0.2316418882f + 1.0f;
    f32x2 t; t.x = __builtin_amdgcn_rcpf(d.x); t.y = __builtin_amdgcn_rcpf(d.y);
    f32x2 q = t * 0.5307027145f + (-0.7265760135f); q = q * t + 0.7107068705f; q = q * t + (-0.142248368f); q = q * t + 0.127414796f; q = q * t;
    const f32x2 s = (v * v) * (-0.72134752044f);
    f32x2 e; e.x = __builtin_amdgcn_exp2f(s.x); e.y = __builtin_amdgcn_exp2f(s.y);
    const f32x2 m = v * (q * e), r = v - m;
    f32x2 o; o.x = v.x < 0.f ? m.x : r.x; o.y = v.y < 0.f ? m.y : r.y; return o;
}

template <int ACT  > struct EpiBf16 {
    static constexpr bool PERM = true, AFTER_DRAIN = false; static_assert(ACT == 0 || ACT == 1, "EpiBf16: ACT is 0 (none) or 1 (gelu_pk)");
    bf16_t* O; int ldc; const float* bias; int split_cols; size_t split_stride; float scale0;
    __device__ __forceinline__ void operator()(const f32x4 (&acc)[2][2][4][2], const Unit& u, int wr, int wc, int fr, int fq) const {
        const int row0 = u.pm * BM + wr * 64 + fr; int colt = u.pn * BM; bf16_t* base = O;
        float sc = 1.f; if (split_cols) { const int t = colt / split_cols; base += (size_t)t * split_stride; colt -= t * split_cols; if (t == 0) sc = scale0; }
        const int col0 = colt + wc * 32 + 8 * fq, bcol0 = u.pn * BM + wc * 32 + 8 * fq;
        f32x4 bv[2][2];
#pragma unroll
        for (int bj = 0; bj < 2; ++bj)
#pragma unroll
            for (int n = 0; n < 2; ++n) bv[bj][n] = bias ? *(const f32x4*)(bias + bcol0 + bj * HALF + 4 * n) : (f32x4){0.f, 0.f, 0.f, 0.f};
#pragma unroll
        for (int ai = 0; ai < 2; ++ai)
#pragma unroll
            for (int m = 0; m < 4; ++m) { bf16_t* rowp = base + (size_t)(row0 + ai * HALF + m * 16) * ldc + col0;
#pragma unroll
                for (int bj = 0; bj < 2; ++bj) { f32x4 v0 = acc[ai][bj][m][0] + bv[bj][0], v1 = acc[ai][bj][m][1] + bv[bj][1];
                    if (ACT == 1) { f32x2 a = gelu_pk((f32x2){v0[0], v0[1]}), b = gelu_pk((f32x2){v0[2], v0[3]}), c = gelu_pk((f32x2){v1[0], v1[1]}), d = gelu_pk((f32x2){v1[2], v1[3]});
                        v0 = (f32x4){a.x, a.y, b.x, b.y}; v1 = (f32x4){c.x, c.y, d.x, d.y}; }
                    v0 = v0 * sc; v1 = v1 * sc; u32x4 w; w.x = cvt_pk_bf16(v0[0], v0[1]); w.y = cvt_pk_bf16(v0[2], v0[3]); w.z = cvt_pk_bf16(v1[0], v1[1]); w.w = cvt_pk_bf16(v1[2], v1[3]);
                    *(u32x4*)(rowp + bj * HALF) = w; } }
    }
};
typedef unsigned u32x2e __attribute__((ext_vector_type(2)));
struct EpiF32 {
    static constexpr bool PERM = false, AFTER_DRAIN = false;
    float* O; int ldc;
    __device__ __forceinline__ void operator()(const f32x4 (&acc)[2][2][4][2], const Unit& u, int wr, int wc, int fr, int fq) const {
        const int col0 = u.pn * BM + wc * 32 + 4 * fq;
#pragma unroll
        for (int ai = 0; ai < 2; ++ai)
#pragma unroll
            for (int m = 0; m < 4; ++m) { const size_t off = (size_t)(u.pm * BM + ai * HALF + wr * 64 + m * 16 + fr) * ldc + col0;
#pragma unroll
                for (int bj = 0; bj < 2; ++bj)
#pragma unroll
                    for (int n = 0; n < 2; ++n) *(f32x4*)(O + off + bj * HALF + n * 16) = acc[ai][bj][m][n]; }
    }
};
struct EpiResid {
    static constexpr bool PERM = false, AFTER_DRAIN = false;
    const float* X; float* Z; int ldc; float alpha;
    __device__ __forceinline__ void operator()(const f32x4 (&acc)[2][2][4][2], const Unit& u, int wr, int wc, int fr, int fq) const {
        const int col0 = u.pn * BM + wc * 32 + 4 * fq;
#pragma unroll
        for (int ai = 0; ai < 2; ++ai)
#pragma unroll
            for (int m = 0; m < 4; ++m) { const size_t off = (size_t)(u.pm * BM + ai * HALF + wr * 64 + m * 16 + fr) * ldc + col0;
#pragma unroll
                for (int bj = 0; bj < 2; ++bj)
#pragma unroll
                    for (int n = 0; n < 2; ++n) { const f32x4 xv = *(const f32x4*)(X + off + bj * HALF + n * 16); *(f32x4*)(Z + off + bj * HALF + n * 16) = xv * alpha + acc[ai][bj][m][n]; } }
    }
};
struct EpiPle {
    static constexpr bool PERM = false, AFTER_DRAIN = false;
    const float* X2; const float* PW; const float* bg; float* OUT; bf16_t* OUTB; int ldc;
    __device__ __forceinline__ void operator()(const f32x4 (&acc)[2][2][4][2], const Unit& u, int wr, int wc, int fr, int fq) const {
        const int col0 = u.pn * BM + wc * 32 + 4 * fq;
#pragma unroll
        for (int ai = 0; ai < 2; ++ai)
#pragma unroll
            for (int m = 0; m < 4; ++m) { const size_t off = (size_t)(u.pm * BM + ai * HALF + wr * 64 + m * 16 + fr) * ldc + col0;
#pragma unroll
                for (int bj = 0; bj < 2; ++bj)
#pragma unroll
                    for (int n = 0; n < 2; ++n) { const int co = bj * HALF + n * 16;
                        const f32x4 xv = *(const f32x4*)(X2 + off + co), pw = *(const f32x4*)(PW + off + co), bv = *(const f32x4*)(bg + col0 + co);
                        const f32x4 a = acc[ai][bj][m][n] + bv; f32x4 o;
#pragma unroll
                        for (int e = 0; e < 4; ++e) { const float sg = 1.0f / (1.0f + __expf(-a[e])); o[e] = xv[e] + sg * pw[e]; }
                        *(f32x4*)(OUT + off + co) = o;
                        u32x2e w; w.x = cvt_pk_bf16(o[0], o[1]); w.y = cvt_pk_bf16(o[2], o[3]); *(u32x2e*)(OUTB + off + co) = w; } }
    }
};
template <class Epi, class Sched, bool ALIGN_EPI = false, bool SP2 = false>
__device__ __forceinline__ void gemm_phase(PG8_LAS unsigned char* lds, const Gemm g, const Sched& S, const Epi& E) {
    int tid_ = threadIdx.x; asm volatile("" : "+v"(tid_));
    const int tid = tid_, wid = __builtin_amdgcn_readfirstlane(tid >> 6), lane = tid & 63, wr = wid >> 2, wc = wid & 3, fr = lane & 15, fq = lane >> 4;
    const int K = g.K, nt = K / BK;
    unsigned voffA[2], voffB[2];
#pragma unroll
    for (int i = 0; i < 2; ++i) { int R, C; stage_rc(tid * 16 + i * 8192, R, C); const int Rb = Epi::PERM ? ((R & ~31) + perm32(R & 31)) : R;
        voffA[i] = (unsigned)(R * K + C) * 2u; voffB[i] = (unsigned)(Rb * K + C) * 2u; }
    const size_t kstep = (size_t)(BK * 2);
    const size_t hstep = (size_t)HALF * K * 2;
    const size_t tstep = 2 * hstep;
    const unsigned ldsw = (unsigned)wid * 1024u;
    const int aoff = lds_byte(wr * 64 + fr, fq * 8), boff = lds_byte(wc * 32 + fr, fq * 8);
#define PG8_SA(b, h) (((b) * 2 + (h)) * HTB)
#define PG8_SB(b, h) ((4 + (b) * 2 + (h)) * HTB)
#define PG8_STAGE(bufoff, gbase, voff) do { _Pragma("unroll") for (int _i = 0; _i < 2; ++_i) \
        __builtin_amdgcn_global_load_lds((const unsigned*)((const char*)(gbase) + (voff)[_i]), (PG8_LAS unsigned*)(lds + (bufoff) + ldsw + _i * 8192), 16, 0, 0); } while (0)
#define PG8_LDA(dst, b, h) do { _Pragma("unroll") for (int m = 0; m < 4; ++m) _Pragma("unroll") for (int k = 0; k < 2; ++k) dst[m][k] = *(const PG8_LAS bf16x8*)(lds + PG8_SA(b, h) + aoff + m * 2048 + k * 1024); } while (0)
#define PG8_LDB(dst, b, h) do { _Pragma("unroll") for (int n = 0; n < 2; ++n) _Pragma("unroll") for (int k = 0; k < 2; ++k) dst[n][k] = *(const PG8_LAS bf16x8*)(lds + PG8_SB(b, h) + boff + n * 2048 + k * 1024); } while (0)
#define PG8_MMA(ai, bj, At, Bt) do { __builtin_amdgcn_s_setprio(1); _Pragma("unroll") for (int m = 0; m < 4; ++m) _Pragma("unroll") for (int n = 0; n < 2; ++n) _Pragma("unroll") for (int k = 0; k < 2; ++k) \
        acc[ai][bj][m][n] = __builtin_amdgcn_mfma_f32_16x16x32_bf16(Bt[n][k], At[m][k], acc[ai][bj][m][n], 0, 0, 0); __builtin_amdgcn_s_setprio(0); } while (0)
#define PG8_WAIT_V(n) asm volatile("s_waitcnt vmcnt(" #n ")" ::: "memory")
#define PG8_WAIT_L(n) asm volatile("s_waitcnt lgkmcnt(" #n ")" ::: "memory")
#define PG8_BAR __builtin_amdgcn_s_barrier()
#define PG8_SCHED __builtin_amdgcn_sched_barrier(0)
    Unit cur, nxt; int ui = 0;
    if (!S.next(0, cur)) return;
    f32x4 acc[2][2][4][2];
#pragma unroll
    for (int a = 0; a < 2; ++a)
#pragma unroll
        for (int b = 0; b < 2; ++b)
#pragma unroll
            for (int m = 0; m < 4; ++m)
#pragma unroll
                for (int n = 0; n < 2; ++n) acc[a][b][m][n] = (f32x4){0.f, 0.f, 0.f, 0.f};
    bf16x8 At[4][2], B0[2][2], B1[2][2];
    const char* cA = (const char*)g.A + (size_t)cur.pm * tstep; const char* cB = (const char*)g.Bt + (size_t)cur.pn * tstep;
    S.a_ready(cur);
    if constexpr (SP2) {
        PG8_STAGE(PG8_SB(0, 0), cB, voffB); PG8_STAGE(PG8_SB(0, 1), cB + hstep, voffB); PG8_STAGE(PG8_SA(0, 0), cA, voffA); PG8_STAGE(PG8_SA(0, 1), cA + hstep, voffA);
        if (wr == 1) PG8_BAR;
        PG8_WAIT_V(2); PG8_BAR;
        PG8_STAGE(PG8_SB(1, 0), cB + kstep, voffB); PG8_STAGE(PG8_SA(1, 0), cA + kstep, voffA); PG8_STAGE(PG8_SB(1, 1), cB + hstep + kstep, voffB);
        PG8_WAIT_V(6); PG8_BAR;
    } else {
        PG8_STAGE(PG8_SB(0, 0), cB, voffB); PG8_STAGE(PG8_SA(0, 0), cA, voffA); PG8_STAGE(PG8_SB(0, 1), cB + hstep, voffB); PG8_STAGE(PG8_SA(0, 1), cA + hstep, voffA);
        if (wr == 1) PG8_BAR;
        PG8_WAIT_V(4); PG8_BAR;
        PG8_STAGE(PG8_SB(1, 0), cB + kstep, voffB); PG8_STAGE(PG8_SA(1, 0), cA + kstep, voffA); PG8_STAGE(PG8_SB(1, 1), cB + hstep + kstep, voffB);
        PG8_WAIT_V(6); PG8_BAR;
    }
    for (;;) {
        const bool has_next = S.next(ui + 1, nxt);
        const char* nA = has_next ? (const char*)g.A + (size_t)nxt.pm * tstep : cA; const char* nB = has_next ? (const char*)g.Bt + (size_t)nxt.pn * tstep : cB;
        for (int t = 0; t < nt; t += 2) {
            const bool last = (t == nt - 2);
            const char* a1 = cA + (size_t)(t + 1) * kstep;
            const char* a2 = last ? nA : cA + (size_t)(t + 2) * kstep; const char* b2 = last ? nB : cB + (size_t)(t + 2) * kstep;
            const char* a3 = a2 + kstep; const char* b3 = b2 + kstep;
            if (last && has_next) S.a_ready(nxt);
            if constexpr (SP2) {
            PG8_LDB(B0, 0, 0); PG8_LDB(B1, 0, 1); PG8_SCHED; PG8_LDA(At, 0, 0); PG8_STAGE(PG8_SA(1, 1), a1 + hstep, voffA);
            PG8_WAIT_V(8); PG8_WAIT_L(0); PG8_BAR; PG8_MMA(0, 0, At, B0); PG8_MMA(0, 1, At, B1); PG8_BAR; PG8_SCHED;
            PG8_LDA(At, 0, 1); PG8_STAGE(PG8_SB(0, 0), b2, voffB); PG8_STAGE(PG8_SB(0, 1), b2 + hstep, voffB); PG8_STAGE(PG8_SA(0, 0), a2, voffA);
            PG8_WAIT_V(8); PG8_WAIT_L(0); PG8_BAR; PG8_MMA(1, 0, At, B0); PG8_MMA(1, 1, At, B1); PG8_BAR; PG8_SCHED;
            PG8_LDB(B0, 1, 0); PG8_LDB(B1, 1, 1); PG8_SCHED; PG8_LDA(At, 1, 0); PG8_STAGE(PG8_SA(0, 1), a2 + hstep, voffA);
            PG8_WAIT_V(8); PG8_WAIT_L(0); PG8_BAR; PG8_MMA(0, 0, At, B0); PG8_MMA(0, 1, At, B1); PG8_BAR; PG8_SCHED;
            PG8_LDA(At, 1, 1); PG8_STAGE(PG8_SB(1, 0), b3, voffB); PG8_STAGE(PG8_SB(1, 1), b3 + hstep, voffB); PG8_STAGE(PG8_SA(1, 0), a3, voffA);
            PG8_WAIT_V(8); PG8_WAIT_L(0); PG8_BAR; PG8_MMA(1, 0, At, B0); PG8_MMA(1, 1, At, B1); PG8_BAR; PG8_SCHED;
            } else {
            PG8_LDB(B0, 0, 0); PG8_SCHED; PG8_LDA(At, 0, 0); PG8_STAGE(PG8_SA(1, 1), a1 + hstep, voffA);
            PG8_WAIT_L(8); PG8_BAR; PG8_WAIT_L(0); PG8_MMA(0, 0, At, B0); PG8_BAR; PG8_SCHED;
            PG8_LDB(B1, 0, 1); PG8_STAGE(PG8_SB(0, 0), b2, voffB);
            PG8_BAR; PG8_WAIT_L(0); PG8_MMA(0, 1, At, B1); PG8_BAR;
            PG8_LDA(At, 0, 1); PG8_STAGE(PG8_SA(0, 0), a2, voffA);
            PG8_BAR; PG8_WAIT_L(0); PG8_MMA(1, 0, At, B0); PG8_BAR; PG8_SCHED;
            PG8_STAGE(PG8_SB(0, 1), b2 + hstep, voffB);
            PG8_WAIT_V(6); PG8_BAR; PG8_MMA(1, 1, At, B1); PG8_BAR;
            PG8_LDB(B0, 1, 0); PG8_SCHED; PG8_LDA(At, 1, 0); PG8_STAGE(PG8_SA(0, 1), a2 + hstep, voffA);
            PG8_WAIT_L(8); PG8_BAR; PG8_WAIT_L(0); PG8_MMA(0, 0, At, B0); PG8_BAR; PG8_SCHED;
            PG8_LDB(B1, 1, 1); PG8_STAGE(PG8_SB(1, 0), b3, voffB);
            PG8_BAR; PG8_WAIT_L(0); PG8_MMA(0, 1, At, B1); PG8_BAR;
            PG8_LDA(At, 1, 1); PG8_STAGE(PG8_SA(1, 0), a3, voffA);
            PG8_BAR; PG8_WAIT_L(0); PG8_MMA(1, 0, At, B0); PG8_BAR; PG8_SCHED;
            PG8_STAGE(PG8_SB(1, 1), b3 + hstep, voffB);
            PG8_WAIT_V(6); PG8_BAR; PG8_MMA(1, 1, At, B1); PG8_BAR;
            }
        }
        if constexpr (ALIGN_EPI) { if (wr == 0) PG8_BAR; }
        if constexpr (!Epi::AFTER_DRAIN) { E(acc, cur, wr, wc, fr, fq); S.done(cur); }
        if (!has_next) break;
#pragma unroll
        for (int a = 0; a < 2; ++a)
#pragma unroll
            for (int b = 0; b < 2; ++b)
#pragma unroll
                for (int m = 0; m < 4; ++m)
#pragma unroll
                    for (int n = 0; n < 2; ++n) acc[a][b][m][n] = (f32x4){0.f, 0.f, 0.f, 0.f};
        cur = nxt; cA = nA; cB = nB; ++ui;
        if constexpr (ALIGN_EPI) { if (wr == 1) PG8_BAR; }
    }
    PG8_WAIT_V(0);
    if constexpr (!ALIGN_EPI) { if (wr == 0) PG8_BAR; }
    PG8_BAR;
    if constexpr (Epi::AFTER_DRAIN) { E.fused(acc, cur, wr, wc, fr, fq, lds, wid, lane); S.done(cur); }
#undef PG8_SA
#undef PG8_SB
#undef PG8_STAGE
#undef PG8_LDA
#undef PG8_LDB
#undef PG8_MMA
#undef PG8_WAIT_V
#undef PG8_WAIT_L
#undef PG8_BAR
#undef PG8_SCHED
}
}
#ifndef PG8_SP2
#define PG8_SP2 true
#endif
#ifndef PG8_ALIGN
#define PG8_ALIGN true
#endif
constexpr int S = 16384, D = 1024, DEPTH = 4, NW = 8, NTHR = 512;
constexpr int PEER_E = 16384;
constexpr float LN_EPS = 1e-5f;
constexpr float DN_ALPHA = 1.681792830507429f;
constexpr float LOG2E = 1.4426950408889634f, LN2F = 0.6931471805599453f;
constexpr size_t MiB = 1u << 20;
constexpr size_t WS_CTL = 0;
constexpr size_t WS_WQKV_A = 1 * MiB;
constexpr size_t WS_WO_A = WS_WQKV_A + 5 * MiB;
constexpr size_t WS_WQKV_B = WS_WO_A + 4 * MiB;
constexpr size_t WS_WO_B = WS_WQKV_B + 10 * MiB;
constexpr size_t WS_WQKV_C = WS_WO_B + 2 * MiB;
constexpr size_t WS_WO_C = WS_WQKV_C + 6 * MiB;
constexpr size_t WS_WEFF = WS_WO_C + 2 * MiB;
constexpr size_t WS_PLEW = WS_WEFF + 16 * MiB;
constexpr size_t WS_PLEG = WS_PLEW + 2 * MiB;
constexpr size_t WS_KMEAN = WS_PLEG + 8 * MiB;
constexpr size_t WS_LSE = WS_KMEAN + 1 * MiB;
constexpr size_t WS_U = 64 * MiB;
constexpr size_t WS_V = WS_U + 128 * MiB;
constexpr size_t WS_P = WS_V + 128 * MiB;
constexpr size_t WS_F0 = WS_P + 32 * MiB;
constexpr size_t WS_F1 = WS_F0 + 64 * MiB;
constexpr size_t WS_B0 = WS_F1 + 64 * MiB;
constexpr size_t WS_B1 = WS_B0 + 32 * MiB;
constexpr size_t WS_QKV = WS_B1 + 32 * MiB;
constexpr size_t WS_O = WS_QKV + 160 * MiB;
constexpr size_t WS_OG = WS_O + 32 * MiB;
constexpr size_t WS_CLIST = WS_OG + 96 * MiB;
constexpr size_t WS_CPML = WS_CLIST + 64 * MiB;
constexpr size_t WS_END = WS_CPML + 8 * MiB;
constexpr size_t WS_CCNT = 32768;
static_assert(WS_LSE + 4 * MiB <= WS_U, "ws map");

constexpr int LDS_BYTES = 147456;

#define GAS __attribute__((address_space(1)))
#define LAS __attribute__((address_space(3)))
typedef unsigned short bf16;
typedef unsigned v4u __attribute__((ext_vector_type(4)));
typedef unsigned v2u __attribute__((ext_vector_type(2)));
typedef float f32x4 __attribute__((ext_vector_type(4)));
typedef short bf16x8 __attribute__((ext_vector_type(8)));
typedef float f32x2 __attribute__((ext_vector_type(2)));
typedef __bf16 bf2_t __attribute__((ext_vector_type(2)));

__device__ __forceinline__ unsigned f2bf(float f) { unsigned u = __builtin_bit_cast(unsigned, f); return (u + 0x7fffu + ((u >> 16) & 1u)) >> 16; }
__device__ __forceinline__ unsigned pk2(float lo, float hi) { return f2bf(lo) | (f2bf(hi) << 16); }
__device__ __forceinline__ float bflo(unsigned w) { return __uint_as_float(w << 16); }
__device__ __forceinline__ float bfhi(unsigned w) { return __uint_as_float(w & 0xffff0000u); }
__device__ __forceinline__ float wave_sum(float v) {
#pragma unroll
    for (int o = 1; o < 64; o <<= 1) v += __shfl_xor(v, o);
    return v;
}
#define DPPI(x, ctl) __builtin_amdgcn_update_dpp(0, (int)(x), (ctl), 0xF, 0xF, true)
__device__ __forceinline__ unsigned row_max_u32(unsigned x) {
    unsigned y;
    y = (unsigned)DPPI(x, 0xB1); x = x > y ? x : y;
    y = (unsigned)DPPI(x, 0x4E); x = x > y ? x : y;
    y = (unsigned)DPPI(x, 0x141); x = x > y ? x : y;
    y = (unsigned)DPPI(x, 0x140); x = x > y ? x : y;
    return x;
}
__device__ __forceinline__ float row_max_f32(float x) {
    x = fmaxf(x, __int_as_float(DPPI(__float_as_int(x), 0xB1)));
    x = fmaxf(x, __int_as_float(DPPI(__float_as_int(x), 0x4E)));
    x = fmaxf(x, __int_as_float(DPPI(__float_as_int(x), 0x141)));
    x = fmaxf(x, __int_as_float(DPPI(__float_as_int(x), 0x140)));
    return x;
}
__device__ __forceinline__ float row_sum_f32(float x) {
    x += __int_as_float(DPPI(__float_as_int(x), 0xB1));
    x += __int_as_float(DPPI(__float_as_int(x), 0x4E));
    x += __int_as_float(DPPI(__float_as_int(x), 0x141));
    x += __int_as_float(DPPI(__float_as_int(x), 0x140));
    return x;
}
__device__ __forceinline__ float dot16bf(v4u a0, v4u a1, v4u b0, v4u b1) {
    float acc = 0.f;
    asm volatile("s_nop 1\n\tv_dot2c_f32_bf16 %0, %1, %9\n\tv_dot2c_f32_bf16 %0, %2, %10\n\tv_dot2c_f32_bf16 %0, %3, %11\n\tv_dot2c_f32_bf16 %0, %4, %12\n\t"
                 "v_dot2c_f32_bf16 %0, %5, %13\n\tv_dot2c_f32_bf16 %0, %6, %14\n\tv_dot2c_f32_bf16 %0, %7, %15\n\tv_dot2c_f32_bf16 %0, %8, %16\n\ts_nop 2"
                 : "+v"(acc)
                 : "v"(a0.x), "v"(a0.y), "v"(a0.z), "v"(a0.w), "v"(a1.x), "v"(a1.y), "v"(a1.z), "v"(a1.w),
                   "v"(b0.x), "v"(b0.y), "v"(b0.z), "v"(b0.w), "v"(b1.x), "v"(b1.y), "v"(b1.z), "v"(b1.w));
    return acc;
}
__device__ __forceinline__ unsigned sortable(float f) { const unsigned u = __float_as_uint(f); return (u & 0x80000000u) ? ~u : (u | 0x80000000u); }

__device__ __forceinline__ void p0_transpose_item(const float* W, int K, int N, bf16* WT, LAS float* scr, int item, int lane) {
    const int nblk = N / 32, kb = item / nblk, nb = item % nblk, k0 = 64 * kb, n0 = 32 * nb;
#pragma unroll 8
    for (int i = 0; i < 32; ++i) { const int kk = 2 * i + (lane >> 5); scr[kk * 33 + (lane & 31)] = W[(size_t)(k0 + kk) * N + n0 + (lane & 31)]; }
    asm volatile("s_waitcnt lgkmcnt(0)" ::: "memory");
    const int c = lane & 7;
#pragma unroll
    for (int j = 0; j < 4; ++j) { const int n = (lane >> 3) + 8 * j; const LAS float* s = scr + (8 * c) * 33 + n;
        v4u o; o.x = pk2(s[0 * 33], s[1 * 33]); o.y = pk2(s[2 * 33], s[3 * 33]); o.z = pk2(s[4 * 33], s[5 * 33]); o.w = pk2(s[6 * 33], s[7 * 33]);
        *(v4u*)(WT + (size_t)(n0 + n) * K + k0 + 8 * c) = o; }
    asm volatile("s_waitcnt lgkmcnt(0)" ::: "memory");
}
__device__ __forceinline__ void p0_transpose(const float* W, int K, int N, bf16* WT, LAS float* scr, int gw, int NGW, int lane) {
    const int items = (K / 64) * (N / 32);
    for (int it = gw; it < items; it += NGW) p0_transpose_item(W, K, N, WT, scr, it, lane);
}
__device__ __forceinline__ void p0_convert(const float* src, bf16* dst, size_t n, size_t gtid, size_t nthr) {
    const size_t n8 = n / 8;
    for (size_t i = gtid; i < n8; i += nthr) {
        const f32x4 a = *(const f32x4*)(src + i * 8), b = *(const f32x4*)(src + i * 8 + 4);
        v4u o; o.x = pk2(a.x, a.y); o.y = pk2(a.z, a.w); o.z = pk2(b.x, b.y); o.w = pk2(b.z, b.w);
        *(v4u*)(dst + i * 8) = o;
    }
}
__device__ __forceinline__ void p0_convert8(const float* src, unsigned char* dst, size_t n, float scale, size_t gtid, size_t nthr) {
    const size_t n16 = n / 16;
    for (size_t i = gtid; i < n16; i += nthr) {
        v4u o;
#pragma unroll
        for (int q = 0; q < 4; ++q) { const f32x4 a = *(const f32x4*)(src + i * 16 + q * 4);
            int w = __builtin_amdgcn_cvt_pk_fp8_f32(a.x * scale, a.y * scale, 0, false); w = __builtin_amdgcn_cvt_pk_fp8_f32(a.z * scale, a.w * scale, w, true); o[q] = (unsigned)w; }
        *(v4u*)(dst + i * 16) = o;
    }
}
__device__ __forceinline__ void p0_weff(const float* wq, const float* subk, bf16* weff, LAS unsigned char* lds, int bid, int G, int tid) {
    LAS float* SK = (LAS float*)lds;
    LAS float* WQ = SK + 128 * 129;
    for (int unit = bid; unit < 256; unit += G) {
        const int i = unit >> 6, hc = (unit >> 2) & 15, kq = unit & 3, c = hc & 1;
        __syncthreads();
        const float* sk = subk + ((size_t)(i * 2 + c) * 128) * 128;
        for (int idx = tid; idx < 128 * 128; idx += NTHR) SK[(idx >> 7) * 129 + (idx & 127)] = sk[idx];
        const int k = tid & 127, kg = tid >> 7;
        for (int kt = 0; kt < 8; ++kt) {
            const int kk0 = kq * 256 + kt * 32;
            __syncthreads();
            for (int idx = tid; idx < 32 * 128; idx += NTHR) WQ[(idx >> 7) * 129 + (idx & 127)] = wq[((size_t)i * 1024 + kk0 + (idx >> 7)) * 2048 + hc * 128 + (idx & 127)];
            __syncthreads();
            float acc[8];
#pragma unroll
            for (int j = 0; j < 8; ++j) acc[j] = 0.f;
            for (int d = 0; d < 128; ++d) { const float a = SK[k * 129 + d];
#pragma unroll
                for (int j = 0; j < 8; ++j) acc[j] += a * WQ[(kg * 8 + j) * 129 + d]; }
            v4u o; o.x = pk2(acc[0], acc[1]); o.y = pk2(acc[2], acc[3]); o.z = pk2(acc[4], acc[5]); o.w = pk2(acc[6], acc[7]);
            *(v4u*)(weff + ((size_t)i * 2048 + hc * 128 + k) * 1024 + kk0 + kg * 8) = o;
        }
    }
    __syncthreads();
}

__device__ __forceinline__ void ln_row(const float* zrow, const float* g, const float* b, float* orow, bf16* obrow, int lane) {
    const f32x4* zr = (const f32x4*)zrow + lane;
    f32x4 v[4]; float s = 0.f;
#pragma unroll
    for (int j = 0; j < 4; ++j) { v[j] = zr[64 * j]; s += (v[j].x + v[j].y) + (v[j].z + v[j].w); }
    const float mean = wave_sum(s) * (1.f / D); float s2 = 0.f;
#pragma unroll
    for (int j = 0; j < 4; ++j) { v[j] = v[j] - mean; s2 += (v[j].x * v[j].x + v[j].y * v[j].y) + (v[j].z * v[j].z + v[j].w * v[j].w); }
    const float rstd = 1.f / sqrtf(wave_sum(s2) * (1.f / D) + LN_EPS);
#pragma unroll
    for (int j = 0; j < 4; ++j) { const f32x4 gg = ((const f32x4*)g + lane)[64 * j], bb = ((const f32x4*)b + lane)[64 * j];
        const f32x4 o = v[j] * rstd * gg + bb; ((f32x4*)orow + lane)[64 * j] = o;
        v2u w; w.x = pk2(o.x, o.y); w.y = pk2(o.z, o.w); ((v2u*)obrow + lane)[64 * j] = w; }
}

namespace att {
constexpr int KP = 144;
constexpr int VT_OFF = 64 * KP;
constexpr int MISC_OFF = 2 * 64 * KP;
struct Stage { v4u k, v; };
__device__ __forceinline__ Stage gload(const bf16* kb, const bf16* vb, int pitch, int tok0, int tstride, int jd0, int tid) {
    Stage s; const int row = tid >> 3, ch = tid & 7, key = tid & 63, vc = tid >> 6;
    s.k = *(const v4u*)(kb + (size_t)(tok0 + tstride * (jd0 + row)) * pitch + ch * 8);
    s.v = *(const v4u*)(vb + (size_t)(tok0 + tstride * (jd0 + key)) * pitch + vc * 8);
    return s;
}
__device__ __forceinline__ void lstore(LAS unsigned char* lds, const Stage& s, int tid) {
    const int row = tid >> 3, ch = tid & 7, key = tid & 63, vc = tid >> 6;
    *(LAS v4u*)(lds + row * KP + ch * 16) = s.k;
    LAS unsigned short* vt = (LAS unsigned short*)(lds + VT_OFF);
#pragma unroll
    for (int i = 0; i < 8; ++i) vt[(vc * 8 + i) * (KP / 2) + key] = (unsigned short)(s.v[i >> 1] >> ((i & 1) * 16));
}
__device__ __forceinline__ void qk(f32x4 (&s)[4], LAS const unsigned char* lds, const bf16x8 (&qf)[2], int fr, int g) {
#pragma unroll
    for (int mt = 0; mt < 4; ++mt) { s[mt] = (f32x4){0.f, 0.f, 0.f, 0.f};
#pragma unroll
        for (int ks = 0; ks < 2; ++ks) { const bf16x8 kf = *(const LAS bf16x8*)(lds + (mt * 16 + fr) * KP + (ks * 32 + 8 * g) * 2);
            s[mt] = __builtin_amdgcn_mfma_f32_16x16x32_bf16(kf, qf[ks], s[mt], 0, 0, 0); } }
}
typedef __bf16 bf16x2v __attribute__((ext_vector_type(2)));
__device__ __forceinline__ unsigned cvtpk(float lo, float hi) { const f32x2 v = {lo, hi}; return __builtin_bit_cast(unsigned, __builtin_convertvector(v, bf16x2v)); }
constexpr float M_INIT = -1e20f, M_MASK = -1e30f;
template <int VPITCH, bool FULL>
__device__ __forceinline__ void tile_compute_g(LAS const unsigned char* klds, LAS const unsigned char* vlds, const bf16x8 (&qf)[2], float& m, float& l, f32x4 (&o)[4], int dist0, bool lane_ok, int maxd, float sc2, float slope2, int fr, int g) {
    f32x4 s[4];
    qk(s, klds, qf, fr, g);
    float tmax = M_MASK;
    if (FULL) {
        const float base = lane_ok ? -slope2 * (float)dist0 : M_MASK;
#pragma unroll
        for (int mt = 0; mt < 4; ++mt)
#pragma unroll
            for (int r = 0; r < 4; ++r) { const float val = __builtin_fmaf(s[mt][r], sc2, __builtin_fmaf(slope2, (float)(mt * 16 + r), base)); s[mt][r] = val; tmax = fmaxf(tmax, val); }
    } else {
#pragma unroll
        for (int mt = 0; mt < 4; ++mt)
#pragma unroll
            for (int r = 0; r < 4; ++r) { const int d = dist0 - mt * 16 - r; const bool valid = lane_ok && d >= 0 && d <= maxd;
                const float val = valid ? (s[mt][r] * sc2 - slope2 * (float)d) : M_MASK; s[mt][r] = val; tmax = fmaxf(tmax, val); }
    }
    tmax = fmaxf(tmax, __shfl_xor(tmax, 16)); tmax = fmaxf(tmax, __shfl_xor(tmax, 32));
    const float mnew = fmaxf(m, tmax), alpha = __builtin_amdgcn_exp2f(m - mnew);
    float psum = 0.f;
#pragma unroll
    for (int mt = 0; mt < 4; ++mt)
#pragma unroll
        for (int r = 0; r < 4; ++r) { const float p = __builtin_amdgcn_exp2f(s[mt][r] - mnew); psum += p; s[mt][r] = p; }
    l = l * alpha + psum; m = mnew;
#pragma unroll
    for (int dt = 0; dt < 4; ++dt) o[dt] = o[dt] * alpha;
    bf16x8 pb[2];
#pragma unroll
    for (int kk = 0; kk < 2; ++kk) { v4u w; w.x = cvtpk(s[2 * kk][0], s[2 * kk][1]); w.y = cvtpk(s[2 * kk][2], s[2 * kk][3]); w.z = cvtpk(s[2 * kk + 1][0], s[2 * kk + 1][1]); w.w = cvtpk(s[2 * kk + 1][2], s[2 * kk + 1][3]);
        pb[kk] = __builtin_bit_cast(bf16x8, w); }
#pragma unroll
    for (int dt = 0; dt < 4; ++dt)
#pragma unroll
        for (int kk = 0; kk < 2; ++kk) { LAS const unsigned char* vp = vlds + (dt * 16 + fr) * VPITCH + (32 * kk + 4 * g) * 2;
            const v2u lo = *(const LAS v2u*)vp, hi = *(const LAS v2u*)(vp + 32);
            v4u w; w.x = lo.x; w.y = lo.y; w.z = hi.x; w.w = hi.y;
            o[dt] = __builtin_amdgcn_mfma_f32_16x16x32_bf16(__builtin_bit_cast(bf16x8, w), pb[kk], o[dt], 0, 0, 0); }
}
template <int VPITCH>
__device__ __forceinline__ void tile_compute_auto(LAS const unsigned char* klds, LAS const unsigned char* vlds, const bf16x8 (&qf)[2], float& m, float& l, f32x4 (&o)[4], int iq, int iq_lo, int jd0, bool lane_ok, int maxd, float sc2, float slope2, int fr, int g) {
    const bool full = (jd0 + 63 <= iq_lo) && (jd0 >= iq_lo + 15 - maxd);
    if (full) tile_compute_g<VPITCH, true>(klds, vlds, qf, m, l, o, iq - jd0 - 4 * g, lane_ok, maxd, sc2, slope2, fr, g);
    else tile_compute_g<VPITCH, false>(klds, vlds, qf, m, l, o, iq - jd0 - 4 * g, lane_ok, maxd, sc2, slope2, fr, g);
}
constexpr int VP4 = 528, VT4_OFF = 256 * KP, MISC4_OFF = VT4_OFF + 64 * VP4;
struct Stage4 { v4u k[4], v[4]; };
__device__ __forceinline__ void gload4(Stage4& s, const bf16* kb, const bf16* vb, int pitch, int tok0, int nsub, int tid) {
    const int row = tid >> 3, ch = tid & 7, key = tid & 63, vc = tid >> 6;
#pragma unroll
    for (int i = 0; i < 4; ++i) {
        s.k[i] = *(const GAS v4u*)(kb + (size_t)(tok0 + 64 * i + row) * pitch + ch * 8);
        s.v[i] = *(const GAS v4u*)(vb + (size_t)(tok0 + 64 * i + key) * pitch + vc * 8); }
}
__device__ __forceinline__ void lstore4(LAS unsigned char* lds, const Stage4& s, int nsub, int tid) {
    const int row = tid >> 3, ch = tid & 7, key = tid & 63, vc = tid >> 6;
    LAS unsigned short* vt = (LAS unsigned short*)(lds + VT4_OFF);
#pragma unroll
    for (int i = 0; i < 4; ++i) {
        *(LAS v4u*)(lds + (64 * i + row) * KP + ch * 16) = s.k[i];
#pragma unroll
        for (int e = 0; e < 8; ++e) vt[(vc * 8 + e) * (VP4 / 2) + 64 * i + key] = (unsigned short)(s.v[i][e >> 1] >> ((e & 1) * 16)); }
}
__device__ __forceinline__ void load_q(bf16x8 (&qf)[2], const bf16* qrow, int g) {
    qf[0] = *(const bf16x8*)(qrow + 8 * g); qf[1] = *(const bf16x8*)(qrow + 32 + 8 * g);
}
__device__ __forceinline__ void store_o(bf16* orow, const f32x4 (&o)[4], float scale, int g) {
#ifdef EXP_NOATT
    scale = 0.f;
#endif
#pragma unroll
    for (int dt = 0; dt < 4; ++dt) { v2u w; w.x = pk2(o[dt][0] * scale, o[dt][1] * scale); w.y = pk2(o[dt][2] * scale, o[dt][3] * scale); *(v2u*)(orow + dt * 16 + 4 * g) = w; }
}

__device__ __forceinline__ void banded_unit(LAS unsigned char* lds, const bf16* qb, const bf16* kb, const bf16* vb, int pitch, int tok0, int tstride, int idil0, int maxd, float slope2,
                                            float& m, float& l, f32x4 (&o)[4], int tid) {
    const int lane = tid & 63, w = tid >> 6, fr = lane & 15, g = lane >> 4;
    const int iq = idil0 + 16 * w + fr;
    bf16x8 qf[2]; load_q(qf, qb + (size_t)(tok0 + tstride * iq) * pitch, g);
    m = M_INIT; l = 0.f;
#pragma unroll
    for (int dt = 0; dt < 4; ++dt) o[dt] = (f32x4){0.f, 0.f, 0.f, 0.f};
    const int kt0 = idil0 >= 128 ? 0 : 2;
    Stage st = gload(kb, vb, pitch, tok0, tstride, idil0 - 128 + 64 * kt0, tid);
    for (int kt = kt0; kt < 4; ++kt) {
        const int jd0 = idil0 - 128 + 64 * kt;
        __syncthreads();
        lstore(lds, st, tid);
        __syncthreads();
        if (kt + 1 < 4) st = gload(kb, vb, pitch, tok0, tstride, jd0 + 64, tid);
        const bool poss = (jd0 <= iq) && (jd0 + 63 >= iq - maxd);
        if (__any(poss)) tile_compute_auto<KP>(lds, lds + VT_OFF, qf, m, l, o, iq, idil0 + 16 * w, jd0, true, maxd, 0.125f * LOG2E, slope2, fr, g);
    }
    l += __shfl_xor(l, 16); l += __shfl_xor(l, 32);
}
}

#define XB_TMO      128
#define XB_XCNT(j)  (256  + 64 * (j))
#define XB_XSUB(j)  (1280 + 64 * (j))
#define XB_XGEN(j)  (2304 + 64 * (j))
#define XB_TOP      3328
#define XB_TOPGEN   3392
#define XCD_BAR_WORDS 3456
#define XB_SPIN_CAP (1u << 18)

__device__ __forceinline__ unsigned xb_ld(unsigned* p)              { return __hip_atomic_load(p, __ATOMIC_RELAXED, __HIP_MEMORY_SCOPE_AGENT); }
__device__ __forceinline__ unsigned xb_add(unsigned* p, unsigned v) { return __hip_atomic_fetch_add(p, v, __ATOMIC_RELAXED, __HIP_MEMORY_SCOPE_AGENT); }
__device__ __forceinline__ unsigned xb_xcc_id() { return (unsigned)__builtin_amdgcn_s_getreg((3 << 11) | 20) & 0xFu; }
#define XB_SPIN(cond, bar) do { unsigned _sp = 0; while (cond) { __builtin_amdgcn_s_sleep(1); \
    if ((++_sp & 255u) == 0u) { if (xb_ld(&(bar)[XB_TMO])) break; if (_sp > XB_SPIN_CAP) { atomicAdd(&(bar)[XB_TMO], 1u); break; } } } } while (0)

struct XcdBarrier {
    unsigned* bar; unsigned x;
    volatile LAS unsigned* st;
};

__device__ __forceinline__ XcdBarrier xcd_barrier_post(unsigned* bar, volatile LAS unsigned* st) {
    XcdBarrier b; b.bar = bar; b.x = xb_xcc_id(); b.st = st;
    if (threadIdx.x == 0) (void)xb_add(&bar[XB_XCNT(b.x)], 1u);
    return b;
}
__device__ __forceinline__ void xcd_barrier_complete(unsigned* bar, unsigned x, unsigned& nloc, unsigned& nx) {
    const unsigned G = gridDim.x * gridDim.y * gridDim.z;
    unsigned sum, cnt, mine, sp = 0u;
    for (;;) {
        sum = 0u; cnt = 0u; mine = 0u;
#pragma unroll
        for (unsigned j = 0; j < 16; ++j) { const unsigned c = xb_ld(&bar[XB_XCNT(j)]); sum += c; cnt += (c > 0u) ? 1u : 0u; mine = (j == x) ? c : mine; }
        if (sum == G) break;
        __builtin_amdgcn_s_sleep(1);
        if ((++sp & 255u) == 0u) { if (xb_ld(&bar[XB_TMO])) break; if (sp > XB_SPIN_CAP) { atomicAdd(&bar[XB_TMO], 1u); break; } }
    }
    nloc = mine > 0u ? mine : 1u; nx = cnt > 0u ? cnt : 1u;
}

__device__ __forceinline__ void xcd_barrier(const XcdBarrier& b) {
    asm volatile("s_waitcnt vmcnt(0)" ::: "memory");
    __syncthreads();
    if (threadIdx.x == 0) {
        unsigned* bar = b.bar;
        __builtin_amdgcn_s_waitcnt(0);
        unsigned nloc = b.st[0], nx = b.st[1];
        if (nloc == 0u) { xcd_barrier_complete(bar, b.x, nloc, nx); b.st[0] = nloc; b.st[1] = nx; }
        const unsigned old = xb_add(&bar[XB_XSUB(b.x)], 1u);
        const unsigned gen = old / nloc;
        if (old + 1u == (gen + 1u) * nloc) {
            __builtin_amdgcn_fence(__ATOMIC_RELEASE, "agent");
            asm volatile("s_waitcnt vmcnt(0)" ::: "memory");
            const unsigned og = xb_add(&bar[XB_TOP], 1u);
            const unsigned tg = og / nx;
            if (og + 1u == (tg + 1u) * nx) xb_add(&bar[XB_TOPGEN], 1u);
            else XB_SPIN(xb_ld(&bar[XB_TOPGEN]) == tg, bar);
            __builtin_amdgcn_fence(__ATOMIC_ACQUIRE, "agent");
            xb_add(&bar[XB_XGEN(b.x)], 1u);
            asm volatile("s_waitcnt vmcnt(0)" ::: "memory");
        } else {
            XB_SPIN(xb_ld(&bar[XB_XGEN(b.x)]) == gen, bar);
            __builtin_amdgcn_fence(__ATOMIC_ACQUIRE, "agent");
            asm volatile("s_waitcnt vmcnt(0)" ::: "memory");
        }
    }
    __syncthreads();
}

struct Args { const float* in[20]; float* out; unsigned char* ws; };
enum { I_X = 0, I_P, I_AWQKV, I_ASINK, I_AWO, I_BWQKV, I_BWO, I_CWQKV, I_CWO, I_LN1G, I_LN1B, I_LN2G, I_LN2B, I_PWQ, I_PSUBK, I_PU, I_PV, I_PLEW, I_PLEGW, I_PLEGB, I_OUT, I_WS };
constexpr int PTAB_OFF = 131072 + 1024, XBST_OFF = 131072 + 2048;
__device__ __forceinline__ unsigned long long ldp(LAS unsigned char* lds, int i) {
    volatile LAS unsigned* t = (volatile LAS unsigned*)(lds + PTAB_OFF);
    const unsigned lo = __builtin_amdgcn_readfirstlane(t[2 * i]), hi = __builtin_amdgcn_readfirstlane(t[2 * i + 1]);
    return ((unsigned long long)hi << 32) | lo;
}
#define INP(i) ((const float*)ldp(lds, (i)))
#define WSP() ((unsigned char*)ldp(lds, I_WS))
#define LAUNDER(v) asm volatile("" : "+s"(v))
struct Ctx { int tid, lane, wave, G, bid, gw, NGW; };
__device__ __forceinline__ Ctx mkctx() { Ctx c; int t_ = threadIdx.x; asm volatile("" : "+v"(t_)); c.tid = t_; c.lane = c.tid & 63; c.wave = __builtin_amdgcn_readfirstlane(c.tid >> 6); c.G = gridDim.x; c.bid = blockIdx.x; c.gw = c.bid * NW + c.wave; c.NGW = c.G * NW; return c; }

__device__ __forceinline__ void ph_prologue(LAS unsigned char* lds) {
    const Ctx c = mkctx(); unsigned char* ws = WSP();
    const size_t gtid = (size_t)c.bid * NTHR + c.tid, nthr = (size_t)c.G * NTHR;
    LAS float* scr = (LAS float*)(lds + c.wave * 16384);
    for (int j = 0; j < 2; ++j) {
        p0_transpose(INP(I_AWQKV) + (size_t)j * 1024 * 1280, 1024, 1280, (bf16*)(ws + WS_WQKV_A) + (size_t)j * 1280 * 1024, scr, c.gw, c.NGW, c.lane);
        p0_transpose(INP(I_AWO) + (size_t)j * 1024 * 1024, 1024, 1024, (bf16*)(ws + WS_WO_A) + (size_t)j * 1024 * 1024, scr, c.gw, c.NGW, c.lane);
    }
    p0_transpose(INP(I_BWQKV), 1024, 5120, (bf16*)(ws + WS_WQKV_B), scr, c.gw, c.NGW, c.lane);
    p0_transpose(INP(I_BWO), 1024, 1024, (bf16*)(ws + WS_WO_B), scr, c.gw, c.NGW, c.lane);
    p0_transpose(INP(I_CWQKV), 1024, 3072, (bf16*)(ws + WS_WQKV_C), scr, c.gw, c.NGW, c.lane);
    p0_transpose(INP(I_CWO), 1024, 1024, (bf16*)(ws + WS_WO_C), scr, c.gw, c.NGW, c.lane);
    for (int i = 0; i < DEPTH; ++i) {
        p0_transpose(INP(I_PLEW) + (size_t)i * 256 * 1024, 256, 1024, (bf16*)(ws + WS_PLEW) + (size_t)i * 1024 * 256, scr, c.gw, c.NGW, c.lane);
        p0_transpose(INP(I_PLEGW) + (size_t)i * 1024 * 1024, 1024, 1024, (bf16*)(ws + WS_PLEG) + (size_t)i * 1024 * 1024, scr, c.gw, c.NGW, c.lane);
    }
    p0_convert(INP(I_X), (bf16*)(ws + WS_B0), (size_t)S * D, gtid, nthr);
    p0_convert(INP(I_P), (bf16*)(ws + WS_P), (size_t)DEPTH * S * 256, gtid, nthr);
    p0_convert8(INP(I_PU), ws + WS_U, (size_t)DEPTH * PEER_E * D, 32.0f, gtid, nthr);
    p0_convert8(INP(I_PV), ws + WS_V, (size_t)DEPTH * PEER_E * D, 8.0f, gtid, nthr);
    p0_weff(INP(I_PWQ), INP(I_PSUBK), (bf16*)(ws + WS_WEFF), lds, c.bid, c.G, c.tid);
}
__device__ __forceinline__ bf16* bcur(unsigned char* ws, int li) { return (bf16*)(ws + ((li & 1) ? WS_B1 : WS_B0)); }
__device__ __forceinline__ bf16* both(unsigned char* ws, int li) { return (bf16*)(ws + ((li & 1) ? WS_B0 : WS_B1)); }

__device__ __forceinline__ void ph_qkv(LAS unsigned char* lds, int li) {
    unsigned char* ws = WSP(); const int kind = li % 3, lj = li / 3;
    const int NQKV = kind == 0 ? 1280 : (kind == 1 ? 5120 : 3072);
    const bf16* wqkv = kind == 0 ? (const bf16*)(ws + WS_WQKV_A) + (size_t)lj * 1280 * 1024 : (kind == 1 ? (const bf16*)(ws + WS_WQKV_B) : (const bf16*)(ws + WS_WQKV_C));
    pg8::Gemm g{bcur(ws, li), wqkv, S, NQKV, D}; pg8::StaticOrder So; So.init(S, NQKV, (int)gridDim.x, (int)blockIdx.x);
    pg8::EpiBf16<0> E{(bf16*)(ws + WS_QKV), NQKV, nullptr, 0, 0, 1.f};
    pg8::gemm_phase<pg8::EpiBf16<0>, pg8::StaticOrder, PG8_ALIGN, PG8_SP2>(lds, g, So, E);
}
__device__ __forceinline__ void ph_attn_a(LAS unsigned char* lds, int li) {
    const Ctx c = mkctx(); unsigned char* ws = WSP(); const int lj = li / 3;
    bf16* const QKV = (bf16*)(ws + WS_QKV); bf16* const Ob = (bf16*)(ws + WS_O);
    const float* sinks = INP(I_ASINK) + lj * 16;
    for (int u = c.bid; u < 16 * 128; u += c.G) {
        const int h = u >> 7, qb = u & 127, kvh = h >> 3;
        const float slope = exp2f(-0.5f * (float)(h + 1));
        float m, l; f32x4 o[4];
        att::banded_unit(lds, QKV + h * 64, QKV + 1024 + kvh * 64, QKV + 1152 + kvh * 64, 1280, 0, 1, qb * 128, 127, slope * LOG2E, m, l, o, c.tid);
        const float sk2 = sinks[h] * LOG2E, mf = fmaxf(m, sk2), lf = l * exp2f(m - mf) + exp2f(sk2 - mf);
        const int tok = qb * 128 + 16 * (c.tid >> 6) + (c.lane & 15);
        att::store_o(Ob + (size_t)tok * 1024 + h * 64, o, exp2f(m - mf) / lf, c.lane >> 4);
    }
}
__device__ __forceinline__ void ph_attn_b(LAS unsigned char* lds) {
    const Ctx c = mkctx(); unsigned char* ws = WSP();
    bf16* const QKV = (bf16*)(ws + WS_QKV); bf16* const OG = (bf16*)(ws + WS_OG); float* const LSE = (float*)(ws + WS_LSE);
    for (int u = c.bid; u < 3 * 16 * 128; u += c.G) {
        const int gi = u >> 11, h = (u >> 7) & 15, uu = u & 127;
        const int r = gi == 0 ? 1 : (gi == 1 ? 4 : 16);
        const int cc = uu % r, b = uu / r;
        const float slope = exp2f(-0.5f * (float)(h + 1));
        float m, l; f32x4 o[4];
        att::banded_unit(lds, QKV + gi * 1024 + h * 64, QKV + 3072 + h * 64, QKV + 4096 + h * 64, 5120, cc, r, b * 128, 128, slope * (float)r * LOG2E, m, l, o, c.tid);
        const int tok = cc + r * (b * 128 + 16 * (c.tid >> 6) + (c.lane & 15));
        att::store_o(OG + ((size_t)gi * S + tok) * 1024 + h * 64, o, 1.0f / l, c.lane >> 4);
        if ((c.lane >> 4) == 0) LSE[((size_t)gi * S + tok) * 16 + h] = (m + log2f(l)) * LN2F;
    }
}
__device__ __forceinline__ void ph_merge_b(LAS unsigned char* lds) {
    const Ctx c = mkctx(); unsigned char* ws = WSP();
    const bf16* OG = (const bf16*)(ws + WS_OG); const float* LSE = (const float*)(ws + WS_LSE); bf16* const Ob = (bf16*)(ws + WS_O);
    const size_t gtid = (size_t)c.bid * NTHR + c.tid, nthr = (size_t)c.G * NTHR;
    for (size_t idx = gtid; idx < (size_t)S * 16 * 8; idx += nthr) {
        const int t = (int)(idx >> 7), h = (int)(idx >> 3) & 15, cch = (int)idx & 7;
        const float l0 = LSE[((size_t)0 * S + t) * 16 + h], l1 = LSE[((size_t)1 * S + t) * 16 + h], l2 = LSE[((size_t)2 * S + t) * 16 + h];
        const float mx = fmaxf(l0, fmaxf(l1, l2)); float w0 = __expf(l0 - mx), w1 = __expf(l1 - mx), w2 = __expf(l2 - mx); const float inv = 1.0f / (w0 + w1 + w2);
        w0 *= inv; w1 *= inv; w2 *= inv;
        const size_t off = (size_t)t * 1024 + h * 64 + cch * 8;
        const v4u a = *(const v4u*)(OG + off), bq = *(const v4u*)(OG + (size_t)S * 1024 + off), cq = *(const v4u*)(OG + (size_t)2 * S * 1024 + off);
        v4u o;
#pragma unroll
        for (int e = 0; e < 4; ++e) o[e] = pk2(w0 * bflo(a[e]) + w1 * bflo(bq[e]) + w2 * bflo(cq[e]), w0 * bfhi(a[e]) + w1 * bfhi(bq[e]) + w2 * bfhi(cq[e]));
        *(v4u*)(Ob + off) = o;
    }
}
__device__ __forceinline__ void ph_kmean(LAS unsigned char* lds) {
    const Ctx c = mkctx(); unsigned char* ws = WSP();
    const bf16* QKV = (const bf16*)(ws + WS_QKV); bf16* const KMEAN = (bf16*)(ws + WS_KMEAN);
    const size_t gtid = (size_t)c.bid * NTHR + c.tid, nthr = (size_t)c.G * NTHR;
    for (size_t idx = gtid; idx < 64 * 512; idx += nthr) {
        const int blk = (int)(idx >> 9), cp = (int)idx & 511;
        const bf16* kp = QKV + (size_t)blk * 256 * 3072 + 1024 + cp * 2;
        float s0 = 0.f, s1 = 0.f;
        for (int r = 0; r < 256; ++r) { const unsigned w = *(const unsigned*)(kp + (size_t)r * 3072); s0 += bflo(w); s1 += bfhi(w); }
        *(unsigned*)(KMEAN + blk * 1024 + cp * 2) = pk2(s0 * (1.f / 256.f), s1 * (1.f / 256.f));
    }
}
__device__ __forceinline__ void ph_attn_c(LAS unsigned char* lds) {
    const Ctx c = mkctx(); unsigned char* ws = WSP();
    const bf16* QKV = (const bf16*)(ws + WS_QKV); const bf16* KMEAN = (const bf16*)(ws + WS_KMEAN); bf16* const Ob = (bf16*)(ws + WS_O);
    const int tid = c.tid, lane = c.lane, G = c.G, bid = c.bid;
    const int rounds = (2048 + G - 1) / G;
    for (int rd = 0; rd < rounds; ++rd) {
        const int L = rd * G + ((rd & 1) ? (G - 1 - bid) : bid);
        if (L >= 2048) continue;
        const int qt = 127 - (L >> 4), h = L & 15, qblk = qt >> 1, t0 = qt * 128;
        const int w = tid >> 6, fr = lane & 15, g = lane >> 4;
        const int iq = t0 + 16 * w + fr;
        const bf16* qb = QKV + h * 64; const bf16* kb = QKV + 1024 + h * 64; const bf16* vb = QKV + 2048 + h * 64;
        const float slope2 = exp2f(-0.5f * (float)(h + 1)) * LOG2E;
        bf16x8 qf[2]; att::load_q(qf, qb + (size_t)iq * 3072, g);
        unsigned long long selmask = 0ull, bunion = 0ull;
        if (qblk > 0) {
            __syncthreads();
            { const int row = tid >> 3, ch = tid & 7; *(LAS v4u*)(lds + row * att::KP + ch * 16) = *(const v4u*)(KMEAN + row * 1024 + h * 64 + ch * 8); }
            __syncthreads();
            f32x4 s[4]; att::qk(s, lds, qf, fr, g);
            const int nsel = qblk < 3 ? qblk : 3;
            for (int sr = 0; sr < nsel; ++sr) {
                float best = -INFINITY; int bi = 64;
#pragma unroll
                for (int mt = 0; mt < 4; ++mt)
#pragma unroll
                    for (int r = 0; r < 4; ++r) { const int n = mt * 16 + 4 * g + r; const bool ok = n < qblk && !((selmask >> n) & 1ull);
                        if (ok && (s[mt][r] > best || bi == 64)) { best = s[mt][r]; bi = n; } }
#pragma unroll
                for (int x = 16; x <= 32; x <<= 1) { const float ob = __shfl_xor(best, x); const int oi = __shfl_xor(bi, x);
                    if (oi < 64 && (bi == 64 || ob > best || (ob == best && oi < bi))) { best = ob; bi = oi; } }
                selmask |= 1ull << bi;
            }
            unsigned lo = (unsigned)selmask, hi = (unsigned)(selmask >> 32);
#pragma unroll
            for (int x = 1; x < 16; x <<= 1) { lo |= __shfl_xor(lo, x); hi |= __shfl_xor(hi, x); }
            LAS unsigned* wun = (LAS unsigned*)(lds + att::MISC4_OFF);
            if (lane == 0) { wun[2 * w] = lo; wun[2 * w + 1] = hi; }
            __syncthreads();
            unsigned ul = 0, uh = 0;
#pragma unroll
            for (int x = 0; x < 8; ++x) { ul |= wun[2 * x]; uh |= wun[2 * x + 1]; }
            bunion = ((unsigned long long)uh << 32) | ul;
        }
        float m = att::M_INIT, l = 0.f; f32x4 o[4];
#pragma unroll
        for (int dt = 0; dt < 4; ++dt) o[dt] = (f32x4){0.f, 0.f, 0.f, 0.f};
        const int nown = (t0 + 128 - qblk * 256) / 64;
        unsigned long long todo = bunion;
        int kbcur = todo ? (__ffsll((long long)todo) - 1) : qblk;
        if (todo) todo &= todo - 1;
        att::Stage4 st; att::gload4(st, (const bf16*)kb, (const bf16*)vb, 3072, kbcur * 256, kbcur == qblk ? nown : 4, tid);
        for (;;) {
            const bool own = kbcur == qblk; const int nsub = own ? nown : 4;
            int nkb = qblk; bool more = !own;
            if (!own && todo) { nkb = __ffsll((long long)todo) - 1; todo &= todo - 1; }
            __syncthreads();
            att::lstore4(lds, st, nsub, tid);
            __syncthreads();
            if (more) att::gload4(st, (const bf16*)kb, (const bf16*)vb, 3072, nkb * 256, nkb == qblk ? nown : 4, tid);
            const bool sel_ok = own || (((selmask >> kbcur) & 1ull) != 0ull);
            if (__any(sel_ok)) {
#pragma unroll 1
                for (int sub = 0; sub < nsub; ++sub) { const int jd0 = kbcur * 256 + sub * 64; const bool lane_ok = sel_ok && (jd0 <= iq);
                    if (__any(lane_ok)) att::tile_compute_auto<att::VP4>(lds + sub * 64 * att::KP, lds + att::VT4_OFF + sub * 128, qf, m, l, o, iq, t0 + 16 * w, jd0, lane_ok, 0x3fffffff, 0.125f * LOG2E, slope2, fr, g); }
            }
            if (!more) break;
            kbcur = nkb;
        }
        l += __shfl_xor(l, 16); l += __shfl_xor(l, 32);
        att::store_o(Ob + (size_t)iq * 1024 + h * 64, o, 1.0f / l, g);
    }
}
__device__ __forceinline__ void ph_gate_c(LAS unsigned char* lds) {
    const Ctx c = mkctx(); unsigned char* ws = WSP();
    const bf16* QKV = (const bf16*)(ws + WS_QKV); const bf16* KMEAN = (const bf16*)(ws + WS_KMEAN);
    int* const cnt = (int*)(ws + WS_CCNT); unsigned* const list = (unsigned*)(ws + WS_CLIST);
    const int tid = c.tid, lane = c.lane, w = tid >> 6, fr = lane & 15, g = lane >> 4;
    for (int u = c.bid; u < 16 * 128; u += c.G) {
        const int qt = u >> 4, h = u & 15, qblk = qt >> 1;
        if (qblk == 0) continue;
        const int iq = qt * 128 + 16 * w + fr;
        bf16x8 qf[2]; att::load_q(qf, QKV + h * 64 + (size_t)iq * 3072, g);
        __syncthreads();
        { const int row = tid >> 3, ch = tid & 7; *(LAS v4u*)(lds + row * att::KP + ch * 16) = *(const v4u*)(KMEAN + row * 1024 + h * 64 + ch * 8); }
        __syncthreads();
        f32x4 s[4]; att::qk(s, lds, qf, fr, g);
        const int nsel = qblk < 3 ? qblk : 3;
        unsigned long long selmask = 0ull;
        for (int sr = 0; sr < nsel; ++sr) {
            float best = -INFINITY; int bi = 64;
#pragma unroll
            for (int mt = 0; mt < 4; ++mt)
#pragma unroll
                for (int r = 0; r < 4; ++r) { const int n = mt * 16 + 4 * g + r; const bool ok = n < qblk && !((selmask >> n) & 1ull);
                    if (ok && (s[mt][r] > best || bi == 64)) { best = s[mt][r]; bi = n; } }
#pragma unroll
            for (int x = 16; x <= 32; x <<= 1) { const float ob = __shfl_xor(best, x); const int oi = __shfl_xor(bi, x);
                if (oi < 64 && (bi == 64 || ob > best || (ob == best && oi < bi))) { best = ob; bi = oi; } }
            selmask |= 1ull << bi;
            if (g == 0) { const int pos = atomicAdd(cnt + h * 64 + bi, 1); list[(size_t)(h * 64 + bi) * 16384 + pos] = (unsigned)iq | ((unsigned)sr << 14); }
        }
    }
}
__device__ __forceinline__ void ph_bucket_c(LAS unsigned char* lds) {
    const Ctx c = mkctx(); unsigned char* ws = WSP();
    const bf16* QKV = (const bf16*)(ws + WS_QKV);
    const int* cnt = (const int*)(ws + WS_CCNT); const unsigned* list = (const unsigned*)(ws + WS_CLIST);
    bf16* const PO = (bf16*)(ws + WS_OG); f32x2* const PML = (f32x2*)(ws + WS_CPML);
    const int tid = c.tid, lane = c.lane, w = tid >> 6, fr = lane & 15, g = lane >> 4;
    LAS int* cl = (LAS int*)(lds + 81920);
    __syncthreads();
    for (int i = tid; i < 1024; i += NTHR) cl[i] = cnt[i];
    __syncthreads();
    int uc = 0, next = c.bid;
    for (int lst = 0; lst < 1024; ++lst) {
        const int cn = cl[lst], nch = (cn + 127) >> 7;
        if (uc + nch <= next) { uc += nch; continue; }
        for (int ch = 0; ch < nch; ++ch, ++uc) {
            if (uc != next) continue;
            next += c.G;
            const int h = lst >> 6, kb = lst & 63;
            const int e = ch * 128 + 16 * w + fr; const bool valid = e < cn;
            const unsigned entry = list[(size_t)lst * 16384 + (valid ? e : 0)];
            const int qid = (int)(entry & 16383u), slot = (int)(entry >> 14);
            bf16x8 qf[2]; att::load_q(qf, QKV + h * 64 + (size_t)qid * 3072, g);
            att::Stage4 st; att::gload4(st, QKV + 1024 + h * 64, QKV + 2048 + h * 64, 3072, kb * 256, 4, tid);
            __syncthreads();
            att::lstore4(lds, st, 4, tid);
            __syncthreads();
            const float slope2 = exp2f(-0.5f * (float)(h + 1)) * LOG2E;
            float m = att::M_INIT, l = 0.f; f32x4 o[4];
#pragma unroll
            for (int dt = 0; dt < 4; ++dt) o[dt] = (f32x4){0.f, 0.f, 0.f, 0.f};
#pragma unroll 1
            for (int sub = 0; sub < 4; ++sub) { const int jd0 = kb * 256 + sub * 64;
                att::tile_compute_g<att::VP4, true>(lds + sub * 64 * att::KP, lds + att::VT4_OFF + sub * 128, qf, m, l, o, qid - jd0 - 4 * g, true, 0, 0.125f * LOG2E, slope2, fr, g); }
            l += __shfl_xor(l, 16); l += __shfl_xor(l, 32);
            if (valid) { const size_t pi = ((size_t)h * 16384 + qid) * 3 + slot;
                att::store_o(PO + pi * 64, o, 1.0f, g);
                if (g == 0) PML[pi] = (f32x2){m, l}; }
        }
    }
}
__device__ __forceinline__ void ph_own_c(LAS unsigned char* lds) {
    const Ctx c = mkctx(); unsigned char* ws = WSP();
    const bf16* QKV = (const bf16*)(ws + WS_QKV); bf16* const Ob = (bf16*)(ws + WS_O);
    const bf16* PO = (const bf16*)(ws + WS_OG); const f32x2* PML = (const f32x2*)(ws + WS_CPML);
    const int tid = c.tid, lane = c.lane, w = tid >> 6, fr = lane & 15, g = lane >> 4;
    for (int u = c.bid; u < 16 * 128; u += c.G) {
        const int qt = u >> 4, h = u & 15, qblk = qt >> 1, t0 = qt * 128;
        const int iq = t0 + 16 * w + fr;
        const float slope2 = exp2f(-0.5f * (float)(h + 1)) * LOG2E;
        bf16x8 qf[2]; att::load_q(qf, QKV + h * 64 + (size_t)iq * 3072, g);
        const int nown = (t0 + 128 - qblk * 256) / 64;
        att::Stage4 st; att::gload4(st, QKV + 1024 + h * 64, QKV + 2048 + h * 64, 3072, qblk * 256, nown, tid);
        __syncthreads();
        att::lstore4(lds, st, nown, tid);
        __syncthreads();
        float m = att::M_INIT, l = 0.f; f32x4 o[4];
#pragma unroll
        for (int dt = 0; dt < 4; ++dt) o[dt] = (f32x4){0.f, 0.f, 0.f, 0.f};
#pragma unroll 1
        for (int sub = 0; sub < nown; ++sub) { const int jd0 = qblk * 256 + sub * 64; const bool lane_ok = jd0 <= iq;
            if (__any(lane_ok)) att::tile_compute_auto<att::VP4>(lds + sub * 64 * att::KP, lds + att::VT4_OFF + sub * 128, qf, m, l, o, iq, t0 + 16 * w, jd0, lane_ok, 0x3fffffff, 0.125f * LOG2E, slope2, fr, g); }
        l += __shfl_xor(l, 16); l += __shfl_xor(l, 32);
        const int nsel = qblk < 3 ? qblk : 3;
        const size_t pb = ((size_t)h * 16384 + iq) * 3;
        f32x2 ml[3]; float M = m;
#pragma unroll
        for (int s = 0; s < 3; ++s) { ml[s] = (f32x2){att::M_MASK, 0.f}; if (s < nsel) ml[s] = PML[pb + s]; M = fmaxf(M, ml[s].x); }
        const float so = __builtin_amdgcn_exp2f(m - M); l *= so;
#pragma unroll
        for (int dt = 0; dt < 4; ++dt) o[dt] = o[dt] * so;
#pragma unroll
        for (int s = 0; s < 3; ++s) if (s < nsel) { const float sc = __builtin_amdgcn_exp2f(ml[s].x - M); l += ml[s].y * sc;
#pragma unroll
            for (int dt = 0; dt < 4; ++dt) { const v2u pv = *(const v2u*)(PO + (pb + s) * 64 + dt * 16 + 4 * g);
                o[dt][0] += sc * bflo(pv.x); o[dt][1] += sc * bfhi(pv.x); o[dt][2] += sc * bflo(pv.y); o[dt][3] += sc * bfhi(pv.y); } }
        att::store_o(Ob + (size_t)iq * 1024 + h * 64, o, 1.0f / l, g);
    }
}
__device__ __forceinline__ void ph_oproj(LAS unsigned char* lds, int li) {
    unsigned char* ws = WSP(); const int kind = li % 3, lj = li / 3;
    const bf16* wo = kind == 0 ? (const bf16*)(ws + WS_WO_A) + (size_t)lj * 1024 * 1024 : (kind == 1 ? (const bf16*)(ws + WS_WO_B) : (const bf16*)(ws + WS_WO_C));
    const float* xin = li == 0 ? INP(I_X) : (const float*)(ws + WS_F0);
    pg8::Gemm g{(const bf16*)(ws + WS_O), wo, S, D, D}; pg8::StaticOrder So; So.init(S, D, (int)gridDim.x, (int)blockIdx.x);
    pg8::EpiResid E{xin, (float*)(ws + WS_F1), D, DN_ALPHA};
    pg8::gemm_phase<pg8::EpiResid, pg8::StaticOrder, PG8_ALIGN, PG8_SP2>(lds, g, So, E);
}
__device__ __forceinline__ void ph_ln1(LAS unsigned char* lds, int li) {
    const Ctx c = mkctx(); unsigned char* ws = WSP();
    float* const F1 = (float*)(ws + WS_F1); bf16* const Bc = bcur(ws, li);
    const float* g1 = INP(I_LN1G) + li * D; const float* b1 = INP(I_LN1B) + li * D;
    for (int r = c.gw; r < S; r += c.NGW) ln_row(F1 + (size_t)r * D, g1, b1, F1 + (size_t)r * D, Bc + (size_t)r * D, c.lane);
}
__device__ __forceinline__ void ph_sc(LAS unsigned char* lds, int li) {
    unsigned char* ws = WSP();
    pg8::Gemm g{bcur(ws, li), (const bf16*)(ws + WS_WEFF) + (size_t)li * 2048 * 1024, S, 2048, D}; pg8::StaticOrder So; So.init(S, 2048, (int)gridDim.x, (int)blockIdx.x);
    pg8::EpiF32 E{(float*)(ws + WS_QKV), 2048};
    pg8::gemm_phase<pg8::EpiF32, pg8::StaticOrder, PG8_ALIGN, PG8_SP2>(lds, g, So, E);
}
__device__ __forceinline__ void ph_peer(LAS unsigned char* lds, int li, bool dry = false) {
    const Ctx c = mkctx(); unsigned char* ws = WSP();
    const int lane = c.lane, gw = c.gw, NGW = c.NGW;
    const GAS float* SC = (const GAS float*)(ws + WS_QKV); GAS float* const F0 = (GAS float*)(ws + (dry ? WS_OG : WS_F0)); const GAS float* F1 = (const GAS float*)(ws + WS_F1); GAS bf16* const Bout = dry ? (GAS bf16*)(ws + WS_OG + 64 * MiB) : (GAS bf16*)bcur(ws, li);
    const GAS unsigned char* U8 = (const GAS unsigned char*)(ws + WS_U + (size_t)li * PEER_E * D); const GAS unsigned char* V8 = (const GAS unsigned char*)(ws + WS_V + (size_t)li * PEER_E * D);
    const GAS float* g2 = (const GAS float*)(INP(I_LN2G) + li * D); const GAS float* b2 = (const GAS float*)(INP(I_LN2B) + li * D);
    const int seg = lane >> 4, r = lane & 15;
#pragma unroll 1
    for (int t = gw; t < S; t += NGW) {
        const GAS float* scr = SC + (size_t)t * 2048;
        float tv[4]; int ti[4];
#pragma unroll
        for (int p = 0; p < 4; ++p) {
            const int Gp = 4 * p + seg;
            const GAS float* b = scr + Gp * 128 + r * 8;
            const f32x4 a0 = *(const GAS f32x4*)b, a1 = *(const GAS f32x4*)(b + 4);
            unsigned kk[8];
#pragma unroll
            for (int j = 0; j < 4; ++j) { kk[j] = (sortable(a0[j]) & ~127u) | (unsigned)(127 - (r * 8 + j)); kk[4 + j] = (sortable(a1[j]) & ~127u) | (unsigned)(127 - (r * 8 + 4 + j)); }
#define CE(i, j) { const unsigned hi_ = kk[i] > kk[j] ? kk[i] : kk[j], lo_ = kk[i] > kk[j] ? kk[j] : kk[i]; kk[i] = hi_; kk[j] = lo_; }
            CE(0, 1) CE(2, 3) CE(4, 5) CE(6, 7)  CE(0, 2) CE(1, 3) CE(4, 6) CE(5, 7)  CE(1, 2) CE(5, 6)  CE(0, 4) CE(1, 5) CE(2, 6) CE(3, 7)  CE(2, 4) CE(3, 5)  CE(1, 2) CE(3, 4) CE(5, 6)
#undef CE
            unsigned win = 0u;
#pragma unroll
            for (int rd = 0; rd < 16; ++rd) {
                const unsigned head = kk[0], wk = row_max_u32(head); const bool pop = head == wk;
#pragma unroll
                for (int j = 0; j < 7; ++j) kk[j] = pop ? kk[j + 1] : kk[j];
                kk[7] = pop ? 0u : kk[7];
                if (r == rd) win = wk;
            }
            const int idx = 127 - (int)(win & 127u);
            ti[p] = idx; tv[p] = scr[Gp * 128 + idx];
        }
        float gate[4]; int expert[4];
#pragma unroll
        for (int p = 0; p < 4; ++p) {
            const float v1 = tv[p]; const int i1 = ti[p];
            int pa = 0; float bestv = 0.f; int beste = 0;
            const int srcb = (seg | 1) << 4, myb = seg << 4;
#pragma unroll
            for (int rd = 0; rd < 16; ++rd) {
                const float v2 = __shfl(tv[p], srcb + pa); const int i2 = __shfl(ti[p], srcb + pa);
                const float cand = v1 + v2; const unsigned key = (sortable(cand) & ~15u) | (unsigned)(15 - r);
                const unsigned wk = row_max_u32(key); const int a = 15 - (int)(wk & 15u);
                const int eid = i1 * 128 + i2;
                const float bw = __shfl(cand, myb + a); const int ew = __shfl(eid, myb + a);
                if (r == rd) { bestv = bw; beste = ew; }
                if (r == a) ++pa;
            }
            const float mx = row_max_f32(bestv), e = __expf(bestv - mx), sm = row_sum_f32(e);
            gate[p] = e / sm; expert[p] = beste;
        }
        int E0, E1; float G0, G1;
        { const int s0 = lane & 15, s1 = 32 + (lane & 15), pp = lane >> 4;
          const int a0 = __shfl(expert[0], s0), a1 = __shfl(expert[1], s0), a2 = __shfl(expert[2], s0), a3 = __shfl(expert[3], s0);
          const int c0 = __shfl(expert[0], s1), c1 = __shfl(expert[1], s1), c2 = __shfl(expert[2], s1), c3 = __shfl(expert[3], s1);
          const float g0 = __shfl(gate[0], s0), g1 = __shfl(gate[1], s0), g2_ = __shfl(gate[2], s0), g3 = __shfl(gate[3], s0);
          const float d0 = __shfl(gate[0], s1), d1 = __shfl(gate[1], s1), d2 = __shfl(gate[2], s1), d3 = __shfl(gate[3], s1);
          E0 = pp == 0 ? a0 : (pp == 1 ? a1 : (pp == 2 ? a2 : a3)); E1 = pp == 0 ? c0 : (pp == 1 ? c1 : (pp == 2 ? c2 : c3));
          G0 = pp == 0 ? g0 : (pp == 1 ? g1 : (pp == 2 ? g2_ : g3)); G1 = pp == 0 ? d0 : (pp == 1 ? d1 : (pp == 2 ? d2 : d3)); }
        const GAS float* x1r = F1 + (size_t)t * D + lane * 16;
        f32x2 xv[8];
#pragma unroll
        for (int q = 0; q < 4; ++q) { const f32x4 v = *(const GAS f32x4*)(x1r + 4 * q); xv[2 * q] = (f32x2){v.x, v.y}; xv[2 * q + 1] = (f32x2){v.z, v.w}; }
#define PEER_LOADB(dst, TAB, EREG, LB) _Pragma("unroll") for (int j = 0; j < PNB; ++j) { const int e_ = __builtin_amdgcn_readlane(EREG, (LB) + j); dst[j] = *(const GAS v4u*)(TAB + ((size_t)e_ << 10) + lane * 16); }
#define PEER_DOTB(src, HREG, LB) _Pragma("unroll") for (int j = 0; j < PNB; ++j) { const v4u w = src[j]; f32x2 a2 = (f32x2){0.f, 0.f}; \
            _Pragma("unroll") for (int q = 0; q < 4; ++q) { const f32x2 lo = __builtin_amdgcn_cvt_pk_f32_fp8((int)w[q], false), hi = __builtin_amdgcn_cvt_pk_f32_fp8((int)w[q], true); \
                a2 = __builtin_elementwise_fma(lo, xv[2 * q], a2); a2 = __builtin_elementwise_fma(hi, xv[2 * q + 1], a2); } \
            float acc = a2.x + a2.y; acc = row_sum_f32(acc); acc += __shfl_xor(acc, 16); acc += __shfl_xor(acc, 32); if (lane == (LB) + j) HREG = acc; }
#define PEER_AXB(src, AREG, LB) _Pragma("unroll") for (int j = 0; j < PNB; ++j) { const v4u w = src[j]; const float a_ = __int_as_float(__builtin_amdgcn_readlane(__float_as_int(AREG), (LB) + j)); const f32x2 aa = (f32x2){a_, a_}; \
            _Pragma("unroll") for (int q = 0; q < 4; ++q) { const f32x2 lo = __builtin_amdgcn_cvt_pk_f32_fp8((int)w[q], false), hi = __builtin_amdgcn_cvt_pk_f32_fp8((int)w[q], true); \
                y2[2 * q] = __builtin_elementwise_fma(lo, aa, y2[2 * q]); y2[2 * q + 1] = __builtin_elementwise_fma(hi, aa, y2[2 * q + 1]); } }
        constexpr int PNB = 8;
        float H0 = 0.f, H1 = 0.f;
        {
            v4u bA[PNB], bB[PNB];
            PEER_LOADB(bA, U8, E0, 0)
#pragma unroll 1
            for (int k = 0; k < 64 / PNB; ++k) {
                const int LB = PNB * k;
                PEER_LOADB(bB, U8, E1, LB)
                PEER_DOTB(bA, H0, LB)
                if (k + 1 < 64 / PNB) { PEER_LOADB(bA, U8, E0, LB + PNB) }
                PEER_DOTB(bB, H1, LB)
            }
        }
        H0 *= (1.0f / 32.0f); H1 *= (1.0f / 32.0f);
        const float A0 = 0.5f * H0 * (1.0f + erff(H0 * 0.70710678118654752f)) * G0 * 0.125f;
        const float A1 = 0.5f * H1 * (1.0f + erff(H1 * 0.70710678118654752f)) * G1 * 0.125f;
        f32x2 y2[8];
#pragma unroll
        for (int q = 0; q < 8; ++q) y2[q] = (f32x2){0.f, 0.f};
        {
            v4u bA[PNB], bB[PNB];
            PEER_LOADB(bA, V8, E0, 0)
#pragma unroll 1
            for (int k = 0; k < 64 / PNB; ++k) {
                const int LB = PNB * k;
                PEER_LOADB(bB, V8, E1, LB)
                PEER_AXB(bA, A0, LB)
                if (k + 1 < 64 / PNB) { PEER_LOADB(bA, V8, E0, LB + PNB) }
                PEER_AXB(bB, A1, LB)
            }
        }
#undef PEER_LOADB
#undef PEER_DOTB
#undef PEER_AXB
        float z[16]; float s = 0.f;
#pragma unroll
        for (int q = 0; q < 8; ++q) { z[2 * q] = DN_ALPHA * xv[q].x + y2[q].x; z[2 * q + 1] = DN_ALPHA * xv[q].y + y2[q].y; s += z[2 * q] + z[2 * q + 1]; }
        const float mean = wave_sum(s) * (1.f / D); float s2 = 0.f;
#pragma unroll
        for (int q = 0; q < 16; ++q) { z[q] -= mean; s2 += z[q] * z[q]; }
        const float rstd = 1.f / sqrtf(wave_sum(s2) * (1.f / D) + LN_EPS);
        float ov[16];
#pragma unroll
        for (int q = 0; q < 4; ++q) { const int c0 = lane * 16 + q * 4; const f32x4 gg = *(const GAS f32x4*)(g2 + c0), bb2 = *(const GAS f32x4*)(b2 + c0); f32x4 ovv;
#pragma unroll
            for (int e = 0; e < 4; ++e) { ovv[e] = z[q * 4 + e] * rstd * gg[e] + bb2[e]; ov[q * 4 + e] = ovv[e]; }
            *(GAS f32x4*)(F0 + (size_t)t * D + c0) = ovv; }
#pragma unroll
        for (int hh = 0; hh < 2; ++hh) { v4u w; w.x = pk2(ov[hh * 8 + 0], ov[hh * 8 + 1]); w.y = pk2(ov[hh * 8 + 2], ov[hh * 8 + 3]); w.z = pk2(ov[hh * 8 + 4], ov[hh * 8 + 5]); w.w = pk2(ov[hh * 8 + 6], ov[hh * 8 + 7]);
            *(GAS v4u*)(Bout + (size_t)t * D + lane * 16 + hh * 8) = w; }
    }
}
__device__ __forceinline__ void ph_ple_pw(LAS unsigned char* lds, int li) {
    unsigned char* ws = WSP();
    pg8::Gemm g{(const bf16*)(ws + WS_P) + (size_t)li * S * 256, (const bf16*)(ws + WS_PLEW) + (size_t)li * 1024 * 256, S, D, 256}; pg8::StaticOrder So; So.init(S, D, (int)gridDim.x, (int)blockIdx.x);
    pg8::EpiF32 E{(float*)(ws + WS_F1), D};
    pg8::gemm_phase<pg8::EpiF32, pg8::StaticOrder, PG8_ALIGN, PG8_SP2>(lds, g, So, E);
}
__device__ __forceinline__ void ph_ple_gate(LAS unsigned char* lds, int li) {
    unsigned char* ws = WSP();
    float* const F0 = (float*)(ws + WS_F0);
    float* outp = li == DEPTH - 1 ? (float*)ldp(lds, I_OUT) : F0;
    pg8::Gemm g{bcur(ws, li), (const bf16*)(ws + WS_PLEG) + (size_t)li * 1024 * 1024, S, D, D}; pg8::StaticOrder So; So.init(S, D, (int)gridDim.x, (int)blockIdx.x);
    pg8::EpiPle E{F0, (const float*)(ws + WS_F1), INP(I_PLEGB) + li * D, outp, both(ws, li), D};
    pg8::gemm_phase<pg8::EpiPle, pg8::StaticOrder, PG8_ALIGN, PG8_SP2>(lds, g, So, E);
}

#define GRID_SYNC_CG() do { asm volatile("s_waitcnt vmcnt(0)" ::: "memory"); __syncthreads(); grid.sync(); __builtin_amdgcn_fence(__ATOMIC_ACQUIRE, "agent"); asm volatile("s_waitcnt vmcnt(0)" ::: "memory"); __syncthreads(); } while (0)
#define GRID_SYNC() do { XcdBarrier xb_; xb_.bar = (unsigned*)(WSP() + WS_CTL) + 4096; xb_.x = xb_xcc_id(); xb_.st = (volatile LAS unsigned*)(lds + XBST_OFF); xcd_barrier(xb_); } while (0)
__global__ void __launch_bounds__(NTHR, 2) fwd_kernel(Args args) {
    extern __shared__ __attribute__((aligned(16))) unsigned char lds_raw[];
    LAS unsigned char* lds = (LAS unsigned char*)lds_raw;
    cg::grid_group grid = cg::this_grid();
    if (threadIdx.x == 0) {
        LAS unsigned long long* t = (LAS unsigned long long*)(lds + PTAB_OFF);
        t[0] = (unsigned long long)args.in[0]; t[1] = (unsigned long long)args.in[1]; t[2] = (unsigned long long)args.in[2]; t[3] = (unsigned long long)args.in[3];
        t[4] = (unsigned long long)args.in[4]; t[5] = (unsigned long long)args.in[5]; t[6] = (unsigned long long)args.in[6]; t[7] = (unsigned long long)args.in[7];
        t[8] = (unsigned long long)args.in[8]; t[9] = (unsigned long long)args.in[9]; t[10] = (unsigned long long)args.in[10]; t[11] = (unsigned long long)args.in[11];
        t[12] = (unsigned long long)args.in[12]; t[13] = (unsigned long long)args.in[13]; t[14] = (unsigned long long)args.in[14]; t[15] = (unsigned long long)args.in[15];
        t[16] = (unsigned long long)args.in[16]; t[17] = (unsigned long long)args.in[17]; t[18] = (unsigned long long)args.in[18]; t[19] = (unsigned long long)args.in[19];
        t[20] = (unsigned long long)args.out; t[21] = (unsigned long long)args.ws;
    }
    if (threadIdx.x < 2) ((volatile LAS unsigned*)(lds + XBST_OFF))[threadIdx.x] = 0u;
    __syncthreads();
    (void)xcd_barrier_post((unsigned*)args.ws + 4096, (volatile LAS unsigned*)(lds + XBST_OFF));
#ifndef SKIP_PRO
    ph_prologue(lds);
#endif
    GRID_SYNC_CG();
#pragma unroll 1
    for (int li0 = 0; li0 < DEPTH; ++li0) {
        int li = li0;
        LAUNDER(li); ph_qkv(lds, li);
        GRID_SYNC();
#ifndef SKIP_ATT
        LAUNDER(li);
        const int kind = li % 3;
        if (kind == 0) {
#ifndef SKIP_A
            ph_attn_a(lds, li);
#endif
        } else if (kind == 1) {
#ifndef SKIP_B
            ph_attn_b(lds); GRID_SYNC(); ph_merge_b(lds);
#endif
        } else {
#ifndef SKIP_C
#ifdef C_UNION
            ph_kmean(lds); GRID_SYNC(); ph_attn_c(lds);
#else
            ph_kmean(lds); GRID_SYNC(); ph_gate_c(lds); GRID_SYNC(); ph_bucket_c(lds); GRID_SYNC(); ph_own_c(lds);
#endif
#endif
        }
#endif
        GRID_SYNC();
        LAUNDER(li); ph_oproj(lds, li);
        GRID_SYNC();
        LAUNDER(li); ph_ln1(lds, li);
        GRID_SYNC();
        LAUNDER(li); ph_sc(lds, li);
        GRID_SYNC();
#ifndef SKIP_PEER
#ifdef REP_PEER
        LAUNDER(li); ph_peer(lds, li, true);
#endif
        LAUNDER(li); ph_peer(lds, li);
#endif
        GRID_SYNC();
        LAUNDER(li); ph_ple_pw(lds, li);
        asm volatile("s_waitcnt vmcnt(0)" ::: "memory"); __syncthreads();
        LAUNDER(li); ph_ple_gate(lds, li);
        if (li0 + 1 < DEPTH) GRID_SYNC();
    }
}

extern "C" void kernel_launch(void* const* d_in, const int* in_sizes, int n_in, void* d_out, int out_size, void* d_ws, size_t ws_size, hipStream_t stream) {
    static int grid = 0;
    if (grid == 0) {
        if (n_in != 20 || out_size != S * D || ws_size < WS_END) { fprintf(stderr, "kernel_launch: unexpected shapes: n_in %d out %d ws %zu (need %zu)\n", n_in, out_size, ws_size, (size_t)WS_END); grid = -1; return; }
        int dev = 0, cus = 0, per_cu = 0;
        hipGetDevice(&dev); hipDeviceGetAttribute(&cus, hipDeviceAttributeMultiprocessorCount, dev);
        if (hipFuncSetAttribute((const void*)fwd_kernel, hipFuncAttributeMaxDynamicSharedMemorySize, LDS_BYTES) != hipSuccess) { fprintf(stderr, "kernel_launch: hipFuncSetAttribute failed\n"); grid = -1; return; }
        if (hipOccupancyMaxActiveBlocksPerMultiprocessor(&per_cu, (const void*)fwd_kernel, NTHR, LDS_BYTES) != hipSuccess || per_cu < 1) { fprintf(stderr, "kernel_launch: occupancy query says %d\n", per_cu); per_cu = 1; }
        (void)hipGetLastError();
        grid = cus;
        fprintf(stderr, "kernel_launch: grid %d (cus %d, per_cu %d)\n", grid, cus, per_cu);
    }
    if (grid < 0) return;
    if (hipMemsetAsync((char*)d_ws + WS_CTL, 0, 65536, stream) != hipSuccess) { fprintf(stderr, "kernel_launch: memset failed\n"); return; }
    Args a{};
    for (int i = 0; i < 20; ++i) a.in[i] = (const float*)d_in[i];
    a.out = (float*)d_out; a.ws = (unsigned char*)d_ws;
    void* kargs[] = {&a};
    const hipError_t e = hipLaunchCooperativeKernel((const void*)fwd_kernel, dim3(grid), dim3(NTHR), kargs, LDS_BYTES, stream);
    if (e != hipSuccess) fprintf(stderr, "kernel_launch: cooperative launch failed: %s (grid %d)\n", hipGetErrorString(e), grid);
}
```

```cpp
#include <hip/hip_runtime.h>
#include <hip/hip_cooperative_groups.h>
#include <cstdio>
#include <cstdint>
namespace cg = cooperative_groups;
#define PEER_U4 1
#define PEER_V4 1
namespace pg8 {
#define PG8_LAS __attribute__((address_space(3)))
typedef unsigned short bf16_t;
typedef short bf16x8 __attribute__((ext_vector_type(8)));
typedef float f32x4 __attribute__((ext_vector_type(4)));
typedef unsigned u32x4 __attribute__((ext_vector_type(4)));
constexpr int BM = 256, BK = 64, HALF = 128, HTB = HALF * BK * 2  , STAGE_BYTES = 8 * HTB, NXCD = 8, WGM = 8;

__host__ __device__ __forceinline__ int lds_byte(int r, int c) { const int st = (r >> 4) * 2 + (c >> 5), rr = r & 15, cc = c & 31, ob = rr * 64 + cc * 2; return st * 1024 + (ob ^ (((ob >> 9) & 1) << 5)); }
__host__ __device__ __forceinline__ void stage_rc(int b, int& R, int& C) { const int st = b / 1024, sb = b % 1024, swz = sb ^ (((sb >> 9) & 1) << 5); R = (st >> 1) * 16 + swz / 64; C = (st & 1) * 32 + (swz % 64) / 2; }
__host__ __device__ __forceinline__ int perm32(int rho) { const int n = rho >> 4, i = rho & 15; return 8 * (i >> 2) + 4 * n + (i & 3); }

struct Unit { int pm, pn; };
struct Gemm { const bf16_t* A; const bf16_t* Bt; int M, N, K; };

struct StaticOrder {
    int nM, nN, nwg, G, c;
    __host__ __device__ void init(int M, int N, int G_, int c_) { nM = M / BM; nN = N / BM; nwg = nM * nN; G = G_; c = c_; }
    __host__ __device__ bool next(int i, Unit& u) const {
        const long L = (long)i * G + c; if (L >= nwg) return false;
        int wgid = (int)L; { const int q = nwg / NXCD, r = nwg % NXCD, xcd = wgid % NXCD, off = wgid / NXCD; wgid = (xcd < r ? xcd * (q + 1) : r * (q + 1) + (xcd - r) * q) + off; }
        const int nig = WGM * nN, gid = wgid / nig, fm = gid * WGM, gsz = (nM - fm) < WGM ? (nM - fm) : WGM;
        u.pm = fm + ((wgid % nig) % gsz); u.pn = (wgid % nig) / gsz; return true;
    }
    __device__ __forceinline__ void a_ready(const Unit&) const {}
    __device__ __forceinline__ void done(const Unit&) const {}
};

__device__ __forceinline__ unsigned cvt_pk_bf16(float lo, float hi) { unsigned r; asm volatile("v_cvt_pk_bf16_f32 %0, %1, %2" : "=v"(r) : "v"(lo), "v"(hi)); return r; }
typedef float f32x2 __attribute__((ext_vector_type(2)));
__device__ __forceinline__ f32x2 gelu_pk(f32x2 v) {
    const f32x2 av = __builtin_elementwise_abs(v), d = av * 0.2316418882f + 1.0f;
    f32x2 t; t.x = __builtin_amdgcn_rcpf(d.x); t.y = __builtin_amdgcn_rcpf(d.y);
    f32x2 q = t * 0.5307027145f + (-0.7265760135f); q = q * t + 0.7107068705f; q = q * t + (-0.142248368f); q = q * t + 0.127414796f; q = q * t;
    const f32x2 s = (v * v) * (-0.72134752044f);
    f32x2 e; e.x = __builtin_amdgcn_exp2f(s.x); e.y = __builtin_amdgcn_exp2f(s.y);
    const f32x2 m = v * (q * e), r = v - m;
    f32x2 o; o.x = v.x < 0.f ? m.x : r.x; o.y = v.y < 0.f ? m.y : r.y; return o;
}

template <int ACT  > struct EpiBf16 {
    static constexpr bool PERM = true, AFTER_DRAIN = false; static_assert(ACT == 0 || ACT == 1, "EpiBf16: ACT is 0 (none) or 1 (gelu_pk)");
    bf16_t* O; int ldc; const float* bias; int split_cols; size_t split_stride; float scale0;
    __device__ __forceinline__ void operator()(const f32x4 (&acc)[2][2][4][2], const Unit& u, int wr, int wc, int fr, int fq) const {
        const int row0 = u.pm * BM + wr * 64 + fr; int colt = u.pn * BM; bf16_t* base = O;
        float sc = 1.f; if (split_cols) { const int t = colt / split_cols; base += (size_t)t * split_stride; colt -= t * split_cols; if (t == 0) sc = scale0; }
        const int col0 = colt + wc * 32 + 8 * fq, bcol0 = u.pn * BM + wc * 32 + 8 * fq;
        f32x4 bv[2][2];
#pragma unroll
        for (int bj = 0; bj < 2; ++bj)
#pragma unroll
            for (int n = 0; n < 2; ++n) bv[bj][n] = bias ? *(const f32x4*)(bias + bcol0 + bj * HALF + 4 * n) : (f32x4){0.f, 0.f, 0.f, 0.f};
#pragma unroll
        for (int ai = 0; ai < 2; ++ai)
#pragma unroll
            for (int m = 0; m < 4; ++m) { bf16_t* rowp = base + (size_t)(row0 + ai * HALF + m * 16) * ldc + col0;
#pragma unroll
                for (int bj = 0; bj < 2; ++bj) { f32x4 v0 = acc[ai][bj][m][0] + bv[bj][0], v1 = acc[ai][bj][m][1] + bv[bj][1];
                    if (ACT == 1) { f32x2 a = gelu_pk((f32x2){v0[0], v0[1]}), b = gelu_pk((f32x2){v0[2], v0[3]}), c = gelu_pk((f32x2){v1[0], v1[1]}), d = gelu_pk((f32x2){v1[2], v1[3]});
                        v0 = (f32x4){a.x, a.y, b.x, b.y}; v1 = (f32x4){c.x, c.y, d.x, d.y}; }
                    v0 = v0 * sc; v1 = v1 * sc; u32x4 w; w.x = cvt_pk_bf16(v0[0], v0[1]); w.y = cvt_pk_bf16(v0[2], v0[3]); w.z = cvt_pk_bf16(v1[0], v1[1]); w.w = cvt_pk_bf16(v1[2], v1[3]);
                    *(u32x4*)(rowp + bj * HALF) = w; } }
    }
};
typedef unsigned u32x2e __attribute__((ext_vector_type(2)));
struct EpiF32 {
    static constexpr bool PERM = false, AFTER_DRAIN = false;
    float* O; int ldc;
    __device__ __forceinline__ void operator()(const f32x4 (&acc)[2][2][4][2], const Unit& u, int wr, int wc, int fr, int fq) const {
        const int col0 = u.pn * BM + wc * 32 + 4 * fq;
#pragma unroll
        for (int ai = 0; ai < 2; ++ai)
#pragma unroll
            for (int m = 0; m < 4; ++m) { const size_t off = (size_t)(u.pm * BM + ai * HALF + wr * 64 + m * 16 + fr) * ldc + col0;
#pragma unroll
                for (int bj = 0; bj < 2; ++bj)
#pragma unroll
                    for (int n = 0; n < 2; ++n) *(f32x4*)(O + off + bj * HALF + n * 16) = acc[ai][bj][m][n]; }
    }
};
struct EpiResid {
    static constexpr bool PERM = false, AFTER_DRAIN = false;
    const float* X; float* Z; int ldc; float alpha;
    __device__ __forceinline__ void operator()(const f32x4 (&acc)[2][2][4][2], const Unit& u, int wr, int wc, int fr, int fq) const {
        const int col0 = u.pn * BM + wc * 32 + 4 * fq;
#pragma unroll
        for (int ai = 0; ai < 2; ++ai)
#pragma unroll
            for (int m = 0; m < 4; ++m) { const size_t off = (size_t)(u.pm * BM + ai * HALF + wr * 64 + m * 16 + fr) * ldc + col0;
#pragma unroll
                for (int bj = 0; bj < 2; ++bj)
#pragma unroll
                    for (int n = 0; n < 2; ++n) { const f32x4 xv = *(const f32x4*)(X + off + bj * HALF + n * 16); *(f32x4*)(Z + off + bj * HALF + n * 16) = xv * alpha + acc[ai][bj][m][n]; } }
    }
};
struct EpiPle {
    static constexpr bool PERM = false, AFTER_DRAIN = false;
    const float* X2; const float* PW; const float* bg; float* OUT; bf16_t* OUTB; int ldc;
    __device__ __forceinline__ void operator()(const f32x4 (&acc)[2][2][4][2], const Unit& u, int wr, int wc, int fr, int fq) const {
        const int col0 = u.pn * BM + wc * 32 + 4 * fq;
#pragma unroll
        for (int ai = 0; ai < 2; ++ai)
#pragma unroll
            for (int m = 0; m < 4; ++m) { const size_t off = (size_t)(u.pm * BM + ai * HALF + wr * 64 + m * 16 + fr) * ldc + col0;
#pragma unroll
                for (int bj = 0; bj < 2; ++bj)
#pragma unroll
                    for (int n = 0; n < 2; ++n) { const int co = bj * HALF + n * 16;
                        const f32x4 xv = *(const f32x4*)(X2 + off + co), pw = *(const f32x4*)(PW + off + co), bv = *(const f32x4*)(bg + col0 + co);
                        const f32x4 a = acc[ai][bj][m][n] + bv; f32x4 o;
#pragma unroll
                        for (int e = 0; e < 4; ++e) { const float sg = 1.0f / (1.0f + __expf(-a[e])); o[e] = xv[e] + sg * pw[e]; }
                        *(f32x4*)(OUT + off + co) = o;
                        u32x2e w; w.x = cvt_pk_bf16(o[0], o[1]); w.y = cvt_pk_bf16(o[2], o[3]); *(u32x2e*)(OUTB + off + co) = w; } }
    }
};
template <class Epi, class Sched, bool ALIGN_EPI = false, bool SP2 = false>
__device__ __forceinline__ void gemm_phase(PG8_LAS unsigned char* lds, const Gemm g, const Sched& S, const Epi& E) {
    int tid_ = threadIdx.x; asm volatile("" : "+v"(tid_));
    const int tid = tid_, wid = __builtin_amdgcn_readfirstlane(tid >> 6), lane = tid & 63, wr = wid >> 2, wc = wid & 3, fr = lane & 15, fq = lane >> 4;
    const int K = g.K, nt = K / BK;
    unsigned voffA[2], voffB[2];
#pragma unroll
    for (int i = 0; i < 2; ++i) { int R, C; stage_rc(tid * 16 + i * 8192, R, C); const int Rb = Epi::PERM ? ((R & ~31) + perm32(R & 31)) : R;
        voffA[i] = (unsigned)(R * K + C) * 2u; voffB[i] = (unsigned)(Rb * K + C) * 2u; }
    const size_t kstep = (size_t)(BK * 2);
    const size_t hstep = (size_t)HALF * K * 2;
    const size_t tstep = 2 * hstep;
    const unsigned ldsw = (unsigned)wid * 1024u;
    const int aoff = lds_byte(wr * 64 + fr, fq * 8), boff = lds_byte(wc * 32 + fr, fq * 8);
#define PG8_SA(b, h) (((b) * 2 + (h)) * HTB)
#define PG8_SB(b, h) ((4 + (b) * 2 + (h)) * HTB)
#define PG8_STAGE(bufoff, gbase, voff) do { _Pragma("unroll") for (int _i = 0; _i < 2; ++_i) \
        __builtin_amdgcn_global_load_lds((const unsigned*)((const char*)(gbase) + (voff)[_i]), (PG8_LAS unsigned*)(lds + (bufoff) + ldsw + _i * 8192), 16, 0, 0); } while (0)
#define PG8_LDA(dst, b, h) do { _Pragma("unroll") for (int m = 0; m < 4; ++m) _Pragma("unroll") for (int k = 0; k < 2; ++k) dst[m][k] = *(const PG8_LAS bf16x8*)(lds + PG8_SA(b, h) + aoff + m * 2048 + k * 1024); } while (0)
#define PG8_LDB(dst, b, h) do { _Pragma("unroll") for (int n = 0; n < 2; ++n) _Pragma("unroll") for (int k = 0; k < 2; ++k) dst[n][k] = *(const PG8_LAS bf16x8*)(lds + PG8_SB(b, h) + boff + n * 2048 + k * 1024); } while (0)
#define PG8_MMA(ai, bj, At, Bt) do { __builtin_amdgcn_s_setprio(1); _Pragma("unroll") for (int m = 0; m < 4; ++m) _Pragma("unroll") for (int n = 0; n < 2; ++n) _Pragma("unroll") for (int k = 0; k < 2; ++k) \
        acc[ai][bj][m][n] = __builtin_amdgcn_mfma_f32_16x16x32_bf16(Bt[n][k], At[m][k], acc[ai][bj][m][n], 0, 0, 0); __builtin_amdgcn_s_setprio(0); } while (0)
#define PG8_WAIT_V(n) asm volatile("s_waitcnt vmcnt(" #n ")" ::: "memory")
#define PG8_WAIT_L(n) asm volatile("s_waitcnt lgkmcnt(" #n ")" ::: "memory")
#define PG8_BAR __builtin_amdgcn_s_barrier()
#define PG8_SCHED __builtin_amdgcn_sched_barrier(0)
    Unit cur, nxt; int ui = 0;
    if (!S.next(0, cur)) return;
    f32x4 acc[2][2][4][2];
#pragma unroll
    for (int a = 0; a < 2; ++a)
#pragma unroll
        for (int b = 0; b < 2; ++b)
#pragma unroll
            for (int m = 0; m < 4; ++m)
#pragma unroll
                for (int n = 0; n < 2; ++n) acc[a][b][m][n] = (f32x4){0.f, 0.f, 0.f, 0.f};
    bf16x8 At[4][2], B0[2][2], B1[2][2];
    const char* cA = (const char*)g.A + (size_t)cur.pm * tstep; const char* cB = (const char*)g.Bt + (size_t)cur.pn * tstep;
    S.a_ready(cur);
    if constexpr (SP2) {
        PG8_STAGE(PG8_SB(0, 0), cB, voffB); PG8_STAGE(PG8_SB(0, 1), cB + hstep, voffB); PG8_STAGE(PG8_SA(0, 0), cA, voffA); PG8_STAGE(PG8_SA(0, 1), cA + hstep, voffA);
        if (wr == 1) PG8_BAR;
        PG8_WAIT_V(2); PG8_BAR;
        PG8_STAGE(PG8_SB(1, 0), cB + kstep, voffB); PG8_STAGE(PG8_SA(1, 0), cA + kstep, voffA); PG8_STAGE(PG8_SB(1, 1), cB + hstep + kstep, voffB);
        PG8_WAIT_V(6); PG8_BAR;
    } else {
        PG8_STAGE(PG8_SB(0, 0), cB, voffB); PG8_STAGE(PG8_SA(0, 0), cA, voffA); PG8_STAGE(PG8_SB(0, 1), cB + hstep, voffB); PG8_STAGE(PG8_SA(0, 1), cA + hstep, voffA);
        if (wr == 1) PG8_BAR;
        PG8_WAIT_V(4); PG8_BAR;
        PG8_STAGE(PG8_SB(1, 0), cB + kstep, voffB); PG8_STAGE(PG8_SA(1, 0), cA + kstep, voffA); PG8_STAGE(PG8_SB(1, 1), cB + hstep + kstep, voffB);
        PG8_WAIT_V(6); PG8_BAR;
    }
    for (;;) {
        const bool has_next = S.next(ui + 1, nxt);
        const char* nA = has_next ? (const char*)g.A + (size_t)nxt.pm * tstep : cA; const char* nB = has_next ? (const char*)g.Bt + (size_t)nxt.pn * tstep : cB;
        for (int t = 0; t < nt; t += 2) {
            const bool last = (t == nt - 2);
            const char* a1 = cA + (size_t)(t + 1) * kstep;
            const char* a2 = last ? nA : cA + (size_t)(t + 2) * kstep; const char* b2 = last ? nB : cB + (size_t)(t + 2) * kstep;
            const char* a3 = a2 + kstep; const char* b3 = b2 + kstep;
            if (last && has_next) S.a_ready(nxt);
            if constexpr (SP2) {
            PG8_LDB(B0, 0, 0); PG8_LDB(B1, 0, 1); PG8_SCHED; PG8_LDA(At, 0, 0); PG8_STAGE(PG8_SA(1, 1), a1 + hstep, voffA);
            PG8_WAIT_V(8); PG8_WAIT_L(0); PG8_BAR; PG8_MMA(0, 0, At, B0); PG8_MMA(0, 1, At, B1); PG8_BAR; PG8_SCHED;
            PG8_LDA(At, 0, 1); PG8_STAGE(PG8_SB(0, 0), b2, voffB); PG8_STAGE(PG8_SB(0, 1), b2 + hstep, voffB); PG8_STAGE(PG8_SA(0, 0), a2, voffA);
            PG8_WAIT_V(8); PG8_WAIT_L(0); PG8_BAR; PG8_MMA(1, 0, At, B0); PG8_MMA(1, 1, At, B1); PG8_BAR; PG8_SCHED;
            PG8_LDB(B0, 1, 0); PG8_LDB(B1, 1, 1); PG8_SCHED; PG8_LDA(At, 1, 0); PG8_STAGE(PG8_SA(0, 1), a2 + hstep, voffA);
            PG8_WAIT_V(8); PG8_WAIT_L(0); PG8_BAR; PG8_MMA(0, 0, At, B0); PG8_MMA(0, 1, At, B1); PG8_BAR; PG8_SCHED;
            PG8_LDA(At, 1, 1); PG8_STAGE(PG8_SB(1, 0), b3, voffB); PG8_STAGE(PG8_SB(1, 1), b3 + hstep, voffB); PG8_STAGE(PG8_SA(1, 0), a3, voffA);
            PG8_WAIT_V(8); PG8_WAIT_L(0); PG8_BAR; PG8_MMA(1, 0, At, B0); PG8_MMA(1, 1, At, B1); PG8_BAR; PG8_SCHED;
            } else {
            PG8_LDB(B0, 0, 0); PG8_SCHED; PG8_LDA(At, 0, 0); PG8_STAGE(PG8_SA(1, 1), a1 + hstep, voffA);
            PG8_WAIT_L(8); PG8_BAR; PG8_WAIT_L(0); PG8_MMA(0, 0, At, B0); PG8_BAR; PG8_SCHED;
            PG8_LDB(B1, 0, 1); PG8_STAGE(PG8_SB(0, 0), b2, voffB);
            PG8_BAR; PG8_WAIT_L(0); PG8_MMA(0, 1, At, B1); PG8_BAR;
            PG8_LDA(At, 0, 1); PG8_STAGE(PG8_SA(0, 0), a2, voffA);
            PG8_BAR; PG8_WAIT_L(0); PG8_MMA(1, 0, At, B0); PG8_BAR; PG8_SCHED;
            PG8_STAGE(PG8_SB(0, 1), b2 + hstep, voffB);
            PG8_WAIT_V(6); PG8_BAR; PG8_MMA(1, 1, At, B1); PG8_BAR;
            PG8_LDB(B0, 1, 0); PG8_SCHED; PG8_LDA(At, 1, 0); PG8_STAGE(PG8_SA(0, 1), a2 + hstep, voffA);
            PG8_WAIT_L(8); PG8_BAR; PG8_WAIT_L(0); PG8_MMA(0, 0, At, B0); PG8_BAR; PG8_SCHED;
            PG8_LDB(B1, 1, 1); PG8_STAGE(PG8_SB(1, 0), b3, voffB);
            PG8_BAR; PG8_WAIT_L(0); PG8_MMA(0, 1, At, B1); PG8_BAR;
            PG8_LDA(At, 1, 1); PG8_STAGE(PG8_SA(1, 0), a3, voffA);
            PG8_BAR; PG8_WAIT_L(0); PG8_MMA(1, 0, At, B0); PG8_BAR; PG8_SCHED;
            PG8_STAGE(PG8_SB(1, 1), b3 + hstep, voffB);
            PG8_WAIT_V(6); PG8_BAR; PG8_MMA(1, 1, At, B1); PG8_BAR;
            }
        }
        if constexpr (ALIGN_EPI) { if (wr == 0) PG8_BAR; }
        if constexpr (!Epi::AFTER_DRAIN) { E(acc, cur, wr, wc, fr, fq); S.done(cur); }
        if (!has_next) break;
#pragma unroll
        for (int a = 0; a < 2; ++a)
#pragma unroll
            for (int b = 0; b < 2; ++b)
#pragma unroll
                for (int m = 0; m < 4; ++m)
#pragma unroll
                    for (int n = 0; n < 2; ++n) acc[a][b][m][n] = (f32x4){0.f, 0.f, 0.f, 0.f};
        cur = nxt; cA = nA; cB = nB; ++ui;
        if constexpr (ALIGN_EPI) { if (wr == 1) PG8_BAR; }
    }
    PG8_WAIT_V(0);
    if constexpr (!ALIGN_EPI) { if (wr == 0) PG8_BAR; }
    PG8_BAR;
    if constexpr (Epi::AFTER_DRAIN) { E.fused(acc, cur, wr, wc, fr, fq, lds, wid, lane); S.done(cur); }
#undef PG8_SA
#undef PG8_SB
#undef PG8_STAGE
#undef PG8_LDA
#undef PG8_LDB
#undef PG8_MMA
#undef PG8_WAIT_V
#undef PG8_WAIT_L
#undef PG8_BAR
#undef PG8_SCHED
}
}
#ifndef PG8_SP2
#define PG8_SP2 true
#endif
#ifndef PG8_ALIGN
#define PG8_ALIGN true
#endif
constexpr int S = 16384, D = 1024, DEPTH = 4, NW = 8, NTHR = 512;
constexpr int PEER_E = 16384;
constexpr float LN_EPS = 1e-5f;
constexpr float DN_ALPHA = 1.681792830507429f;
constexpr float LOG2E = 1.4426950408889634f, LN2F = 0.6931471805599453f;
constexpr size_t MiB = 1u << 20;
constexpr size_t WS_CTL = 0;
constexpr size_t WS_WQKV_A = 1 * MiB;
constexpr size_t WS_WO_A = WS_WQKV_A + 5 * MiB;
constexpr size_t WS_WQKV_B = WS_WO_A + 4 * MiB;
constexpr size_t WS_WO_B = WS_WQKV_B + 10 * MiB;
constexpr size_t WS_WQKV_C = WS_WO_B + 2 * MiB;
constexpr size_t WS_WO_C = WS_WQKV_C + 6 * MiB;
constexpr size_t WS_WEFF = WS_WO_C + 2 * MiB;
constexpr size_t WS_PLEW = WS_WEFF + 16 * MiB;
constexpr size_t WS_PLEG = WS_PLEW + 2 * MiB;
constexpr size_t WS_KMEAN = WS_PLEG + 8 * MiB;
constexpr size_t WS_LSE = WS_KMEAN + 1 * MiB;
constexpr size_t WS_U = 64 * MiB;
constexpr size_t WS_V = WS_U + 128 * MiB;
constexpr size_t WS_P = WS_V + 128 * MiB;
constexpr size_t WS_F0 = WS_P + 32 * MiB;
constexpr size_t WS_F1 = WS_F0 + 64 * MiB;
constexpr size_t WS_B0 = WS_F1 + 64 * MiB;
constexpr size_t WS_B1 = WS_B0 + 32 * MiB;
constexpr size_t WS_QKV = WS_B1 + 32 * MiB;
constexpr size_t WS_O = WS_QKV + 160 * MiB;
constexpr size_t WS_OG = WS_O + 32 * MiB;
constexpr size_t WS_CLIST = WS_OG + 96 * MiB;
constexpr size_t WS_CPML = WS_CLIST + 64 * MiB;
constexpr size_t WS_END = WS_CPML + 8 * MiB;
constexpr size_t WS_CCNT = 32768;
constexpr size_t WS_RSCALE = WS_CPML + 7 * MiB;
static_assert(WS_LSE + 4 * MiB <= WS_U, "ws map");

constexpr int LDS_BYTES = 147456;

#define GAS __attribute__((address_space(1)))
#define LAS __attribute__((address_space(3)))
typedef unsigned short bf16;
typedef unsigned v4u __attribute__((ext_vector_type(4)));
typedef unsigned v2u __attribute__((ext_vector_type(2)));
typedef float f32x4 __attribute__((ext_vector_type(4)));
typedef short bf16x8 __attribute__((ext_vector_type(8)));
typedef float f32x2 __attribute__((ext_vector_type(2)));
typedef __bf16 bf2_t __attribute__((ext_vector_type(2)));

__device__ __forceinline__ unsigned f2bf(float f) { unsigned u = __builtin_bit_cast(unsigned, f); return (u + 0x7fffu + ((u >> 16) & 1u)) >> 16; }
__device__ __forceinline__ unsigned pk2(float lo, float hi) { return f2bf(lo) | (f2bf(hi) << 16); }
__device__ __forceinline__ float bflo(unsigned w) { return __uint_as_float(w << 16); }
__device__ __forceinline__ float bfhi(unsigned w) { return __uint_as_float(w & 0xffff0000u); }
__device__ __forceinline__ float wave_sum(float v) {
#pragma unroll
    for (int o = 1; o < 64; o <<= 1) v += __shfl_xor(v, o);
    return v;
}
#define DPPI(x, ctl) __builtin_amdgcn_update_dpp(0, (int)(x), (ctl), 0xF, 0xF, true)
__device__ __forceinline__ unsigned row_max_u32(unsigned x) {
    unsigned y;
    y = (unsigned)DPPI(x, 0xB1); x = x > y ? x : y;
    y = (unsigned)DPPI(x, 0x4E); x = x > y ? x : y;
    y = (unsigned)DPPI(x, 0x141); x = x > y ? x : y;
    y = (unsigned)DPPI(x, 0x140); x = x > y ? x : y;
    return x;
}
__device__ __forceinline__ float row_max_f32(float x) {
    x = fmaxf(x, __int_as_float(DPPI(__float_as_int(x), 0xB1)));
    x = fmaxf(x, __int_as_float(DPPI(__float_as_int(x), 0x4E)));
    x = fmaxf(x, __int_as_float(DPPI(__float_as_int(x), 0x141)));
    x = fmaxf(x, __int_as_float(DPPI(__float_as_int(x), 0x140)));
    return x;
}
__device__ __forceinline__ float row_sum_f32(float x) {
    x += __int_as_float(DPPI(__float_as_int(x), 0xB1));
    x += __int_as_float(DPPI(__float_as_int(x), 0x4E));
    x += __int_as_float(DPPI(__float_as_int(x), 0x141));
    x += __int_as_float(DPPI(__float_as_int(x), 0x140));
    return x;
}
__device__ __forceinline__ float dot16bf(v4u a0, v4u a1, v4u b0, v4u b1) {
    float acc = 0.f;
    asm volatile("s_nop 1\n\tv_dot2c_f32_bf16 %0, %1, %9\n\tv_dot2c_f32_bf16 %0, %2, %10\n\tv_dot2c_f32_bf16 %0, %3, %11\n\tv_dot2c_f32_bf16 %0, %4, %12\n\t"
                 "v_dot2c_f32_bf16 %0, %5, %13\n\tv_dot2c_f32_bf16 %0, %6, %14\n\tv_dot2c_f32_bf16 %0, %7, %15\n\tv_dot2c_f32_bf16 %0, %8, %16\n\ts_nop 2"
                 : "+v"(acc)
                 : "v"(a0.x), "v"(a0.y), "v"(a0.z), "v"(a0.w), "v"(a1.x), "v"(a1.y), "v"(a1.z), "v"(a1.w),
                   "v"(b0.x), "v"(b0.y), "v"(b0.z), "v"(b0.w), "v"(b1.x), "v"(b1.y), "v"(b1.z), "v"(b1.w));
    return acc;
}
__device__ __forceinline__ unsigned sortable(float f) { const unsigned u = __float_as_uint(f); return (u & 0x80000000u) ? ~u : (u | 0x80000000u); }

__device__ __forceinline__ void p0_transpose_item(const float* W, int K, int N, bf16* WT, LAS float* scr, int item, int lane) {
    const int nblk = N / 32, kb = item / nblk, nb = item % nblk, k0 = 64 * kb, n0 = 32 * nb;
#pragma unroll 8
    for (int i = 0; i < 32; ++i) { const int kk = 2 * i + (lane >> 5); scr[kk * 33 + (lane & 31)] = W[(size_t)(k0 + kk) * N + n0 + (lane & 31)]; }
    asm volatile("s_waitcnt lgkmcnt(0)" ::: "memory");
    const int c = lane & 7;
#pragma unroll
    for (int j = 0; j < 4; ++j) { const int n = (lane >> 3) + 8 * j; const LAS float* s = scr + (8 * c) * 33 + n;
        v4u o; o.x = pk2(s[0 * 33], s[1 * 33]); o.y = pk2(s[2 * 33], s[3 * 33]); o.z = pk2(s[4 * 33], s[5 * 33]); o.w = pk2(s[6 * 33], s[7 * 33]);
        *(v4u*)(WT + (size_t)(n0 + n) * K + k0 + 8 * c) = o; }
    asm volatile("s_waitcnt lgkmcnt(0)" ::: "memory");
}
__device__ __forceinline__ void p0_transpose(const float* W, int K, int N, bf16* WT, LAS float* scr, int gw, int NGW, int lane) {
    const int items = (K / 64) * (N / 32);
    for (int it = gw; it < items; it += NGW) p0_transpose_item(W, K, N, WT, scr, it, lane);
}
__device__ __forceinline__ void p0_convert(const float* src, bf16* dst, size_t n, size_t gtid, size_t nthr) {
    const size_t n8 = n / 8;
    for (size_t i = gtid; i < n8; i += nthr) {
        const f32x4 a = *(const f32x4*)(src + i * 8), b = *(const f32x4*)(src + i * 8 + 4);
        v4u o; o.x = pk2(a.x, a.y); o.y = pk2(a.z, a.w); o.z = pk2(b.x, b.y); o.w = pk2(b.z, b.w);
        *(v4u*)(dst + i * 8) = o;
    }
}
__device__ __forceinline__ void p0_convert8(const float* src, unsigned char* dst, size_t n, float scale, size_t gtid, size_t nthr) {
    const size_t n16 = n / 16;
    for (size_t i = gtid; i < n16; i += nthr) {
        v4u o;
#pragma unroll
        for (int q = 0; q < 4; ++q) { const f32x4 a = *(const f32x4*)(src + i * 16 + q * 4);
            int w = __builtin_amdgcn_cvt_pk_fp8_f32(a.x * scale, a.y * scale, 0, false); w = __builtin_amdgcn_cvt_pk_fp8_f32(a.z * scale, a.w * scale, w, true); o[q] = (unsigned)w; }
        *(v4u*)(dst + i * 16) = o;
    }
}
__device__ __forceinline__ void p0_convert4(const float* src, unsigned char* dst, float* rscale, int nrows, int gw, int NGW, int lane) {
    for (int r = gw; r < nrows; r += NGW) {
        const float* s = src + (size_t)r * 1024 + lane * 16;
        f32x4 v[4]; float mx = 0.f;
#pragma unroll
        for (int q = 0; q < 4; ++q) { v[q] = *(const GAS f32x4*)(s + 4 * q); mx = fmaxf(mx, fmaxf(fmaxf(fabsf(v[q].x), fabsf(v[q].y)), fmaxf(fabsf(v[q].z), fabsf(v[q].w)))); }
#pragma unroll
        for (int o = 1; o < 64; o <<= 1) mx = fmaxf(mx, __shfl_xor(mx, o));
        const float sc = mx > 0.f ? mx * (1.0f / 6.0f) : 1.0f, inv = 1.0f / sc;
        v2u w; w.x = 0u; w.y = 0u;
        w.x = __builtin_amdgcn_cvt_scalef32_pk_fp4_f32(w.x, v[0].x * inv, v[0].y * inv, 1.0f, 0); w.x = __builtin_amdgcn_cvt_scalef32_pk_fp4_f32(w.x, v[0].z * inv, v[0].w * inv, 1.0f, 1);
        w.x = __builtin_amdgcn_cvt_scalef32_pk_fp4_f32(w.x, v[1].x * inv, v[1].y * inv, 1.0f, 2); w.x = __builtin_amdgcn_cvt_scalef32_pk_fp4_f32(w.x, v[1].z * inv, v[1].w * inv, 1.0f, 3);
        w.y = __builtin_amdgcn_cvt_scalef32_pk_fp4_f32(w.y, v[2].x * inv, v[2].y * inv, 1.0f, 0); w.y = __builtin_amdgcn_cvt_scalef32_pk_fp4_f32(w.y, v[2].z * inv, v[2].w * inv, 1.0f, 1);
        w.y = __builtin_amdgcn_cvt_scalef32_pk_fp4_f32(w.y, v[3].x * inv, v[3].y * inv, 1.0f, 2); w.y = __builtin_amdgcn_cvt_scalef32_pk_fp4_f32(w.y, v[3].z * inv, v[3].w * inv, 1.0f, 3);
        *(GAS v2u*)(dst + (size_t)r * 512 + lane * 8) = w;
        if (lane == 0) rscale[r] = sc;
    }
}
__device__ __forceinline__ void p0_weff(const float* wq, const float* subk, bf16* weff, LAS unsigned char* lds, int bid, int G, int tid) {
    LAS float* SK = (LAS float*)lds;
    LAS float* WQ = SK + 128 * 129;
    for (int unit = bid; unit < 256; unit += G) {
        const int i = unit >> 6, hc = (unit >> 2) & 15, kq = unit & 3, c = hc & 1;
        __syncthreads();
        const float* sk = subk + ((size_t)(i * 2 + c) * 128) * 128;
        for (int idx = tid; idx < 128 * 128; idx += NTHR) SK[(idx >> 7) * 129 + (idx & 127)] = sk[idx];
        const int k = tid & 127, kg = tid >> 7;
        for (int kt = 0; kt < 8; ++kt) {
            const int kk0 = kq * 256 + kt * 32;
            __syncthreads();
            for (int idx = tid; idx < 32 * 128; idx += NTHR) WQ[(idx >> 7) * 129 + (idx & 127)] = wq[((size_t)i * 1024 + kk0 + (idx >> 7)) * 2048 + hc * 128 + (idx & 127)];
            __syncthreads();
            float acc[8];
#pragma unroll
            for (int j = 0; j < 8; ++j) acc[j] = 0.f;
            for (int d = 0; d < 128; ++d) { const float a = SK[k * 129 + d];
#pragma unroll
                for (int j = 0; j < 8; ++j) acc[j] += a * WQ[(kg * 8 + j) * 129 + d]; }
            v4u o; o.x = pk2(acc[0], acc[1]); o.y = pk2(acc[2], acc[3]); o.z = pk2(acc[4], acc[5]); o.w = pk2(acc[6], acc[7]);
            *(v4u*)(weff + ((size_t)i * 2048 + hc * 128 + k) * 1024 + kk0 + kg * 8) = o;
        }
    }
    __syncthreads();
}

__device__ __forceinline__ void ln_row(const float* zrow, const float* g, const float* b, float* orow, bf16* obrow, int lane) {
    const f32x4* zr = (const f32x4*)zrow + lane;
    f32x4 v[4]; float s = 0.f;
#pragma unroll
    for (int j = 0; j < 4; ++j) { v[j] = zr[64 * j]; s += (v[j].x + v[j].y) + (v[j].z + v[j].w); }
    const float mean = wave_sum(s) * (1.f / D); float s2 = 0.f;
#pragma unroll
    for (int j = 0; j < 4; ++j) { v[j] = v[j] - mean; s2 += (v[j].x * v[j].x + v[j].y * v[j].y) + (v[j].z * v[j].z + v[j].w * v[j].w); }
    const float rstd = 1.f / sqrtf(wave_sum(s2) * (1.f / D) + LN_EPS);
#pragma unroll
    for (int j = 0; j < 4; ++j) { const f32x4 gg = ((const f32x4*)g + lane)[64 * j], bb = ((const f32x4*)b + lane)[64 * j];
        const f32x4 o = v[j] * rstd * gg + bb; ((f32x4*)orow + lane)[64 * j] = o;
        v2u w; w.x = pk2(o.x, o.y); w.y = pk2(o.z, o.w); ((v2u*)obrow + lane)[64 * j] = w; }
}

namespace att {
constexpr int KP = 144;
constexpr int VT_OFF = 64 * KP;
constexpr int MISC_OFF = 2 * 64 * KP;
struct Stage { v4u k, v; };
__device__ __forceinline__ Stage gload(const bf16* kb, const bf16* vb, int pitch, int tok0, int tstride, int jd0, int tid) {
    Stage s; const int row = tid >> 3, ch = tid & 7, key = tid & 63, vc = tid >> 6;
    s.k = *(const v4u*)(kb + (size_t)(tok0 + tstride * (jd0 + row)) * pitch + ch * 8);
    s.v = *(const v4u*)(vb + (size_t)(tok0 + tstride * (jd0 + key)) * pitch + vc * 8);
    return s;
}
__device__ __forceinline__ void lstore(LAS unsigned char* lds, const Stage& s, int tid) {
    const int row = tid >> 3, ch = tid & 7, key = tid & 63, vc = tid >> 6;
    *(LAS v4u*)(lds + row * KP + ch * 16) = s.k;
    LAS unsigned short* vt = (LAS unsigned short*)(lds + VT_OFF);
#pragma unroll
    for (int i = 0; i < 8; ++i) vt[(vc * 8 + i) * (KP / 2) + key] = (unsigned short)(s.v[i >> 1] >> ((i & 1) * 16));
}
__device__ __forceinline__ void qk(f32x4 (&s)[4], LAS const unsigned char* lds, const bf16x8 (&qf)[2], int fr, int g) {
#pragma unroll
    for (int mt = 0; mt < 4; ++mt) { s[mt] = (f32x4){0.f, 0.f, 0.f, 0.f};
#pragma unroll
        for (int ks = 0; ks < 2; ++ks) { const bf16x8 kf = *(const LAS bf16x8*)(lds + (mt * 16 + fr) * KP + (ks * 32 + 8 * g) * 2);
            s[mt] = __builtin_amdgcn_mfma_f32_16x16x32_bf16(kf, qf[ks], s[mt], 0, 0, 0); } }
}
typedef __bf16 bf16x2v __attribute__((ext_vector_type(2)));
__device__ __forceinline__ unsigned cvtpk(float lo, float hi) { const f32x2 v = {lo, hi}; return __builtin_bit_cast(unsigned, __builtin_convertvector(v, bf16x2v)); }
constexpr float M_INIT = -1e20f, M_MASK = -1e30f;
template <int VPITCH, bool FULL>
__device__ __forceinline__ void tile_compute_g(LAS const unsigned char* klds, LAS const unsigned char* vlds, const bf16x8 (&qf)[2], float& m, float& l, f32x4 (&o)[4], int dist0, bool lane_ok, int maxd, float sc2, float slope2, int fr, int g) {
    f32x4 s[4];
    qk(s, klds, qf, fr, g);
    float tmax = M_MASK;
    if (FULL) {
        const float base = lane_ok ? -slope2 * (float)dist0 : M_MASK;
#pragma unroll
        for (int mt = 0; mt < 4; ++mt)
#pragma unroll
            for (int r = 0; r < 4; ++r) { const float val = __builtin_fmaf(s[mt][r], sc2, __builtin_fmaf(slope2, (float)(mt * 16 + r), base)); s[mt][r] = val; tmax = fmaxf(tmax, val); }
    } else {
#pragma unroll
        for (int mt = 0; mt < 4; ++mt)
#pragma unroll
            for (int r = 0; r < 4; ++r) { const int d = dist0 - mt * 16 - r; const bool valid = lane_ok && d >= 0 && d <= maxd;
                const float val = valid ? (s[mt][r] * sc2 - slope2 * (float)d) : M_MASK; s[mt][r] = val; tmax = fmaxf(tmax, val); }
    }
    tmax = fmaxf(tmax, __shfl_xor(tmax, 16)); tmax = fmaxf(tmax, __shfl_xor(tmax, 32));
    const float mnew = fmaxf(m, tmax), alpha = __builtin_amdgcn_exp2f(m - mnew);
    float psum = 0.f;
#pragma unroll
    for (int mt = 0; mt < 4; ++mt)
#pragma unroll
        for (int r = 0; r < 4; ++r) { const float p = __builtin_amdgcn_exp2f(s[mt][r] - mnew); psum += p; s[mt][r] = p; }
    l = l * alpha + psum; m = mnew;
#pragma unroll
    for (int dt = 0; dt < 4; ++dt) o[dt] = o[dt] * alpha;
    bf16x8 pb[2];
#pragma unroll
    for (int kk = 0; kk < 2; ++kk) { v4u w; w.x = cvtpk(s[2 * kk][0], s[2 * kk][1]); w.y = cvtpk(s[2 * kk][2], s[2 * kk][3]); w.z = cvtpk(s[2 * kk + 1][0], s[2 * kk + 1][1]); w.w = cvtpk(s[2 * kk + 1][2], s[2 * kk + 1][3]);
        pb[kk] = __builtin_bit_cast(bf16x8, w); }
#pragma unroll
    for (int dt = 0; dt < 4; ++dt)
#pragma unroll
        for (int kk = 0; kk < 2; ++kk) { LAS const unsigned char* vp = vlds + (dt * 16 + fr) * VPITCH + (32 * kk + 4 * g) * 2;
            const v2u lo = *(const LAS v2u*)vp, hi = *(const LAS v2u*)(vp + 32);
            v4u w; w.x = lo.x; w.y = lo.y; w.z = hi.x; w.w = hi.y;
            o[dt] = __builtin_amdgcn_mfma_f32_16x16x32_bf16(__builtin_bit_cast(bf16x8, w), pb[kk], o[dt], 0, 0, 0); }
}
template <int VPITCH>
__device__ __forceinline__ void tile_compute_auto(LAS const unsigned char* klds, LAS const unsigned char* vlds, const bf16x8 (&qf)[2], float& m, float& l, f32x4 (&o)[4], int iq, int iq_lo, int jd0, bool lane_ok, int maxd, float sc2, float slope2, int fr, int g) {
    const bool full = (jd0 + 63 <= iq_lo) && (jd0 >= iq_lo + 15 - maxd);
    if (full) tile_compute_g<VPITCH, true>(klds, vlds, qf, m, l, o, iq - jd0 - 4 * g, lane_ok, maxd, sc2, slope2, fr, g);
    else tile_compute_g<VPITCH, false>(klds, vlds, qf, m, l, o, iq - jd0 - 4 * g, lane_ok, maxd, sc2, slope2, fr, g);
}
constexpr int VP4 = 528, VT4_OFF = 256 * KP, MISC4_OFF = VT4_OFF + 64 * VP4;
struct Stage4 { v4u k[4], v[4]; };
__device__ __forceinline__ void gload4(Stage4& s, const bf16* kb, const bf16* vb, int pitch, int tok0, int nsub, int tid) {
    const int row = tid >> 3, ch = tid & 7, key = tid & 63, vc = tid >> 6;
#pragma unroll
    for (int i = 0; i < 4; ++i) {
        s.k[i] = *(const GAS v4u*)(kb + (size_t)(tok0 + 64 * i + row) * pitch + ch * 8);
        s.v[i] = *(const GAS v4u*)(vb + (size_t)(tok0 + 64 * i + key) * pitch + vc * 8); }
}
__device__ __forceinline__ void lstore4(LAS unsigned char* lds, const Stage4& s, int nsub, int tid) {
    const int row = tid >> 3, ch = tid & 7, key = tid & 63, vc = tid >> 6;
    LAS unsigned short* vt = (LAS unsigned short*)(lds + VT4_OFF);
#pragma unroll
    for (int i = 0; i < 4; ++i) {
        *(LAS v4u*)(lds + (64 * i + row) * KP + ch * 16) = s.k[i];
#pragma unroll
        for (int e = 0; e < 8; ++e) vt[(vc * 8 + e) * (VP4 / 2) + 64 * i + key] = (unsigned short)(s.v[i][e >> 1] >> ((e & 1) * 16)); }
}
__device__ __forceinline__ void load_q(bf16x8 (&qf)[2], const bf16* qrow, int g) {
    qf[0] = *(const bf16x8*)(qrow + 8 * g); qf[1] = *(const bf16x8*)(qrow + 32 + 8 * g);
}
__device__ __forceinline__ void store_o(bf16* orow, const f32x4 (&o)[4], float scale, int g) {
#ifdef EXP_NOATT
    scale = 0.f;
#endif
#pragma unroll
    for (int dt = 0; dt < 4; ++dt) { v2u w; w.x = pk2(o[dt][0] * scale, o[dt][1] * scale); w.y = pk2(o[dt][2] * scale, o[dt][3] * scale); *(v2u*)(orow + dt * 16 + 4 * g) = w; }
}

__device__ __forceinline__ void banded_unit(LAS unsigned char* lds, const bf16* qb, const bf16* kb, const bf16* vb, int pitch, int tok0, int tstride, int idil0, int maxd, float slope2,
                                            float& m, float& l, f32x4 (&o)[4], int tid) {
    const int lane = tid & 63, w = tid >> 6, fr = lane & 15, g = lane >> 4;
    const int iq = idil0 + 16 * w + fr;
    bf16x8 qf[2]; load_q(qf, qb + (size_t)(tok0 + tstride * iq) * pitch, g);
    m = M_INIT; l = 0.f;
#pragma unroll
    for (int dt = 0; dt < 4; ++dt) o[dt] = (f32x4){0.f, 0.f, 0.f, 0.f};
    const int kt0 = idil0 >= 128 ? 0 : 2;
    Stage st = gload(kb, vb, pitch, tok0, tstride, idil0 - 128 + 64 * kt0, tid);
    for (int kt = kt0; kt < 4; ++kt) {
        const int jd0 = idil0 - 128 + 64 * kt;
        __syncthreads();
        lstore(lds, st, tid);
        __syncthreads();
        if (kt + 1 < 4) st = gload(kb, vb, pitch, tok0, tstride, jd0 + 64, tid);
        const bool poss = (jd0 <= iq) && (jd0 + 63 >= iq - maxd);
        if (__any(poss)) tile_compute_auto<KP>(lds, lds + VT_OFF, qf, m, l, o, iq, idil0 + 16 * w, jd0, true, maxd, 0.125f * LOG2E, slope2, fr, g);
    }
    l += __shfl_xor(l, 16); l += __shfl_xor(l, 32);
}
}

#define XB_TMO      128
#define XB_XCNT(j)  (256  + 64 * (j))
#define XB_XSUB(j)  (1280 + 64 * (j))
#define XB_XGEN(j)  (2304 + 64 * (j))
#define XB_TOP      3328
#define XB_TOPGEN   3392
#define XCD_BAR_WORDS 3456
#define XB_SPIN_CAP (1u << 18)

__device__ __forceinline__ unsigned xb_ld(unsigned* p)              { return __hip_atomic_load(p, __ATOMIC_RELAXED, __HIP_MEMORY_SCOPE_AGENT); }
__device__ __forceinline__ unsigned xb_add(unsigned* p, unsigned v) { return __hip_atomic_fetch_add(p, v, __ATOMIC_RELAXED, __HIP_MEMORY_SCOPE_AGENT); }
__device__ __forceinline__ unsigned xb_xcc_id() { return (unsigned)__builtin_amdgcn_s_getreg((3 << 11) | 20) & 0xFu; }
#define XB_SPIN(cond, bar) do { unsigned _sp = 0; while (cond) { __builtin_amdgcn_s_sleep(1); \
    if ((++_sp & 255u) == 0u) { if (xb_ld(&(bar)[XB_TMO])) break; if (_sp > XB_SPIN_CAP) { atomicAdd(&(bar)[XB_TMO], 1u); break; } } } } while (0)

struct XcdBarrier {
    unsigned* bar; unsigned x;
    volatile LAS unsigned* st;
};

__device__ __forceinline__ XcdBarrier xcd_barrier_post(unsigned* bar, volatile LAS unsigned* st) {
    XcdBarrier b; b.bar = bar; b.x = xb_xcc_id(); b.st = st;
    if (threadIdx.x == 0) (void)xb_add(&bar[XB_XCNT(b.x)], 1u);
    return b;
}
__device__ __forceinline__ void xcd_barrier_complete(unsigned* bar, unsigned x, unsigned& nloc, unsigned& nx) {
    const unsigned G = gridDim.x * gridDim.y * gridDim.z;
    unsigned sum, cnt, mine, sp = 0u;
    for (;;) {
        sum = 0u; cnt = 0u; mine = 0u;
#pragma unroll
        for (unsigned j = 0; j < 16; ++j) { const unsigned c = xb_ld(&bar[XB_XCNT(j)]); sum += c; cnt += (c > 0u) ? 1u : 0u; mine = (j == x) ? c : mine; }
        if (sum == G) break;
        __builtin_amdgcn_s_sleep(1);
        if ((++sp & 255u) == 0u) { if (xb_ld(&bar[XB_TMO])) break; if (sp > XB_SPIN_CAP) { atomicAdd(&bar[XB_TMO], 1u); break; } }
    }
    nloc = mine > 0u ? mine : 1u; nx = cnt > 0u ? cnt : 1u;
}

__device__ __forceinline__ void xcd_barrier(const XcdBarrier& b) {
    asm volatile("s_waitcnt vmcnt(0)" ::: "memory");
    __syncthreads();
    if (threadIdx.x == 0) {
        unsigned* bar = b.bar;
        __builtin_amdgcn_s_waitcnt(0);
        unsigned nloc = b.st[0], nx = b.st[1];
        if (nloc == 0u) { xcd_barrier_complete(bar, b.x, nloc, nx); b.st[0] = nloc; b.st[1] = nx; }
        const unsigned old = xb_add(&bar[XB_XSUB(b.x)], 1u);
        const unsigned gen = old / nloc;
        if (old + 1u == (gen + 1u) * nloc) {
            __builtin_amdgcn_fence(__ATOMIC_RELEASE, "agent");
            asm volatile("s_waitcnt vmcnt(0)" ::: "memory");
            const unsigned og = xb_add(&bar[XB_TOP], 1u);
            const unsigned tg = og / nx;
            if (og + 1u == (tg + 1u) * nx) xb_add(&bar[XB_TOPGEN], 1u);
            else XB_SPIN(xb_ld(&bar[XB_TOPGEN]) == tg, bar);
            __builtin_amdgcn_fence(__ATOMIC_ACQUIRE, "agent");
            xb_add(&bar[XB_XGEN(b.x)], 1u);
            asm volatile("s_waitcnt vmcnt(0)" ::: "memory");
        } else {
            XB_SPIN(xb_ld(&bar[XB_XGEN(b.x)]) == gen, bar);
            __builtin_amdgcn_fence(__ATOMIC_ACQUIRE, "agent");
            asm volatile("s_waitcnt vmcnt(0)" ::: "memory");
        }
    }
    __syncthreads();
}

struct Args { const float* in[20]; float* out; unsigned char* ws; };
enum { I_X = 0, I_P, I_AWQKV, I_ASINK, I_AWO, I_BWQKV, I_BWO, I_CWQKV, I_CWO, I_LN1G, I_LN1B, I_LN2G, I_LN2B, I_PWQ, I_PSUBK, I_PU, I_PV, I_PLEW, I_PLEGW, I_PLEGB, I_OUT, I_WS };
constexpr int PTAB_OFF = 131072 + 1024, XBST_OFF = 131072 + 2048;
__device__ __forceinline__ unsigned long long ldp(LAS unsigned char* lds, int i) {
    volatile LAS unsigned* t = (volatile LAS unsigned*)(lds + PTAB_OFF);
    const unsigned lo = __builtin_amdgcn_readfirstlane(t[2 * i]), hi = __builtin_amdgcn_readfirstlane(t[2 * i + 1]);
    return ((unsigned long long)hi << 32) | lo;
}
#define INP(i) ((const float*)ldp(lds, (i)))
#define WSP() ((unsigned char*)ldp(lds, I_WS))
#define LAUNDER(v) asm volatile("" : "+s"(v))
struct Ctx { int tid, lane, wave, G, bid, gw, NGW; };
__device__ __forceinline__ Ctx mkctx() { Ctx c; int t_ = threadIdx.x; asm volatile("" : "+v"(t_)); c.tid = t_; c.lane = c.tid & 63; c.wave = __builtin_amdgcn_readfirstlane(c.tid >> 6); c.G = gridDim.x; c.bid = blockIdx.x; c.gw = c.bid * NW + c.wave; c.NGW = c.G * NW; return c; }

__device__ __forceinline__ void ph_prologue(LAS unsigned char* lds) {
    const Ctx c = mkctx(); unsigned char* ws = WSP();
    const size_t gtid = (size_t)c.bid * NTHR + c.tid, nthr = (size_t)c.G * NTHR;
    LAS float* scr = (LAS float*)(lds + c.wave * 16384);
    for (int j = 0; j < 2; ++j) {
        p0_transpose(INP(I_AWQKV) + (size_t)j * 1024 * 1280, 1024, 1280, (bf16*)(ws + WS_WQKV_A) + (size_t)j * 1280 * 1024, scr, c.gw, c.NGW, c.lane);
        p0_transpose(INP(I_AWO) + (size_t)j * 1024 * 1024, 1024, 1024, (bf16*)(ws + WS_WO_A) + (size_t)j * 1024 * 1024, scr, c.gw, c.NGW, c.lane);
    }
    p0_transpose(INP(I_BWQKV), 1024, 5120, (bf16*)(ws + WS_WQKV_B), scr, c.gw, c.NGW, c.lane);
    p0_transpose(INP(I_BWO), 1024, 1024, (bf16*)(ws + WS_WO_B), scr, c.gw, c.NGW, c.lane);
    p0_transpose(INP(I_CWQKV), 1024, 3072, (bf16*)(ws + WS_WQKV_C), scr, c.gw, c.NGW, c.lane);
    p0_transpose(INP(I_CWO), 1024, 1024, (bf16*)(ws + WS_WO_C), scr, c.gw, c.NGW, c.lane);
    for (int i = 0; i < DEPTH; ++i) {
        p0_transpose(INP(I_PLEW) + (size_t)i * 256 * 1024, 256, 1024, (bf16*)(ws + WS_PLEW) + (size_t)i * 1024 * 256, scr, c.gw, c.NGW, c.lane);
        p0_transpose(INP(I_PLEGW) + (size_t)i * 1024 * 1024, 1024, 1024, (bf16*)(ws + WS_PLEG) + (size_t)i * 1024 * 1024, scr, c.gw, c.NGW, c.lane);
    }
    p0_convert(INP(I_X), (bf16*)(ws + WS_B0), (size_t)S * D, gtid, nthr);
    p0_convert(INP(I_P), (bf16*)(ws + WS_P), (size_t)DEPTH * S * 256, gtid, nthr);
#ifdef PEER_U4
    p0_convert4(INP(I_PU), ws + WS_U, (float*)(ws + WS_RSCALE), DEPTH * PEER_E, c.gw, c.NGW, c.lane);
#else
    p0_convert8(INP(I_PU), ws + WS_U, (size_t)DEPTH * PEER_E * D, 32.0f, gtid, nthr);
#endif
#ifdef PEER_V4
    p0_convert4(INP(I_PV), ws + WS_V, (float*)(ws + WS_RSCALE) + DEPTH * PEER_E, DEPTH * PEER_E, c.gw, c.NGW, c.lane);
#else
    p0_convert8(INP(I_PV), ws + WS_V, (size_t)DEPTH * PEER_E * D, 8.0f, gtid, nthr);
#endif
    p0_weff(INP(I_PWQ), INP(I_PSUBK), (bf16*)(ws + WS_WEFF), lds, c.bid, c.G, c.tid);
}
__device__ __forceinline__ bf16* bcur(unsigned char* ws, int li) { return (bf16*)(ws + ((li & 1) ? WS_B1 : WS_B0)); }
__device__ __forceinline__ bf16* both(unsigned char* ws, int li) { return (bf16*)(ws + ((li & 1) ? WS_B0 : WS_B1)); }

__device__ __forceinline__ void ph_qkv(LAS unsigned char* lds, int li) {
    unsigned char* ws = WSP(); const int kind = li % 3, lj = li / 3;
    const int NQKV = kind == 0 ? 1280 : (kind == 1 ? 5120 : 3072);
    const bf16* wqkv = kind == 0 ? (const bf16*)(ws + WS_WQKV_A) + (size_t)lj * 1280 * 1024 : (kind == 1 ? (const bf16*)(ws + WS_WQKV_B) : (const bf16*)(ws + WS_WQKV_C));
    pg8::Gemm g{bcur(ws, li), wqkv, S, NQKV, D}; pg8::StaticOrder So; So.init(S, NQKV, (int)gridDim.x, (int)blockIdx.x);
    pg8::EpiBf16<0> E{(bf16*)(ws + WS_QKV), NQKV, nullptr, 0, 0, 1.f};
    pg8::gemm_phase<pg8::EpiBf16<0>, pg8::StaticOrder, PG8_ALIGN, PG8_SP2>(lds, g, So, E);
}
__device__ __forceinline__ void ph_attn_a(LAS unsigned char* lds, int li) {
    const Ctx c = mkctx(); unsigned char* ws = WSP(); const int lj = li / 3;
    bf16* const QKV = (bf16*)(ws + WS_QKV); bf16* const Ob = (bf16*)(ws + WS_O);
    const float* sinks = INP(I_ASINK) + lj * 16;
    for (int u = c.bid; u < 16 * 128; u += c.G) {
        const int h = u >> 7, qb = u & 127, kvh = h >> 3;
        const float slope = exp2f(-0.5f * (float)(h + 1));
        float m, l; f32x4 o[4];
        att::banded_unit(lds, QKV + h * 64, QKV + 1024 + kvh * 64, QKV + 1152 + kvh * 64, 1280, 0, 1, qb * 128, 127, slope * LOG2E, m, l, o, c.tid);
        const float sk2 = sinks[h] * LOG2E, mf = fmaxf(m, sk2), lf = l * exp2f(m - mf) + exp2f(sk2 - mf);
        const int tok = qb * 128 + 16 * (c.tid >> 6) + (c.lane & 15);
        att::store_o(Ob + (size_t)tok * 1024 + h * 64, o, exp2f(m - mf) / lf, c.lane >> 4);
    }
}
__device__ __forceinline__ void ph_attn_b(LAS unsigned char* lds) {
    const Ctx c = mkctx(); unsigned char* ws = WSP();
    bf16* const QKV = (bf16*)(ws + WS_QKV); bf16* const OG = (bf16*)(ws + WS_OG); float* const LSE = (float*)(ws + WS_LSE);
    for (int u = c.bid; u < 3 * 16 * 128; u += c.G) {
        const int gi = u >> 11, h = (u >> 7) & 15, uu = u & 127;
        const int r = gi == 0 ? 1 : (gi == 1 ? 4 : 16);
        const int cc = uu % r, b = uu / r;
        const float slope = exp2f(-0.5f * (float)(h + 1));
        float m, l; f32x4 o[4];
        att::banded_unit(lds, QKV + gi * 1024 + h * 64, QKV + 3072 + h * 64, QKV + 4096 + h * 64, 5120, cc, r, b * 128, 128, slope * (float)r * LOG2E, m, l, o, c.tid);
        const int tok = cc + r * (b * 128 + 16 * (c.tid >> 6) + (c.lane & 15));
        att::store_o(OG + ((size_t)gi * S + tok) * 1024 + h * 64, o, 1.0f / l, c.lane >> 4);
        if ((c.lane >> 4) == 0) LSE[((size_t)gi * S + tok) * 16 + h] = (m + log2f(l)) * LN2F;
    }
}
__device__ __forceinline__ void ph_merge_b(LAS unsigned char* lds) {
    const Ctx c = mkctx(); unsigned char* ws = WSP();
    const bf16* OG = (const bf16*)(ws + WS_OG); const float* LSE = (const float*)(ws + WS_LSE); bf16* const Ob = (bf16*)(ws + WS_O);
    const size_t gtid = (size_t)c.bid * NTHR + c.tid, nthr = (size_t)c.G * NTHR;
    for (size_t idx = gtid; idx < (size_t)S * 16 * 8; idx += nthr) {
        const int t = (int)(idx >> 7), h = (int)(idx >> 3) & 15, cch = (int)idx & 7;
        const float l0 = LSE[((size_t)0 * S + t) * 16 + h], l1 = LSE[((size_t)1 * S + t) * 16 + h], l2 = LSE[((size_t)2 * S + t) * 16 + h];
        const float mx = fmaxf(l0, fmaxf(l1, l2)); float w0 = __expf(l0 - mx), w1 = __expf(l1 - mx), w2 = __expf(l2 - mx); const float inv = 1.0f / (w0 + w1 + w2);
        w0 *= inv; w1 *= inv; w2 *= inv;
        const size_t off = (size_t)t * 1024 + h * 64 + cch * 8;
        const v4u a = *(const v4u*)(OG + off), bq = *(const v4u*)(OG + (size_t)S * 1024 + off), cq = *(const v4u*)(OG + (size_t)2 * S * 1024 + off);
        v4u o;
#pragma unroll
        for (int e = 0; e < 4; ++e) o[e] = pk2(w0 * bflo(a[e]) + w1 * bflo(bq[e]) + w2 * bflo(cq[e]), w0 * bfhi(a[e]) + w1 * bfhi(bq[e]) + w2 * bfhi(cq[e]));
        *(v4u*)(Ob + off) = o;
    }
}
__device__ __forceinline__ void ph_kmean(LAS unsigned char* lds) {
    const Ctx c = mkctx(); unsigned char* ws = WSP();
    const bf16* QKV = (const bf16*)(ws + WS_QKV); bf16* const KMEAN = (bf16*)(ws + WS_KMEAN);
    const size_t gtid = (size_t)c.bid * NTHR + c.tid, nthr = (size_t)c.G * NTHR;
    for (size_t idx = gtid; idx < 64 * 512; idx += nthr) {
        const int blk = (int)(idx >> 9), cp = (int)idx & 511;
        const bf16* kp = QKV + (size_t)blk * 256 * 3072 + 1024 + cp * 2;
        float s0 = 0.f, s1 = 0.f;
        for (int r = 0; r < 256; ++r) { const unsigned w = *(const unsigned*)(kp + (size_t)r * 3072); s0 += bflo(w); s1 += bfhi(w); }
        *(unsigned*)(KMEAN + blk * 1024 + cp * 2) = pk2(s0 * (1.f / 256.f), s1 * (1.f / 256.f));
    }
}
__device__ __forceinline__ void ph_attn_c(LAS unsigned char* lds) {
    const Ctx c = mkctx(); unsigned char* ws = WSP();
    const bf16* QKV = (const bf16*)(ws + WS_QKV); const bf16* KMEAN = (const bf16*)(ws + WS_KMEAN); bf16* const Ob = (bf16*)(ws + WS_O);
    const int tid = c.tid, lane = c.lane, G = c.G, bid = c.bid;
    const int rounds = (2048 + G - 1) / G;
    for (int rd = 0; rd < rounds; ++rd) {
        const int L = rd * G + ((rd & 1) ? (G - 1 - bid) : bid);
        if (L >= 2048) continue;
        const int qt = 127 - (L >> 4), h = L & 15, qblk = qt >> 1, t0 = qt * 128;
        const int w = tid >> 6, fr = lane & 15, g = lane >> 4;
        const int iq = t0 + 16 * w + fr;
        const bf16* qb = QKV + h * 64; const bf16* kb = QKV + 1024 + h * 64; const bf16* vb = QKV + 2048 + h * 64;
        const float slope2 = exp2f(-0.5f * (float)(h + 1)) * LOG2E;
        bf16x8 qf[2]; att::load_q(qf, qb + (size_t)iq * 3072, g);
        unsigned long long selmask = 0ull, bunion = 0ull;
        if (qblk > 0) {
            __syncthreads();
            { const int row = tid >> 3, ch = tid & 7; *(LAS v4u*)(lds + row * att::KP + ch * 16) = *(const v4u*)(KMEAN + row * 1024 + h * 64 + ch * 8); }
            __syncthreads();
            f32x4 s[4]; att::qk(s, lds, qf, fr, g);
            const int nsel = qblk < 3 ? qblk : 3;
            for (int sr = 0; sr < nsel; ++sr) {
                float best = -INFINITY; int bi = 64;
#pragma unroll
                for (int mt = 0; mt < 4; ++mt)
#pragma unroll
                    for (int r = 0; r < 4; ++r) { const int n = mt * 16 + 4 * g + r; const bool ok = n < qblk && !((selmask >> n) & 1ull);
                        if (ok && (s[mt][r] > best || bi == 64)) { best = s[mt][r]; bi = n; } }
#pragma unroll
                for (int x = 16; x <= 32; x <<= 1) { const float ob = __shfl_xor(best, x); const int oi = __shfl_xor(bi, x);
                    if (oi < 64 && (bi == 64 || ob > best || (ob == best && oi < bi))) { best = ob; bi = oi; } }
                selmask |= 1ull << bi;
            }
            unsigned lo = (unsigned)selmask, hi = (unsigned)(selmask >> 32);
#pragma unroll
            for (int x = 1; x < 16; x <<= 1) { lo |= __shfl_xor(lo, x); hi |= __shfl_xor(hi, x); }
            LAS unsigned* wun = (LAS unsigned*)(lds + att::MISC4_OFF);
            if (lane == 0) { wun[2 * w] = lo; wun[2 * w + 1] = hi; }
            __syncthreads();
            unsigned ul = 0, uh = 0;
#pragma unroll
            for (int x = 0; x < 8; ++x) { ul |= wun[2 * x]; uh |= wun[2 * x + 1]; }
            bunion = ((unsigned long long)uh << 32) | ul;
        }
        float m = att::M_INIT, l = 0.f; f32x4 o[4];
#pragma unroll
        for (int dt = 0; dt < 4; ++dt) o[dt] = (f32x4){0.f, 0.f, 0.f, 0.f};
        const int nown = (t0 + 128 - qblk * 256) / 64;
        unsigned long long todo = bunion;
        int kbcur = todo ? (__ffsll((long long)todo) - 1) : qblk;
        if (todo) todo &= todo - 1;
        att::Stage4 st; att::gload4(st, (const bf16*)kb, (const bf16*)vb, 3072, kbcur * 256, kbcur == qblk ? nown : 4, tid);
        for (;;) {
            const bool own = kbcur == qblk; const int nsub = own ? nown : 4;
            int nkb = qblk; bool more = !own;
            if (!own && todo) { nkb = __ffsll((long long)todo) - 1; todo &= todo - 1; }
            __syncthreads();
            att::lstore4(lds, st, nsub, tid);
            __syncthreads();
            if (more) att::gload4(st, (const bf16*)kb, (const bf16*)vb, 3072, nkb * 256, nkb == qblk ? nown : 4, tid);
            const bool sel_ok = own || (((selmask >> kbcur) & 1ull) != 0ull);
            if (__any(sel_ok)) {
#pragma unroll 1
                for (int sub = 0; sub < nsub; ++sub) { const int jd0 = kbcur * 256 + sub * 64; const bool lane_ok = sel_ok && (jd0 <= iq);
                    if (__any(lane_ok)) att::tile_compute_auto<att::VP4>(lds + sub * 64 * att::KP, lds + att::VT4_OFF + sub * 128, qf, m, l, o, iq, t0 + 16 * w, jd0, lane_ok, 0x3fffffff, 0.125f * LOG2E, slope2, fr, g); }
            }
            if (!more) break;
            kbcur = nkb;
        }
        l += __shfl_xor(l, 16); l += __shfl_xor(l, 32);
        att::store_o(Ob + (size_t)iq * 1024 + h * 64, o, 1.0f / l, g);
    }
}
__device__ __forceinline__ void ph_gate_c(LAS unsigned char* lds) {
    const Ctx c = mkctx(); unsigned char* ws = WSP();
    const bf16* QKV = (const bf16*)(ws + WS_QKV); const bf16* KMEAN = (const bf16*)(ws + WS_KMEAN);
    int* const cnt = (int*)(ws + WS_CCNT); unsigned* const list = (unsigned*)(ws + WS_CLIST);
    const int tid = c.tid, lane = c.lane, w = tid >> 6, fr = lane & 15, g = lane >> 4;
    for (int u = c.bid; u < 16 * 128; u += c.G) {
        const int qt = u >> 4, h = u & 15, qblk = qt >> 1;
        if (qblk == 0) continue;
        const int iq = qt * 128 + 16 * w + fr;
        bf16x8 qf[2]; att::load_q(qf, QKV + h * 64 + (size_t)iq * 3072, g);
        __syncthreads();
        { const int row = tid >> 3, ch = tid & 7; *(LAS v4u*)(lds + row * att::KP + ch * 16) = *(const v4u*)(KMEAN + row * 1024 + h * 64 + ch * 8); }
        __syncthreads();
        f32x4 s[4]; att::qk(s, lds, qf, fr, g);
        const int nsel = qblk < 3 ? qblk : 3;
        unsigned long long selmask = 0ull;
        for (int sr = 0; sr < nsel; ++sr) {
            float best = -INFINITY; int bi = 64;
#pragma unroll
            for (int mt = 0; mt < 4; ++mt)
#pragma unroll
                for (int r = 0; r < 4; ++r) { const int n = mt * 16 + 4 * g + r; const bool ok = n < qblk && !((selmask >> n) & 1ull);
                    if (ok && (s[mt][r] > best || bi == 64)) { best = s[mt][r]; bi = n; } }
#pragma unroll
            for (int x = 16; x <= 32; x <<= 1) { const float ob = __shfl_xor(best, x); const int oi = __shfl_xor(bi, x);
                if (oi < 64 && (bi == 64 || ob > best || (ob == best && oi < bi))) { best = ob; bi = oi; } }
            selmask |= 1ull << bi;
            if (g == 0) { const int pos = atomicAdd(cnt + h * 64 + bi, 1); list[(size_t)(h * 64 + bi) * 16384 + pos] = (unsigned)iq | ((unsigned)sr << 14); }
        }
    }
}
__device__ __forceinline__ void ph_bucket_c(LAS unsigned char* lds) {
    const Ctx c = mkctx(); unsigned char* ws = WSP();
    const bf16* QKV = (const bf16*)(ws + WS_QKV);
    const int* cnt = (const int*)(ws + WS_CCNT); const unsigned* list = (const unsigned*)(ws + WS_CLIST);
    bf16* const PO = (bf16*)(ws + WS_OG); f32x2* const PML = (f32x2*)(ws + WS_CPML);
    const int tid = c.tid, lane = c.lane, w = tid >> 6, fr = lane & 15, g = lane >> 4;
    LAS int* cl = (LAS int*)(lds + 81920);
    __syncthreads();
    for (int i = tid; i < 1024; i += NTHR) cl[i] = cnt[i];
    __syncthreads();
    int uc = 0, next = c.bid;
    for (int lst = 0; lst < 1024; ++lst) {
        const int cn = cl[lst], nch = (cn + 127) >> 7;
        if (uc + nch <= next) { uc += nch; continue; }
        for (int ch = 0; ch < nch; ++ch, ++uc) {
            if (uc != next) continue;
            next += c.G;
            const int h = lst >> 6, kb = lst & 63;
            const int e = ch * 128 + 16 * w + fr; const bool valid = e < cn;
            const unsigned entry = list[(size_t)lst * 16384 + (valid ? e : 0)];
            const int qid = (int)(entry & 16383u), slot = (int)(entry >> 14);
            bf16x8 qf[2]; att::load_q(qf, QKV + h * 64 + (size_t)qid * 3072, g);
            att::Stage4 st; att::gload4(st, QKV + 1024 + h * 64, QKV + 2048 + h * 64, 3072, kb * 256, 4, tid);
            __syncthreads();
            att::lstore4(lds, st, 4, tid);
            __syncthreads();
            const float slope2 = exp2f(-0.5f * (float)(h + 1)) * LOG2E;
            float m = att::M_INIT, l = 0.f; f32x4 o[4];
#pragma unroll
            for (int dt = 0; dt < 4; ++dt) o[dt] = (f32x4){0.f, 0.f, 0.f, 0.f};
#pragma unroll 1
            for (int sub = 0; sub < 4; ++sub) { const int jd0 = kb * 256 + sub * 64;
                att::tile_compute_g<att::VP4, true>(lds + sub * 64 * att::KP, lds + att::VT4_OFF + sub * 128, qf, m, l, o, qid - jd0 - 4 * g, true, 0, 0.125f * LOG2E, slope2, fr, g); }
            l += __shfl_xor(l, 16); l += __shfl_xor(l, 32);
            if (valid) { const size_t pi = ((size_t)h * 16384 + qid) * 3 + slot;
                att::store_o(PO + pi * 64, o, 1.0f, g);
                if (g == 0) PML[pi] = (f32x2){m, l}; }
        }
    }
}
__device__ __forceinline__ void ph_own_c(LAS unsigned char* lds) {
    const Ctx c = mkctx(); unsigned char* ws = WSP();
    const bf16* QKV = (const bf16*)(ws + WS_QKV); bf16* const Ob = (bf16*)(ws + WS_O);
    const bf16* PO = (const bf16*)(ws + WS_OG); const f32x2* PML = (const f32x2*)(ws + WS_CPML);
    const int tid = c.tid, lane = c.lane, w = tid >> 6, fr = lane & 15, g = lane >> 4;
    for (int u = c.bid; u < 16 * 128; u += c.G) {
        const int qt = u >> 4, h = u & 15, qblk = qt >> 1, t0 = qt * 128;
        const int iq = t0 + 16 * w + fr;
        const float slope2 = exp2f(-0.5f * (float)(h + 1)) * LOG2E;
        bf16x8 qf[2]; att::load_q(qf, QKV + h * 64 + (size_t)iq * 3072, g);
        const int nown = (t0 + 128 - qblk * 256) / 64;
        att::Stage4 st; att::gload4(st, QKV + 1024 + h * 64, QKV + 2048 + h * 64, 3072, qblk * 256, nown, tid);
        __syncthreads();
        att::lstore4(lds, st, nown, tid);
        __syncthreads();
        float m = att::M_INIT, l = 0.f; f32x4 o[4];
#pragma unroll
        for (int dt = 0; dt < 4; ++dt) o[dt] = (f32x4){0.f, 0.f, 0.f, 0.f};
#pragma unroll 1
        for (int sub = 0; sub < nown; ++sub) { const int jd0 = qblk * 256 + sub * 64; const bool lane_ok = jd0 <= iq;
            if (__any(lane_ok)) att::tile_compute_auto<att::VP4>(lds + sub * 64 * att::KP, lds + att::VT4_OFF + sub * 128, qf, m, l, o, iq, t0 + 16 * w, jd0, lane_ok, 0x3fffffff, 0.125f * LOG2E, slope2, fr, g); }
        l += __shfl_xor(l, 16); l += __shfl_xor(l, 32);
        const int nsel = qblk < 3 ? qblk : 3;
        const size_t pb = ((size_t)h * 16384 + iq) * 3;
        f32x2 ml[3]; float M = m;
#pragma unroll
        for (int s = 0; s < 3; ++s) { ml[s] = (f32x2){att::M_MASK, 0.f}; if (s < nsel) ml[s] = PML[pb + s]; M = fmaxf(M, ml[s].x); }
        const float so = __builtin_amdgcn_exp2f(m - M); l *= so;
#pragma unroll
        for (int dt = 0; dt < 4; ++dt) o[dt] = o[dt] * so;
#pragma unroll
        for (int s = 0; s < 3; ++s) if (s < nsel) { const float sc = __builtin_amdgcn_exp2f(ml[s].x - M); l += ml[s].y * sc;
#pragma unroll
            for (int dt = 0; dt < 4; ++dt) { const v2u pv = *(const v2u*)(PO + (pb + s) * 64 + dt * 16 + 4 * g);
                o[dt][0] += sc * bflo(pv.x); o[dt][1] += sc * bfhi(pv.x); o[dt][2] += sc * bflo(pv.y); o[dt][3] += sc * bfhi(pv.y); } }
        att::store_o(Ob + (size_t)iq * 1024 + h * 64, o, 1.0f / l, g);
    }
}
__device__ __forceinline__ void ph_oproj(LAS unsigned char* lds, int li) {
    unsigned char* ws = WSP(); const int kind = li % 3, lj = li / 3;
    const bf16* wo = kind == 0 ? (const bf16*)(ws + WS_WO_A) + (size_t)lj * 1024 * 1024 : (kind == 1 ? (const bf16*)(ws + WS_WO_B) : (const bf16*)(ws + WS_WO_C));
    const float* xin = li == 0 ? INP(I_X) : (const float*)(ws + WS_F0);
    pg8::Gemm g{(const bf16*)(ws + WS_O), wo, S, D, D}; pg8::StaticOrder So; So.init(S, D, (int)gridDim.x, (int)blockIdx.x);
    pg8::EpiResid E{xin, (float*)(ws + WS_F1), D, DN_ALPHA};
    pg8::gemm_phase<pg8::EpiResid, pg8::StaticOrder, PG8_ALIGN, PG8_SP2>(lds, g, So, E);
}
__device__ __forceinline__ void ph_ln1(LAS unsigned char* lds, int li) {
    const Ctx c = mkctx(); unsigned char* ws = WSP();
    float* const F1 = (float*)(ws + WS_F1); bf16* const Bc = bcur(ws, li);
    const float* g1 = INP(I_LN1G) + li * D; const float* b1 = INP(I_LN1B) + li * D;
    for (int r = c.gw; r < S; r += c.NGW) ln_row(F1 + (size_t)r * D, g1, b1, F1 + (size_t)r * D, Bc + (size_t)r * D, c.lane);
}
__device__ __forceinline__ void ph_sc(LAS unsigned char* lds, int li) {
    unsigned char* ws = WSP();
    pg8::Gemm g{bcur(ws, li), (const bf16*)(ws + WS_WEFF) + (size_t)li * 2048 * 1024, S, 2048, D}; pg8::StaticOrder So; So.init(S, 2048, (int)gridDim.x, (int)blockIdx.x);
    pg8::EpiF32 E{(float*)(ws + WS_QKV), 2048};
    pg8::gemm_phase<pg8::EpiF32, pg8::StaticOrder, PG8_ALIGN, PG8_SP2>(lds, g, So, E);
}
__device__ __forceinline__ void ph_peer(LAS unsigned char* lds, int li, bool dry = false) {
    const Ctx c = mkctx(); unsigned char* ws = WSP();
    const int lane = c.lane, gw = c.gw, NGW = c.NGW;
    const GAS float* SC = (const GAS float*)(ws + WS_QKV); GAS float* const F0 = (GAS float*)(ws + (dry ? WS_OG : WS_F0)); const GAS float* F1 = (const GAS float*)(ws + WS_F1); GAS bf16* const Bout = dry ? (GAS bf16*)(ws + WS_OG + 64 * MiB) : (GAS bf16*)bcur(ws, li);
#ifdef PEER_U4
    const GAS unsigned char* U8 = (const GAS unsigned char*)(ws + WS_U + (size_t)li * PEER_E * 512); const GAS float* USC = (const GAS float*)(ws + WS_RSCALE) + li * PEER_E;
#else
    const GAS unsigned char* U8 = (const GAS unsigned char*)(ws + WS_U + (size_t)li * PEER_E * D);
#endif
#ifdef PEER_V4
    const GAS unsigned char* V8 = (const GAS unsigned char*)(ws + WS_V + (size_t)li * PEER_E * 512); const GAS float* VSC = (const GAS float*)(ws + WS_RSCALE) + (DEPTH + li) * PEER_E;
#else
    const GAS unsigned char* V8 = (const GAS unsigned char*)(ws + WS_V + (size_t)li * PEER_E * D);
#endif
    const GAS float* g2 = (const GAS float*)(INP(I_LN2G) + li * D); const GAS float* b2 = (const GAS float*)(INP(I_LN2B) + li * D);
    const int seg = lane >> 4, r = lane & 15;
#pragma unroll 1
    for (int t = gw; t < S; t += NGW) {
        const GAS float* scr = SC + (size_t)t * 2048;
        float tv[4]; int ti[4];
#pragma unroll
        for (int p = 0; p < 4; ++p) {
            const int Gp = 4 * p + seg;
            const GAS float* b = scr + Gp * 128 + r * 8;
            const f32x4 a0 = *(const GAS f32x4*)b, a1 = *(const GAS f32x4*)(b + 4);
            unsigned kk[8];
#pragma unroll
            for (int j = 0; j < 4; ++j) { kk[j] = (sortable(a0[j]) & ~127u) | (unsigned)(127 - (r * 8 + j)); kk[4 + j] = (sortable(a1[j]) & ~127u) | (unsigned)(127 - (r * 8 + 4 + j)); }
#define CE(i, j) { const unsigned hi_ = kk[i] > kk[j] ? kk[i] : kk[j], lo_ = kk[i] > kk[j] ? kk[j] : kk[i]; kk[i] = hi_; kk[j] = lo_; }
            CE(0, 1) CE(2, 3) CE(4, 5) CE(6, 7)  CE(0, 2) CE(1, 3) CE(4, 6) CE(5, 7)  CE(1, 2) CE(5, 6)  CE(0, 4) CE(1, 5) CE(2, 6) CE(3, 7)  CE(2, 4) CE(3, 5)  CE(1, 2) CE(3, 4) CE(5, 6)
#undef CE
            unsigned win = 0u;
#pragma unroll
            for (int rd = 0; rd < 16; ++rd) {
                const unsigned head = kk[0], wk = row_max_u32(head); const bool pop = head == wk;
#pragma unroll
                for (int j = 0; j < 7; ++j) kk[j] = pop ? kk[j + 1] : kk[j];
                kk[7] = pop ? 0u : kk[7];
                if (r == rd) win = wk;
            }
            const int idx = 127 - (int)(win & 127u);
            ti[p] = idx; tv[p] = scr[Gp * 128 + idx];
        }
        float gate[4]; int expert[4];
#pragma unroll
        for (int p = 0; p < 4; ++p) {
            const float v1 = tv[p];
            int pa = 0; unsigned wab = 0u;
            const int srcb = (seg | 1) << 4, myb = seg << 4;
#pragma unroll
            for (int rd = 0; rd < 16; ++rd) {
                const float v2 = __shfl(tv[p], srcb + pa);
                const float cand = v1 + v2; const unsigned key = (sortable(cand) & ~255u) | (unsigned)((15 - r) << 4) | (unsigned)(15 - pa);
                const unsigned wk = row_max_u32(key); const int a = 15 - (int)((wk >> 4) & 15u);
                if (r == rd) wab = wk;
                if (r == a) ++pa;
            }
            const int wa = 15 - (int)((wab >> 4) & 15u), wb = 15 - (int)(wab & 15u);
            const float bestv = __shfl(tv[p], myb + wa) + __shfl(tv[p], srcb + wb);
            const int beste = __shfl(ti[p], myb + wa) * 128 + __shfl(ti[p], srcb + wb);
            const float mx = row_max_f32(bestv), e = __expf(bestv - mx), sm = row_sum_f32(e);
            gate[p] = e / sm; expert[p] = beste;
        }
        int E0, E1; float G0, G1;
        { const int s0 = lane & 15, s1 = 32 + (lane & 15), pp = lane >> 4;
          const int a0 = __shfl(expert[0], s0), a1 = __shfl(expert[1], s0), a2 = __shfl(expert[2], s0), a3 = __shfl(expert[3], s0);
          const int c0 = __shfl(expert[0], s1), c1 = __shfl(expert[1], s1), c2 = __shfl(expert[2], s1), c3 = __shfl(expert[3], s1);
          const float g0 = __shfl(gate[0], s0), g1 = __shfl(gate[1], s0), g2_ = __shfl(gate[2], s0), g3 = __shfl(gate[3], s0);
          const float d0 = __shfl(gate[0], s1), d1 = __shfl(gate[1], s1), d2 = __shfl(gate[2], s1), d3 = __shfl(gate[3], s1);
          E0 = pp == 0 ? a0 : (pp == 1 ? a1 : (pp == 2 ? a2 : a3)); E1 = pp == 0 ? c0 : (pp == 1 ? c1 : (pp == 2 ? c2 : c3));
          G0 = pp == 0 ? g0 : (pp == 1 ? g1 : (pp == 2 ? g2_ : g3)); G1 = pp == 0 ? d0 : (pp == 1 ? d1 : (pp == 2 ? d2 : d3)); }
        const GAS float* x1r = F1 + (size_t)t * D + lane * 16;
        f32x2 xv[8];
#pragma unroll
        for (int q = 0; q < 4; ++q) { const f32x4 v = *(const GAS f32x4*)(x1r + 4 * q); xv[2 * q] = (f32x2){v.x, v.y}; xv[2 * q + 1] = (f32x2){v.z, v.w}; }
#define PEER_LOADB(dst, TAB, EREG, LB) _Pragma("unroll") for (int j = 0; j < PNB; ++j) { const int e_ = __builtin_amdgcn_readlane(EREG, (LB) + j); dst[j] = *(const GAS v4u*)(TAB + ((size_t)e_ << 10) + lane * 16); }
#define PEER_DOTB(src, PREG, LB) _Pragma("unroll") for (int j = 0; j < PNB; ++j) { const v4u w = src[j]; f32x2 a2 = (f32x2){0.f, 0.f}; \
            _Pragma("unroll") for (int q = 0; q < 4; ++q) { const f32x2 lo = __builtin_amdgcn_cvt_pk_f32_fp8((int)w[q], false), hi = __builtin_amdgcn_cvt_pk_f32_fp8((int)w[q], true); \
                a2 = __builtin_elementwise_fma(lo, xv[2 * q], a2); a2 = __builtin_elementwise_fma(hi, xv[2 * q + 1], a2); } \
            float acc = a2.x + a2.y; acc = row_sum_f32(acc); if ((lane & 15) == (((LB) + j) & 15)) PREG = acc; }
#define PEER_AXB(src, AREG, LB) _Pragma("unroll") for (int j = 0; j < PNB; ++j) { const v4u w = src[j]; const float a_ = __int_as_float(__builtin_amdgcn_readlane(__float_as_int(AREG), (LB) + j)); const f32x2 aa = (f32x2){a_, a_}; \
            _Pragma("unroll") for (int q = 0; q < 4; ++q) { const f32x2 lo = __builtin_amdgcn_cvt_pk_f32_fp8((int)w[q], false), hi = __builtin_amdgcn_cvt_pk_f32_fp8((int)w[q], true); \
                y2[2 * q] = __builtin_elementwise_fma(lo, aa, y2[2 * q]); y2[2 * q + 1] = __builtin_elementwise_fma(hi, aa, y2[2 * q + 1]); } }
#define PEER_LOADB4(dst, TAB, EREG, LB) _Pragma("unroll") for (int j = 0; j < PNB; ++j) { const int e_ = __builtin_amdgcn_readlane(EREG, (LB) + j); dst[j] = *(const GAS v2u*)(TAB + ((size_t)e_ << 9) + lane * 8); }
#define PEER_DOTB4(src, PREG, LB) _Pragma("unroll") for (int j = 0; j < PNB; ++j) { const v2u w = src[j]; f32x2 a2 = (f32x2){0.f, 0.f}; \
            _Pragma("unroll") for (int q = 0; q < 2; ++q) { \
                a2 = __builtin_elementwise_fma(__builtin_amdgcn_cvt_scalef32_pk_f32_fp4(w[q], 1.0f, 0), xv[4 * q + 0], a2); a2 = __builtin_elementwise_fma(__builtin_amdgcn_cvt_scalef32_pk_f32_fp4(w[q], 1.0f, 1), xv[4 * q + 1], a2); \
                a2 = __builtin_elementwise_fma(__builtin_amdgcn_cvt_scalef32_pk_f32_fp4(w[q], 1.0f, 2), xv[4 * q + 2], a2); a2 = __builtin_elementwise_fma(__builtin_amdgcn_cvt_scalef32_pk_f32_fp4(w[q], 1.0f, 3), xv[4 * q + 3], a2); } \
            float acc = a2.x + a2.y; acc = row_sum_f32(acc); if ((lane & 15) == (((LB) + j) & 15)) PREG = acc; }
#define PEER_AXB4(src, AREG, LB) _Pragma("unroll") for (int j = 0; j < PNB; ++j) { const v2u w = src[j]; const float a_ = __int_as_float(__builtin_amdgcn_readlane(__float_as_int(AREG), (LB) + j)); const f32x2 aa = (f32x2){a_, a_}; \
            _Pragma("unroll") for (int q = 0; q < 2; ++q) { \
                y2[4 * q + 0] = __builtin_elementwise_fma(__builtin_amdgcn_cvt_scalef32_pk_f32_fp4(w[q], 1.0f, 0), aa, y2[4 * q + 0]); y2[4 * q + 1] = __builtin_elementwise_fma(__builtin_amdgcn_cvt_scalef32_pk_f32_fp4(w[q], 1.0f, 1), aa, y2[4 * q + 1]); \
                y2[4 * q + 2] = __builtin_elementwise_fma(__builtin_amdgcn_cvt_scalef32_pk_f32_fp4(w[q], 1.0f, 2), aa, y2[4 * q + 2]); y2[4 * q + 3] = __builtin_elementwise_fma(__builtin_amdgcn_cvt_scalef32_pk_f32_fp4(w[q], 1.0f, 3), aa, y2[4 * q + 3]); } }
#ifdef PEER_U4
        constexpr int PNB = 16;
#else
        constexpr int PNB = 8;
#endif
        float H0 = 0.f, H1 = 0.f, P0 = 0.f, P1 = 0.f;
        {
#ifdef PEER_U4
            v2u bA[PNB], bB[PNB];
            PEER_LOADB4(bA, U8, E0, 0)
#pragma unroll 1
            for (int k = 0; k < 64 / PNB; ++k) {
                const int LB = PNB * k;
                PEER_LOADB4(bB, U8, E1, LB)
                PEER_DOTB4(bA, P0, LB)
                if (k + 1 < 64 / PNB) { PEER_LOADB4(bA, U8, E0, LB + PNB) }
                PEER_DOTB4(bB, P1, LB)
                if (((LB + PNB) & 15) == 0) {
                    P0 += __shfl_xor(P0, 16); P0 += __shfl_xor(P0, 32); P1 += __shfl_xor(P1, 16); P1 += __shfl_xor(P1, 32);
                    if ((lane >> 4) == (LB >> 4)) { H0 = P0; H1 = P1; } }
            }
#else
            v4u bA[PNB], bB[PNB];
            PEER_LOADB(bA, U8, E0, 0)
#pragma unroll 1
            for (int k = 0; k < 64 / PNB; ++k) {
                const int LB = PNB * k;
                PEER_LOADB(bB, U8, E1, LB)
                PEER_DOTB(bA, P0, LB)
                if (k + 1 < 64 / PNB) { PEER_LOADB(bA, U8, E0, LB + PNB) }
                PEER_DOTB(bB, P1, LB)
                if (((LB + PNB) & 15) == 0) {
                    P0 += __shfl_xor(P0, 16); P0 += __shfl_xor(P0, 32); P1 += __shfl_xor(P1, 16); P1 += __shfl_xor(P1, 32);
                    if ((lane >> 4) == (LB >> 4)) { H0 = P0; H1 = P1; } }
            }
#endif
        }
#ifdef PEER_U4
        H0 *= USC[E0]; H1 *= USC[E1];
#else
        H0 *= (1.0f / 32.0f); H1 *= (1.0f / 32.0f);
#endif
#ifdef PEER_V4
        const float vs0 = VSC[E0], vs1 = VSC[E1];
#else
        const float vs0 = 0.125f, vs1 = 0.125f;
#endif
        const float A0 = 0.5f * H0 * (1.0f + erff(H0 * 0.70710678118654752f)) * G0 * vs0;
        const float A1 = 0.5f * H1 * (1.0f + erff(H1 * 0.70710678118654752f)) * G1 * vs1;
        f32x2 y2[8];
#pragma unroll
        for (int q = 0; q < 8; ++q) y2[q] = (f32x2){0.f, 0.f};
        {
#ifdef PEER_V4
            constexpr int PNB = 16;
            v2u bA[PNB], bB[PNB];
            PEER_LOADB4(bA, V8, E0, 0)
#pragma unroll 1
            for (int k = 0; k < 64 / PNB; ++k) {
                const int LB = PNB * k;
                PEER_LOADB4(bB, V8, E1, LB)
                PEER_AXB4(bA, A0, LB)
                if (k + 1 < 64 / PNB) { PEER_LOADB4(bA, V8, E0, LB + PNB) }
                PEER_AXB4(bB, A1, LB)
            }
#else
            constexpr int PNB = 8;
            v4u bA[PNB], bB[PNB];
            PEER_LOADB(bA, V8, E0, 0)
#pragma unroll 1
            for (int k = 0; k < 64 / PNB; ++k) {
                const int LB = PNB * k;
                PEER_LOADB(bB, V8, E1, LB)
                PEER_AXB(bA, A0, LB)
                if (k + 1 < 64 / PNB) { PEER_LOADB(bA, V8, E0, LB + PNB) }
                PEER_AXB(bB, A1, LB)
            }
#endif
        }
#undef PEER_LOADB
#undef PEER_LOADB4
#undef PEER_DOTB4
#undef PEER_AXB4
#undef PEER_DOTB
#undef PEER_AXB
        float z[16]; float s = 0.f;
#pragma unroll
        for (int q = 0; q < 8; ++q) { z[2 * q] = DN_ALPHA * xv[q].x + y2[q].x; z[2 * q + 1] = DN_ALPHA * xv[q].y + y2[q].y; s += z[2 * q] + z[2 * q + 1]; }
        const float mean = wave_sum(s) * (1.f / D); float s2 = 0.f;
#pragma unroll
        for (int q = 0; q < 16; ++q) { z[q] -= mean; s2 += z[q] * z[q]; }
        const float rstd = 1.f / sqrtf(wave_sum(s2) * (1.f / D) + LN_EPS);
        float ov[16];
#pragma unroll
        for (int q = 0; q < 4; ++q) { const int c0 = lane * 16 + q * 4; const f32x4 gg = *(const GAS f32x4*)(g2 + c0), bb2 = *(const GAS f32x4*)(b2 + c0); f32x4 ovv;
#pragma unroll
            for (int e = 0; e < 4; ++e) { ovv[e] = z[q * 4 + e] * rstd * gg[e] + bb2[e]; ov[q * 4 + e] = ovv[e]; }
            *(GAS f32x4*)(F0 + (size_t)t * D + c0) = ovv; }
#pragma unroll
        for (int hh = 0; hh < 2; ++hh) { v4u w; w.x = pk2(ov[hh * 8 + 0], ov[hh * 8 + 1]); w.y = pk2(ov[hh * 8 + 2], ov[hh * 8 + 3]); w.z = pk2(ov[hh * 8 + 4], ov[hh * 8 + 5]); w.w = pk2(ov[hh * 8 + 6], ov[hh * 8 + 7]);
            *(GAS v4u*)(Bout + (size_t)t * D + lane * 16 + hh * 8) = w; }
    }
}
__device__ __forceinline__ void ph_ple_pw(LAS unsigned char* lds, int li) {
    unsigned char* ws = WSP();
    pg8::Gemm g{(const bf16*)(ws + WS_P) + (size_t)li * S * 256, (const bf16*)(ws + WS_PLEW) + (size_t)li * 1024 * 256, S, D, 256}; pg8::StaticOrder So; So.init(S, D, (int)gridDim.x, (int)blockIdx.x);
    pg8::EpiF32 E{(float*)(ws + WS_F1), D};
    pg8::gemm_phase<pg8::EpiF32, pg8::StaticOrder, PG8_ALIGN, PG8_SP2>(lds, g, So, E);
}
__device__ __forceinline__ void ph_ple_gate(LAS unsigned char* lds, int li) {
    unsigned char* ws = WSP();
    float* const F0 = (float*)(ws + WS_F0);
    float* outp = li == DEPTH - 1 ? (float*)ldp(lds, I_OUT) : F0;
    pg8::Gemm g{bcur(ws, li), (const bf16*)(ws + WS_PLEG) + (size_t)li * 1024 * 1024, S, D, D}; pg8::StaticOrder So; So.init(S, D, (int)gridDim.x, (int)blockIdx.x);
    pg8::EpiPle E{F0, (const float*)(ws + WS_F1), INP(I_PLEGB) + li * D, outp, both(ws, li), D};
    pg8::gemm_phase<pg8::EpiPle, pg8::StaticOrder, PG8_ALIGN, PG8_SP2>(lds, g, So, E);
}

#define GRID_SYNC_CG() do { asm volatile("s_waitcnt vmcnt(0)" ::: "memory"); __syncthreads(); grid.sync(); __builtin_amdgcn_fence(__ATOMIC_ACQUIRE, "agent"); asm volatile("s_waitcnt vmcnt(0)" ::: "memory"); __syncthreads(); } while (0)
#define GRID_SYNC() do { XcdBarrier xb_; xb_.bar = (unsigned*)(WSP() + WS_CTL) + 4096; xb_.x = xb_xcc_id(); xb_.st = (volatile LAS unsigned*)(lds + XBST_OFF); xcd_barrier(xb_); } while (0)
__global__ void __launch_bounds__(NTHR, 2) fwd_kernel(Args args) {
    extern __shared__ __attribute__((aligned(16))) unsigned char lds_raw[];
    LAS unsigned char* lds = (LAS unsigned char*)lds_raw;
    cg::grid_group grid = cg::this_grid();
    if (threadIdx.x == 0) {
        LAS unsigned long long* t = (LAS unsigned long long*)(lds + PTAB_OFF);
        t[0] = (unsigned long long)args.in[0]; t[1] = (unsigned long long)args.in[1]; t[2] = (unsigned long long)args.in[2]; t[3] = (unsigned long long)args.in[3];
        t[4] = (unsigned long long)args.in[4]; t[5] = (unsigned long long)args.in[5]; t[6] = (unsigned long long)args.in[6]; t[7] = (unsigned long long)args.in[7];
        t[8] = (unsigned long long)args.in[8]; t[9] = (unsigned long long)args.in[9]; t[10] = (unsigned long long)args.in[10]; t[11] = (unsigned long long)args.in[11];
        t[12] = (unsigned long long)args.in[12]; t[13] = (unsigned long long)args.in[13]; t[14] = (unsigned long long)args.in[14]; t[15] = (unsigned long long)args.in[15];
        t[16] = (unsigned long long)args.in[16]; t[17] = (unsigned long long)args.in[17]; t[18] = (unsigned long long)args.in[18]; t[19] = (unsigned long long)args.in[19];
        t[20] = (unsigned long long)args.out; t[21] = (unsigned long long)args.ws;
    }
    if (threadIdx.x < 2) ((volatile LAS unsigned*)(lds + XBST_OFF))[threadIdx.x] = 0u;
    __syncthreads();
    (void)xcd_barrier_post((unsigned*)args.ws + 4096, (volatile LAS unsigned*)(lds + XBST_OFF));
#ifndef SKIP_PRO
    ph_prologue(lds);
#ifdef REP_PRO
    ph_prologue(lds);
#endif
#endif
    GRID_SYNC_CG();
#pragma unroll 1
    for (int li0 = 0; li0 < DEPTH; ++li0) {
        int li = li0;
        LAUNDER(li); ph_qkv(lds, li);
        GRID_SYNC();
#ifndef SKIP_ATT
        LAUNDER(li);
        const int kind = li % 3;
        if (kind == 0) {
#ifndef SKIP_A
            ph_attn_a(lds, li);
#ifdef REP_AB
            ph_attn_a(lds, li);
#endif
#endif
        } else if (kind == 1) {
#ifndef SKIP_B
            ph_attn_b(lds);
#ifdef REP_AB
            ph_attn_b(lds);
#endif
            GRID_SYNC(); ph_merge_b(lds);
#endif
        } else {
#ifndef SKIP_C
#ifdef C_UNION
            ph_kmean(lds); GRID_SYNC(); ph_attn_c(lds);
#else
            ph_kmean(lds); GRID_SYNC(); ph_gate_c(lds); GRID_SYNC(); ph_bucket_c(lds); GRID_SYNC(); ph_own_c(lds);
#endif
#endif
        }
#endif
        GRID_SYNC();
        LAUNDER(li); ph_oproj(lds, li);
        GRID_SYNC();
        LAUNDER(li); ph_ln1(lds, li);
        GRID_SYNC();
        LAUNDER(li); ph_sc(lds, li);
        GRID_SYNC();
#ifndef SKIP_PEER
#ifdef REP_PEER
        LAUNDER(li); ph_peer(lds, li, true);
#endif
        LAUNDER(li); ph_peer(lds, li);
#endif
        GRID_SYNC();
        LAUNDER(li); ph_ple_pw(lds, li);
        asm volatile("s_waitcnt vmcnt(0)" ::: "memory"); __syncthreads();
        LAUNDER(li); ph_ple_gate(lds, li);
        if (li0 + 1 < DEPTH) GRID_SYNC();
    }
}

extern "C" void kernel_launch(void* const* d_in, const int* in_sizes, int n_in, void* d_out, int out_size, void* d_ws, size_t ws_size, hipStream_t stream) {
    static int grid = 0;
    if (grid == 0) {
        if (n_in != 20 || out_size != S * D || ws_size < WS_END) { fprintf(stderr, "kernel_launch: unexpected shapes: n_in %d out %d ws %zu (need %zu)\n", n_in, out_size, ws_size, (size_t)WS_END); grid = -1; return; }
        int dev = 0, cus = 0, per_cu = 0;
        hipGetDevice(&dev); hipDeviceGetAttribute(&cus, hipDeviceAttributeMultiprocessorCount, dev);
        if (hipFuncSetAttribute((const void*)fwd_kernel, hipFuncAttributeMaxDynamicSharedMemorySize, LDS_BYTES) != hipSuccess) { fprintf(stderr, "kernel_launch: hipFuncSetAttribute failed\n"); grid = -1; return; }
        if (hipOccupancyMaxActiveBlocksPerMultiprocessor(&per_cu, (const void*)fwd_kernel, NTHR, LDS_BYTES) != hipSuccess || per_cu < 1) { fprintf(stderr, "kernel_launch: occupancy query says %d\n", per_cu); per_cu = 1; }
        (void)hipGetLastError();
        grid = cus;
        fprintf(stderr, "kernel_launch: grid %d (cus %d, per_cu %d)\n", grid, cus, per_cu);
    }
    if (grid < 0) return;
    if (hipMemsetAsync((char*)d_ws + WS_CTL, 0, 65536, stream) != hipSuccess) { fprintf(stderr, "kernel_launch: memset failed\n"); return; }
    Args a{};
    for (int i = 0; i < 20; ++i) a.in[i] = (const float*)d_in[i];
    a.out = (float*)d_out; a.ws = (unsigned char*)d_ws;
    void* kargs[] = {&a};
    const hipError_t e = hipLaunchCooperativeKernel((const void*)fwd_kernel, dim3(grid), dim3(NTHR), kargs, LDS_BYTES, stream);
    if (e != hipSuccess) fprintf(stderr, "kernel_launch: cooperative launch failed: %s (grid %d)\n", hipGetErrorString(e), grid);
}
```
